# Optimizing an MI355X kernel written in HIP

```python
import math
import jax, jax.numpy as jnp
from jax import lax
import numpy as np

D_MODEL = 1024
BATCH = 4
SEQ = 8192
DEPTH = 2
DEC_BATCH = 8
DEC_SEQ = 64
PAST_LEN = 4096

CHUNK = 64
N_EVEN = (DEPTH + 1) // 2
N_ODD = DEPTH // 2
EPS = 1e-6
LRU_WIDTH = D_MODEL // 2
LRU_BLOCKS = 8
LRU_BLOCK_DIM = LRU_WIDTH // LRU_BLOCKS
CONV_WIDTH = 4
LRU_C = 8.0
ATT_HEADS = 8
HEAD_DIM = (D_MODEL // 2) // ATT_HEADS
ATT_WIDTH = ATT_HEADS * HEAD_DIM
LEFT_CHUNKS = 8
BAND = (LEFT_CHUNKS + 1) * CHUNK
WINDOW = LEFT_CHUNKS * CHUNK
MAX_REL = 128
IN_AB = 2 * LRU_WIDTH + 3 * ATT_WIDTH
MIX_AB = LRU_WIDTH + ATT_WIDTH
SSM_WIDTH = D_MODEL
SSM_GROUP = 16
SSM_GROUPS = SSM_WIDTH // SSM_GROUP
SSM_STATE = 64
DT_MIN = 1e-3
DT_MAX = 1e-1
D_FF = 2816

kernel_name = "hybrid_streaming_encoder_step"


def _rms_norm(x, g):
    xf = x.astype(jnp.float32)
    y = xf * lax.rsqrt(jnp.mean(xf * xf, axis=-1, keepdims=True) + EPS)
    return (y * g.astype(jnp.float32)).astype(x.dtype)


def _swiglu(x, w_in, w_out):
    gate, up = jnp.split(x @ w_in, 2, axis=-1)
    return (jax.nn.silu(gate) * up) @ w_out


def _causal_dw_conv(x, prev, w, b):
    S = x.shape[1]
    xp = jnp.concatenate([prev.astype(x.dtype), x], axis=1)
    y = b.astype(x.dtype)
    for k in range(CONV_WIDTH):
        y = y + xp[:, k:k + S] * w[k]
    return y, xp[:, xp.shape[1] - (CONV_WIDTH - 1):]


def _rg_lru(xc, h0, wa, ba, wx, bx, lam):
    Bn, S, W = xc.shape
    xb = xc.reshape(Bn, S, LRU_BLOCKS, LRU_BLOCK_DIM)
    r = jax.nn.sigmoid(jnp.einsum('bshi,hij->bshj', xb, wa).reshape(Bn, S, W) + ba)
    i = jax.nn.sigmoid(jnp.einsum('bshi,hij->bshj', xb, wx).reshape(Bn, S, W) + bx)
    log_a = -LRU_C * r.astype(jnp.float32) * jax.nn.softplus(-lam.astype(jnp.float32))
    a = jnp.exp(log_a)
    u = jnp.sqrt(-jnp.expm1(2.0 * log_a)) * (i * xc).astype(jnp.float32)

    def step(h, au):
        a_t, u_t = au
        h = a_t * h + u_t
        return h, h

    h_last, hs = lax.scan(step, h0.astype(jnp.float32), (jnp.swapaxes(a, 0, 1), jnp.swapaxes(u, 0, 1)))
    return jnp.swapaxes(hs, 0, 1).astype(xc.dtype), h_last


def _band_attention(q, k, v, q_pos, k_pos, rel_table):
    rel = q_pos[:, :, None] - k_pos[:, None, :]
    bias = rel_table[jnp.clip(rel, -MAX_REL, MAX_REL) + MAX_REL]
    qc = (q_pos // CHUNK)[:, :, None]
    kc = (k_pos // CHUNK)[:, None, :]
    valid = (k_pos[:, None, :] >= 0) & (kc <= qc) & (kc >= qc - LEFT_CHUNKS)
    s = jnp.einsum('bnqhd,bnkhd->bnhqk', q, k).astype(jnp.float32) / math.sqrt(HEAD_DIM)
    s = s + jnp.transpose(bias, (0, 3, 1, 2)).astype(jnp.float32)[None]
    s = jnp.where(valid[None, :, None], s, -1e30)
    p = jax.nn.softmax(s, axis=-1).astype(v.dtype)
    return jnp.einsum('bnhqk,bnkhd->bnqhd', p, v)


def _prompt_band_attention(q, k, v, rel_table):
    Bn, S = q.shape[:2]
    nc = S // CHUNK
    qch = q.reshape(Bn, nc, CHUNK, ATT_HEADS, HEAD_DIM)
    pad = ((0, 0), (LEFT_CHUNKS * CHUNK, 0), (0, 0), (0, 0))
    kp = jnp.pad(k, pad).reshape(Bn, nc + LEFT_CHUNKS, CHUNK, ATT_HEADS, HEAD_DIM)
    vp = jnp.pad(v, pad).reshape(Bn, nc + LEFT_CHUNKS, CHUNK, ATT_HEADS, HEAD_DIM)
    k_band = jnp.concatenate([kp[:, o:o + nc] for o in range(LEFT_CHUNKS + 1)], axis=2)
    v_band = jnp.concatenate([vp[:, o:o + nc] for o in range(LEFT_CHUNKS + 1)], axis=2)
    q_pos = jnp.arange(S, dtype=jnp.int32).reshape(nc, CHUNK)
    k_pos = (jnp.arange(nc, dtype=jnp.int32)[:, None] - LEFT_CHUNKS) * CHUNK + jnp.arange(BAND, dtype=jnp.int32)[None]
    out = _band_attention(qch, k_band, v_band, q_pos, k_pos, rel_table)
    return out.reshape(Bn, S, ATT_HEADS, HEAD_DIM)


def _sample_band_attention(q, k, v, cache_k, cache_v, rel_table):
    T = q.shape[1]
    wc = cache_k.shape[1]
    kk = jnp.concatenate([cache_k.astype(k.dtype), k], axis=1)[:, None]
    vv = jnp.concatenate([cache_v.astype(v.dtype), v], axis=1)[:, None]
    q_pos = (PAST_LEN + jnp.arange(T, dtype=jnp.int32))[None]
    k_pos = (PAST_LEN - wc + jnp.arange(wc + T, dtype=jnp.int32))[None]
    return _band_attention(q[:, None], kk, vv, q_pos, k_pos, rel_table)[:, 0]


def _even_mixer(h, conv_prev, lru_prev, cache_k, cache_v, w_in, conv_w, conv_b, lru_wa, lru_ba,
                lru_wx, lru_bx, lru_lambda, q_gain, k_gain, rel_bias, w_out, prompt):
    Bn, S, _ = h.shape
    proj = h @ w_in
    xa, ga, q, k, v = jnp.split(proj, [LRU_WIDTH, 2 * LRU_WIDTH, 2 * LRU_WIDTH + ATT_WIDTH,
                                       2 * LRU_WIDTH + 2 * ATT_WIDTH], axis=-1)
    xc, conv_new = _causal_dw_conv(xa, conv_prev, conv_w, conv_b)
    ya, lru_new = _rg_lru(xc, lru_prev, lru_wa, lru_ba, lru_wx, lru_bx, lru_lambda)
    ya = ya * jax.nn.gelu(ga)
    q = _rms_norm(q.reshape(Bn, S, ATT_HEADS, HEAD_DIM), q_gain)
    k = _rms_norm(k.reshape(Bn, S, ATT_HEADS, HEAD_DIM), k_gain)
    v = v.reshape(Bn, S, ATT_HEADS, HEAD_DIM)
    if prompt:
        yb = _prompt_band_attention(q, k, v, rel_bias)
        keep = min(WINDOW, S)
        k_new, v_new = k[:, S - keep:], v[:, S - keep:]
    else:
        yb = _sample_band_attention(q, k, v, cache_k, cache_v, rel_bias)
        k_new, v_new = k, v
    y = jnp.concatenate([ya, yb.reshape(Bn, S, ATT_WIDTH)], axis=-1) @ w_out
    return y, conv_new, lru_new, k_new, v_new


def _s5(u, s0_re, s0_im, A_re, A_im, B_re, B_im, C_re, C_im, D_skip, log_dt):
    Bn, S, W = u.shape
    f32 = jnp.float32
    A = lax.complex(A_re.astype(f32), A_im.astype(f32))
    dt = jnp.exp(log_dt.astype(f32))[:, None]
    A_bar = jnp.exp(A * dt)
    Bc = lax.complex(B_re.astype(f32), B_im.astype(f32))
    B_bar = ((A_bar - 1.0) / A)[..., None] * Bc
    Cc = lax.complex(C_re.astype(f32), C_im.astype(f32))
    ug = u.reshape(Bn, S, SSM_GROUPS, SSM_GROUP).astype(f32)
    bu = jnp.einsum('bsgi,gpi->bsgp', ug.astype(jnp.complex64), B_bar)
    s0 = lax.complex(s0_re.astype(f32), s0_im.astype(f32))
    bu = bu.at[:, 0].add(A_bar * s0)
    a = jnp.broadcast_to(A_bar, (1, S, SSM_GROUPS, SSM_STATE))

    def combine(e1, e2):
        a1, b1 = e1
        a2, b2 = e2
        return a1 * a2, a2 * b1 + b2

    _, s = lax.associative_scan(combine, (a, bu), axis=1)
    y = jnp.einsum('gip,bsgp->bsgi', Cc, s).real.reshape(Bn, S, W) + D_skip.astype(f32) * u.astype(f32)
    s_last = s[:, -1]
    return y.astype(u.dtype), s_last.real, s_last.imag


def _odd_mixer(h, s_re, s_im, A_re, A_im, B_re, B_im, C_re, C_im, D_skip, log_dt, glu_w):
    y, n_re, n_im = _s5(h, s_re, s_im, A_re, A_im, B_re, B_im, C_re, C_im, D_skip, log_dt)
    a, g = jnp.split(y @ glu_w, 2, axis=-1)
    return a * jax.nn.sigmoid(g), n_re, n_im


def _trunk(x, p, conv_st, lru_st, cache_k, cache_v, ssm_re_st, ssm_im_st, prompt):
    Bn = x.shape[0]
    conv_out, lru_out, k_out, v_out, re_out, im_out = [], [], [], [], [], []
    for l in range(DEPTH):
        x = x + 0.5 * _swiglu(_rms_norm(x, p['ffn1_norm'][l]), p['ffn1_w_in'][l], p['ffn1_w_out'][l])
        h = _rms_norm(x, p['mix_norm'][l])
        if l % 2 == 0:
            e = l // 2
            if prompt:
                c_prev = jnp.zeros((Bn, CONV_WIDTH - 1, LRU_WIDTH), x.dtype)
                h_prev = jnp.zeros((Bn, LRU_WIDTH), jnp.float32)
                ck, cv = None, None
            else:
                c_prev, h_prev, ck, cv = conv_st[e], lru_st[e], cache_k[e], cache_v[e]
            y, c_new, h_new, k_new, v_new = _even_mixer(
                h, c_prev, h_prev, ck, cv, p['ab_w_in'][e], p['conv_w'][e], p['conv_b'][e],
                p['lru_wa'][e], p['lru_ba'][e], p['lru_wx'][e], p['lru_bx'][e], p['lru_lambda'][e],
                p['q_norm'][e], p['k_norm'][e], p['rel_bias'][e], p['ab_w_out'][e], prompt)
            conv_out.append(c_new)
            lru_out.append(h_new)
            k_out.append(k_new)
            v_out.append(v_new)
        else:
            o = l // 2
            if prompt:
                s_re = jnp.zeros((Bn, SSM_GROUPS, SSM_STATE), jnp.float32)
                s_im = jnp.zeros((Bn, SSM_GROUPS, SSM_STATE), jnp.float32)
            else:
                s_re, s_im = ssm_re_st[o], ssm_im_st[o]
            y, n_re, n_im = _odd_mixer(
                h, s_re, s_im, p['ssm_A_re'][o], p['ssm_A_im'][o], p['ssm_B_re'][o], p['ssm_B_im'][o],
                p['ssm_C_re'][o], p['ssm_C_im'][o], p['ssm_D'][o], p['ssm_log_dt'][o], p['glu_w'][o])
            re_out.append(n_re)
            im_out.append(n_im)
        x = x + y
        x = x + 0.5 * _swiglu(_rms_norm(x, p['ffn2_norm'][l]), p['ffn2_w_in'][l], p['ffn2_w_out'][l])
    return (x, jnp.stack(conv_out), jnp.stack(lru_out), jnp.stack(k_out), jnp.stack(v_out),
            jnp.stack(re_out), jnp.stack(im_out))


def _normal(k, shape, scale):
    return scale * jax.random.normal(k, shape, jnp.float32)


def setup_inputs(seed: int = 0) -> dict:
    key = jax.random.key(seed)
    k = jax.random.split(key, 40)
    wc = min(WINDOW, PAST_LEN)
    a0 = jax.random.uniform(k[22], (N_EVEN, LRU_WIDTH), jnp.float32, 0.9, 0.999)
    pa = a0 ** (1.0 / LRU_C)
    lam = jnp.log(pa) - jnp.log1p(-pa)
    n_idx = jnp.arange(SSM_STATE, dtype=jnp.float32)
    return {
        'x_prompt': _normal(k[0], (BATCH, SEQ, D_MODEL), 1.0),
        'x_sample': _normal(k[1], (DEC_BATCH, DEC_SEQ, D_MODEL), 1.0),
        'state_rglru_conv': _normal(k[2], (N_EVEN, DEC_BATCH, CONV_WIDTH - 1, LRU_WIDTH), 1.0),
        'state_rglru_h': _normal(k[3], (N_EVEN, DEC_BATCH, LRU_WIDTH), 0.5),
        'cache_band_k': _normal(k[4], (N_EVEN, DEC_BATCH, wc, ATT_HEADS, HEAD_DIM), 1.0),
        'cache_band_v': _normal(k[5], (N_EVEN, DEC_BATCH, wc, ATT_HEADS, HEAD_DIM), 1.0),
        'state_ssm_re': _normal(k[6], (N_ODD, DEC_BATCH, SSM_GROUPS, SSM_STATE), 0.5),
        'state_ssm_im': _normal(k[7], (N_ODD, DEC_BATCH, SSM_GROUPS, SSM_STATE), 0.5),
        'ffn1_norm': 1.0 + _normal(k[8], (DEPTH, D_MODEL), 0.02),
        'ffn1_w_in': _normal(k[9], (DEPTH, D_MODEL, 2 * D_FF), D_MODEL ** -0.5),
        'ffn1_w_out': _normal(k[10], (DEPTH, D_FF, D_MODEL), D_FF ** -0.5),
        'mix_norm': 1.0 + _normal(k[11], (DEPTH, D_MODEL), 0.02),
        'ffn2_norm': 1.0 + _normal(k[12], (DEPTH, D_MODEL), 0.02),
        'ffn2_w_in': _normal(k[13], (DEPTH, D_MODEL, 2 * D_FF), D_MODEL ** -0.5),
        'ffn2_w_out': _normal(k[14], (DEPTH, D_FF, D_MODEL), D_FF ** -0.5),
        'ab_w_in': _normal(k[15], (N_EVEN, D_MODEL, IN_AB), D_MODEL ** -0.5),
        'conv_w': _normal(k[16], (N_EVEN, CONV_WIDTH, LRU_WIDTH), CONV_WIDTH ** -0.5),
        'conv_b': _normal(k[17], (N_EVEN, LRU_WIDTH), 0.01),
        'lru_wa': _normal(k[18], (N_EVEN, LRU_BLOCKS, LRU_BLOCK_DIM, LRU_BLOCK_DIM), LRU_BLOCK_DIM ** -0.5),
        'lru_ba': _normal(k[19], (N_EVEN, LRU_WIDTH), 0.01),
        'lru_wx': _normal(k[20], (N_EVEN, LRU_BLOCKS, LRU_BLOCK_DIM, LRU_BLOCK_DIM), LRU_BLOCK_DIM ** -0.5),
        'lru_bx': _normal(k[21], (N_EVEN, LRU_WIDTH), 0.01),
        'lru_lambda': lam,
        'q_norm': 1.0 + _normal(k[23], (N_EVEN, HEAD_DIM), 0.02),
        'k_norm': 1.0 + _normal(k[24], (N_EVEN, HEAD_DIM), 0.02),
        'rel_bias': _normal(k[25], (N_EVEN, 2 * MAX_REL + 1, ATT_HEADS), 0.2),
        'ab_w_out': _normal(k[26], (N_EVEN, MIX_AB, D_MODEL), MIX_AB ** -0.5),
        'ssm_A_re': -0.5 + _normal(k[27], (N_ODD, SSM_GROUPS, SSM_STATE), 0.01),
        'ssm_A_im': math.pi * n_idx + _normal(k[28], (N_ODD, SSM_GROUPS, SSM_STATE), 0.01),
        'ssm_B_re': _normal(k[29], (N_ODD, SSM_GROUPS, SSM_STATE, SSM_GROUP), (0.5 / SSM_GROUP) ** 0.5),
        'ssm_B_im': _normal(k[30], (N_ODD, SSM_GROUPS, SSM_STATE, SSM_GROUP), (0.5 / SSM_GROUP) ** 0.5),
        'ssm_C_re': _normal(k[31], (N_ODD, SSM_GROUPS, SSM_GROUP, SSM_STATE), (0.5 / SSM_STATE) ** 0.5),
        'ssm_C_im': _normal(k[32], (N_ODD, SSM_GROUPS, SSM_GROUP, SSM_STATE), (0.5 / SSM_STATE) ** 0.5),
        'ssm_D': _normal(k[33], (N_ODD, SSM_WIDTH), 0.5),
        'ssm_log_dt': jax.random.uniform(k[34], (N_ODD, SSM_GROUPS), jnp.float32, math.log(DT_MIN), math.log(DT_MAX)),
        'glu_w': _normal(k[35], (N_ODD, SSM_WIDTH, 2 * D_MODEL), SSM_WIDTH ** -0.5),
    }


def reference(x_prompt, x_sample, state_rglru_conv, state_rglru_h, cache_band_k, cache_band_v,
              state_ssm_re, state_ssm_im, ffn1_norm, ffn1_w_in, ffn1_w_out, mix_norm, ffn2_norm,
              ffn2_w_in, ffn2_w_out, ab_w_in, conv_w, conv_b, lru_wa, lru_ba, lru_wx, lru_bx,
              lru_lambda, q_norm, k_norm, rel_bias, ab_w_out, ssm_A_re, ssm_A_im, ssm_B_re, ssm_B_im,
              ssm_C_re, ssm_C_im, ssm_D, ssm_log_dt, glu_w):
    p = dict(ffn1_norm=ffn1_norm, ffn1_w_in=ffn1_w_in, ffn1_w_out=ffn1_w_out, mix_norm=mix_norm,
             ffn2_norm=ffn2_norm, ffn2_w_in=ffn2_w_in, ffn2_w_out=ffn2_w_out, ab_w_in=ab_w_in,
             conv_w=conv_w, conv_b=conv_b, lru_wa=lru_wa, lru_ba=lru_ba, lru_wx=lru_wx, lru_bx=lru_bx,
             lru_lambda=lru_lambda, q_norm=q_norm, k_norm=k_norm, rel_bias=rel_bias, ab_w_out=ab_w_out,
             ssm_A_re=ssm_A_re, ssm_A_im=ssm_A_im, ssm_B_re=ssm_B_re, ssm_B_im=ssm_B_im,
             ssm_C_re=ssm_C_re, ssm_C_im=ssm_C_im, ssm_D=ssm_D, ssm_log_dt=ssm_log_dt, glu_w=glu_w)
    y_prompt, p_conv, p_h, p_k, p_v, p_re, p_im = _trunk(
        x_prompt, p, None, None, None, None, None, None, True)
    y_sample, s_conv, s_h, s_k, s_v, s_re, s_im = _trunk(
        x_sample, p, state_rglru_conv, state_rglru_h, cache_band_k, cache_band_v,
        state_ssm_re, state_ssm_im, False)
    return (y_prompt, y_sample, p_conv, p_h, p_k, p_v, p_re, p_im, s_conv, s_h, s_k, s_v, s_re, s_im)
```

```cpp
#include <hip/hip_runtime.h>
#include <hip/hip_cooperative_groups.h>
#include <cstdio>
#include <cstdint>
namespace cg = cooperative_groups;
namespace pg8 {
#define PG8_LAS __attribute__((address_space(3)))
typedef unsigned short bf16_t;
typedef short bf16x8 __attribute__((ext_vector_type(8)));
typedef float f32x4 __attribute__((ext_vector_type(4)));
typedef unsigned u32x4 __attribute__((ext_vector_type(4)));
constexpr int BM = 256, BK = 64, HALF = 128, HTB = HALF * BK * 2  , STAGE_BYTES = 8 * HTB, NXCD = 8, WGM = 8;

__host__ __device__ __forceinline__ int lds_byte(int r, int c) { const int st = (r >> 4) * 2 + (c >> 5), rr = r & 15, cc = c & 31, ob = rr * 64 + cc * 2; return st * 1024 + (ob ^ (((ob >> 9) & 1) << 5)); }
__host__ __device__ __forceinline__ void stage_rc(int b, int& R, int& C) { const int st = b / 1024, sb = b % 1024, swz = sb ^ (((sb >> 9) & 1) << 5); R = (st >> 1) * 16 + swz / 64; C = (st & 1) * 32 + (swz % 64) / 2; }
__host__ __device__ __forceinline__ int perm32(int rho) { const int n = rho >> 4, i = rho & 15; return 8 * (i >> 2) + 4 * n + (i & 3); }

struct Unit { int pm, pn, ka; };
struct Gemm { const bf16_t* A; const bf16_t* Bt; int K, lda; };

struct StaticOrder {
    int nM, nN, nwg, G, c;
    __host__ __device__ void init(int M, int N, int G_, int c_) { nM = M / BM; nN = N / BM; nwg = nM * nN; G = G_; c = c_; }
    __host__ __device__ bool next(int i, Unit& u) const {
        const long L = (long)i * G + c; if (L >= nwg) return false;
        int wgid = (int)L; { const int q = nwg / NXCD, r = nwg % NXCD, xcd = wgid % NXCD, off = wgid / NXCD; wgid = (xcd < r ? xcd * (q + 1) : r * (q + 1) + (xcd - r) * q) + off; }
        const int nig = WGM * nN, gid = wgid / nig, fm = gid * WGM, gsz = (nM - fm) < WGM ? (nM - fm) : WGM;
        u.pm = fm + ((wgid % nig) % gsz); u.pn = (wgid % nig) / gsz; u.ka = 0; return true;
    }
    __device__ __forceinline__ void a_ready(const Unit&) const {}
    __device__ __forceinline__ void done(const Unit&) const {}
};

typedef float f32x2 __attribute__((ext_vector_type(2)));
typedef __bf16 bf16v2_t __attribute__((ext_vector_type(2)));
__device__ __forceinline__ unsigned cvt_pk_bf16(float lo, float hi) { f32x2 v = {lo, hi}; return __builtin_bit_cast(unsigned, __builtin_convertvector(v, bf16v2_t)); }
template <class Epi, class Sched, bool ALIGN_EPI = false, bool SP2 = false>
__device__ __forceinline__ void gemm_phase(PG8_LAS unsigned char* lds, const Gemm g, const Sched& S, const Epi& E) {
    int tid_ = threadIdx.x; asm volatile("" : "+v"(tid_));
    const int tid = tid_, wid = __builtin_amdgcn_readfirstlane(tid >> 6), lane = tid & 63, wr = wid >> 2, wc = wid & 3, fr = lane & 15, fq = lane >> 4;
    int K_ = g.K, lda_ = g.lda; asm volatile("" : "+s"(K_), "+s"(lda_));
    const int K = K_, lda = lda_, nt = K / BK;
    unsigned voffA[2], voffB[2];
#pragma unroll
    for (int i = 0; i < 2; ++i) { int R, C; stage_rc(tid * 16 + i * 8192, R, C); const int Rb = Epi::PERM ? ((R & ~31) + perm32(R & 31)) : R;
        voffA[i] = (unsigned)(R * lda + C) * 2u; voffB[i] = (unsigned)(Rb * K + C) * 2u; }
    const size_t kstep = (size_t)(BK * 2);
    const size_t hsA = (size_t)HALF * lda * 2, hsB = (size_t)HALF * K * 2;
    const size_t tsA = 2 * hsA, tsB = 2 * hsB;
    const unsigned ldsw = (unsigned)wid * 1024u;
    const int aoff = lds_byte(wr * 64 + fr, fq * 8), boff = lds_byte(wc * 32 + fr, fq * 8);
#define PG8_SA(b, h) (((b) * 2 + (h)) * HTB)
#define PG8_SB(b, h) ((4 + (b) * 2 + (h)) * HTB)
#define PG8_STAGE(bufoff, gbase, voff) do { _Pragma("unroll") for (int _i = 0; _i < 2; ++_i) \
        __builtin_amdgcn_global_load_lds((const unsigned*)((const char*)(gbase) + (voff)[_i]), (PG8_LAS unsigned*)(lds + (bufoff) + ldsw + _i * 8192), 16, 0, 0); } while (0)
#define PG8_LDA(dst, b, h) do { _Pragma("unroll") for (int m = 0; m < 4; ++m) _Pragma("unroll") for (int k = 0; k < 2; ++k) dst[m][k] = *(const PG8_LAS bf16x8*)(lds + PG8_SA(b, h) + aoff + m * 2048 + k * 1024); } while (0)
#define PG8_LDB(dst, b, h) do { _Pragma("unroll") for (int n = 0; n < 2; ++n) _Pragma("unroll") for (int k = 0; k < 2; ++k) dst[n][k] = *(const PG8_LAS bf16x8*)(lds + PG8_SB(b, h) + boff + n * 2048 + k * 1024); } while (0)
#define PG8_MMA(ai, bj, At, Bt) do { __builtin_amdgcn_s_setprio(1); _Pragma("unroll") for (int m = 0; m < 4; ++m) _Pragma("unroll") for (int n = 0; n < 2; ++n) _Pragma("unroll") for (int k = 0; k < 2; ++k) \
        acc[ai][bj][m][n] = __builtin_amdgcn_mfma_f32_16x16x32_bf16(Bt[n][k], At[m][k], acc[ai][bj][m][n], 0, 0, 0); __builtin_amdgcn_s_setprio(0); } while (0)
#define PG8_WAIT_V(n) asm volatile("s_waitcnt vmcnt(" #n ")" ::: "memory")
#define PG8_WAIT_L(n) asm volatile("s_waitcnt lgkmcnt(" #n ")" ::: "memory")
#define PG8_BAR __builtin_amdgcn_s_barrier()
#define PG8_SCHED __builtin_amdgcn_sched_barrier(0)
    Unit cur, nxt; int ui = 0;
    if (!S.next(0, cur)) return;
    f32x4 acc[2][2][4][2];
#pragma unroll
    for (int a = 0; a < 2; ++a)
#pragma unroll
        for (int b = 0; b < 2; ++b)
#pragma unroll
            for (int m = 0; m < 4; ++m)
#pragma unroll
                for (int n = 0; n < 2; ++n) acc[a][b][m][n] = (f32x4){0.f, 0.f, 0.f, 0.f};
    bf16x8 At[4][2], B0[2][2], B1[2][2];
    const char* cA = (const char*)g.A + (size_t)cur.pm * tsA + cur.ka; const char* cB = (const char*)g.Bt + (size_t)cur.pn * tsB;
    S.a_ready(cur);
    if constexpr (SP2) {
        PG8_STAGE(PG8_SB(0, 0), cB, voffB); PG8_STAGE(PG8_SB(0, 1), cB + hsB, voffB); PG8_STAGE(PG8_SA(0, 0), cA, voffA); PG8_STAGE(PG8_SA(0, 1), cA + hsA, voffA);
        if (wr == 1) PG8_BAR;
        PG8_WAIT_V(2); PG8_BAR;
        PG8_STAGE(PG8_SB(1, 0), cB + kstep, voffB); PG8_STAGE(PG8_SA(1, 0), cA + kstep, voffA); PG8_STAGE(PG8_SB(1, 1), cB + hsB + kstep, voffB);
        PG8_WAIT_V(6); PG8_BAR;
    } else {
        PG8_STAGE(PG8_SB(0, 0), cB, voffB); PG8_STAGE(PG8_SA(0, 0), cA, voffA); PG8_STAGE(PG8_SB(0, 1), cB + hsB, voffB); PG8_STAGE(PG8_SA(0, 1), cA + hsA, voffA);
        if (wr == 1) PG8_BAR;
        PG8_WAIT_V(4); PG8_BAR;
        PG8_STAGE(PG8_SB(1, 0), cB + kstep, voffB); PG8_STAGE(PG8_SA(1, 0), cA + kstep, voffA); PG8_STAGE(PG8_SB(1, 1), cB + hsB + kstep, voffB);
        PG8_WAIT_V(6); PG8_BAR;
    }
    for (;;) {
        const bool has_next = S.next(ui + 1, nxt);
        const char* nA = has_next ? (const char*)g.A + (size_t)nxt.pm * tsA + nxt.ka : cA; const char* nB = has_next ? (const char*)g.Bt + (size_t)nxt.pn * tsB : cB;
        for (int t = 0; t < nt; t += 2) {
            const bool last = (t == nt - 2);
            const char* a1 = cA + (size_t)(t + 1) * kstep;
            const char* a2 = last ? nA : cA + (size_t)(t + 2) * kstep; const char* b2 = last ? nB : cB + (size_t)(t + 2) * kstep;
            const char* a3 = a2 + kstep; const char* b3 = b2 + kstep;
            if (last && has_next) S.a_ready(nxt);
            if constexpr (SP2) {
            PG8_LDB(B0, 0, 0); PG8_LDB(B1, 0, 1); PG8_SCHED; PG8_LDA(At, 0, 0); PG8_STAGE(PG8_SA(1, 1), a1 + hsA, voffA);
            PG8_WAIT_V(8); PG8_WAIT_L(0); PG8_BAR; PG8_MMA(0, 0, At, B0); PG8_MMA(0, 1, At, B1); PG8_BAR; PG8_SCHED;
            PG8_LDA(At, 0, 1); PG8_STAGE(PG8_SB(0, 0), b2, voffB); PG8_STAGE(PG8_SB(0, 1), b2 + hsB, voffB); PG8_STAGE(PG8_SA(0, 0), a2, voffA);
            PG8_WAIT_V(8); PG8_WAIT_L(0); PG8_BAR; PG8_MMA(1, 0, At, B0); PG8_MMA(1, 1, At, B1); PG8_BAR; PG8_SCHED;
            PG8_LDB(B0, 1, 0); PG8_LDB(B1, 1, 1); PG8_SCHED; PG8_LDA(At, 1, 0); PG8_STAGE(PG8_SA(0, 1), a2 + hsA, voffA);
            PG8_WAIT_V(8); PG8_WAIT_L(0); PG8_BAR; PG8_MMA(0, 0, At, B0); PG8_MMA(0, 1, At, B1); PG8_BAR; PG8_SCHED;
            PG8_LDA(At, 1, 1); PG8_STAGE(PG8_SB(1, 0), b3, voffB); PG8_STAGE(PG8_SB(1, 1), b3 + hsB, voffB); PG8_STAGE(PG8_SA(1, 0), a3, voffA);
            PG8_WAIT_V(8); PG8_WAIT_L(0); PG8_BAR; PG8_MMA(1, 0, At, B0); PG8_MMA(1, 1, At, B1); PG8_BAR; PG8_SCHED;
            } else {
            PG8_LDB(B0, 0, 0); PG8_SCHED; PG8_LDA(At, 0, 0); PG8_STAGE(PG8_SA(1, 1), a1 + hsA, voffA);
            PG8_WAIT_L(8); PG8_BAR; PG8_WAIT_L(0); PG8_MMA(0, 0, At, B0); PG8_BAR; PG8_SCHED;
            PG8_LDB(B1, 0, 1); PG8_STAGE(PG8_SB(0, 0), b2, voffB);
            PG8_BAR; PG8_WAIT_L(0); PG8_MMA(0, 1, At, B1); PG8_BAR;
            PG8_LDA(At, 0, 1); PG8_STAGE(PG8_SA(0, 0), a2, voffA);
            PG8_BAR; PG8_WAIT_L(0); PG8_MMA(1, 0, At, B0); PG8_BAR; PG8_SCHED;
            PG8_STAGE(PG8_SB(0, 1), b2 + hsB, voffB);
            PG8_WAIT_V(6); PG8_BAR; PG8_MMA(1, 1, At, B1); PG8_BAR;
            PG8_LDB(B0, 1, 0); PG8_SCHED; PG8_LDA(At, 1, 0); PG8_STAGE(PG8_SA(0, 1), a2 + hsA, voffA);
            PG8_WAIT_L(8); PG8_BAR; PG8_WAIT_L(0); PG8_MMA(0, 0, At, B0); PG8_BAR; PG8_SCHED;
            PG8_LDB(B1, 1, 1); PG8_STAGE(PG8_SB(1, 0), b3, voffB);
            PG8_BAR; PG8_WAIT_L(0); PG8_MMA(0, 1, At, B1); PG8_BAR;
            PG8_LDA(At, 1, 1); PG8_STAGE(PG8_SA(1, 0), a3, voffA);
            PG8_BAR; PG8_WAIT_L(0); PG8_MMA(1, 0, At, B0); PG8_BAR; PG8_SCHED;
            PG8_STAGE(PG8_SB(1, 1), b3 + hsB, voffB);
            PG8_WAIT_V(6); PG8_BAR; PG8_MMA(1, 1, At, B1); PG8_BAR;
            }
        }
        if constexpr (ALIGN_EPI) { if (wr == 0) PG8_BAR; }
        if constexpr (!Epi::AFTER_DRAIN) { E(acc, cur, wr, wc, fr, fq); S.done(cur); }
        if (!has_next) break;
#pragma unroll
        for (int a = 0; a < 2; ++a)
#pragma unroll
            for (int b = 0; b < 2; ++b)
#pragma unroll
                for (int m = 0; m < 4; ++m)
#pragma unroll
                    for (int n = 0; n < 2; ++n) acc[a][b][m][n] = (f32x4){0.f, 0.f, 0.f, 0.f};
        cur = nxt; cA = nA; cB = nB; ++ui;
        if constexpr (ALIGN_EPI) { if (wr == 1) PG8_BAR; }
    }
    PG8_WAIT_V(0);
    if constexpr (!ALIGN_EPI) { if (wr == 0) PG8_BAR; }
    PG8_BAR;
    if constexpr (Epi::AFTER_DRAIN) { E.fused(acc, cur, wr, wc, fr, fq, lds, wid, lane); S.done(cur); }
#undef PG8_SA
#undef PG8_SB
#undef PG8_STAGE
#undef PG8_LDA
#undef PG8_LDB
#undef PG8_MMA
#undef PG8_WAIT_V
#undef PG8_WAIT_L
#undef PG8_BAR
#undef PG8_SCHED
}
}

using pg8::f32x2; using pg8::bf16_t; using pg8::bf16x8; using pg8::f32x4; using pg8::u32x4; using pg8::Unit; using pg8::cvt_pk_bf16;
#define LAS __attribute__((address_space(3)))
#define DI __device__ __forceinline__
typedef float f32x16 __attribute__((ext_vector_type(16)));
template <class T> DI T* opq(T* p) { asm volatile("" : "+s"(p)); return p; }
#define EPI_FENCE asm volatile("" ::: "memory")
typedef unsigned u32x2 __attribute__((ext_vector_type(2)));

constexpr int MTOK = 33280;
constexpr int MPROMPT = 32768;
constexpr int DM = 1024, DFF = 2816;
constexpr int NCHUNK16 = 2080;
constexpr int S5ROWS = 2304;
constexpr int S5LDA = 384;
constexpr float EPS = 1e-6f;

constexpr size_t MiB = 1u << 20;
constexpr size_t WS_AP = 0, WS_BBAR = 1 * MiB, WS_SP = 2 * MiB, WS_SH = 4 * MiB, WS_KC = 6 * MiB, WS_VC = 10 * MiB;
constexpr size_t WS_WGATEC = 14 * MiB;
constexpr size_t WS_RS = 14 * MiB + 512 * 1024;
constexpr size_t WS_WIN = 16 * MiB;
constexpr size_t WS_WOUT = 60 * MiB;
constexpr size_t WS_WPROJ = 82 * MiB, WS_WO = 87 * MiB, WS_WGLU = 89 * MiB, WS_WGATE = 93 * MiB, WS_BTE = 94 * MiB, WS_BTY = 102 * MiB;
constexpr size_t WS_XN = 114 * MiB;
constexpr size_t WS_SCR = 179 * MiB;
constexpr size_t HALF_MIB = MiB / 2;
constexpr size_t WS_HB = WS_SCR;
constexpr size_t WS_XA = WS_SCR, WS_Q = WS_SCR + 65 * HALF_MIB, WS_KB = WS_SCR + 130 * HALF_MIB, WS_VT = WS_SCR + 195 * HALF_MIB,
                 WS_GA = WS_SCR + 260 * HALF_MIB, WS_XC = WS_SCR + 325 * HALF_MIB, WS_MIX = WS_SCR + 390 * HALF_MIB;
constexpr size_t WS_AB = WS_SCR, WS_UB = WS_SCR + 65 * MiB;
constexpr size_t WS_A2 = WS_SCR, WS_E = WS_SCR + 108 * MiB, WS_Y = WS_SCR + 180 * MiB;
constexpr size_t WS_END = WS_SCR + 260 * MiB;

constexpr size_t O_Y = 0, O_PCONV = 34078720, O_PH = 34084864, O_PK = 34086912, O_PV = 35135488, O_PRE = 36184064, O_PIM = 36200448,
                 O_SCONV = 36216832, O_SH = 36229120, O_SK = 36233216, O_SV = 36495360, O_SRE = 36757504, O_SIM = 36790272;

constexpr int LDS_RING = 131072, LDS_ATTW = 18432  , LDS_BIAS = 147456, LDS_BYTES = 163840;

struct Params { const float* in[36]; float* out; unsigned char* ws; int ph_lo, ph_hi; };
typedef const __attribute__((address_space(4))) Params* KP;
DI KP get_kp() { KP p = (KP)__builtin_amdgcn_kernarg_segment_ptr(); asm volatile("" : "+s"(p)); return p; }

DI float bf2f(unsigned short b) { return __uint_as_float(((unsigned)b) << 16); }
DI float fexp(float x) { return __builtin_amdgcn_exp2f(x * 1.4426950408889634f); }
DI float sigmoidf_(float x) { return __builtin_amdgcn_rcpf(1.0f + fexp(-x)); }
DI float siluf_(float x) { return x * sigmoidf_(x); }
DI float gelu_tanh(float x) { const float y = 0.7978845608028654f * (x + 0.044715f * x * x * x); const float t = fexp(2.0f * y); const float th = 1.0f - 2.0f * __builtin_amdgcn_rcpf(t + 1.0f); return 0.5f * x * (1.0f + th); }
DI float wave_sum(float v) {
#pragma unroll
    for (int o = 1; o < 64; o <<= 1) v += __shfl_xor(v, o);
    return v;
}

struct EpiSwiGLU {
    static constexpr bool PERM = true, AFTER_DRAIN = false;
    bf16_t* O; const float* RS;
    DI void operator()(const f32x4 (&acc)[2][2][4][2], const Unit& u, int wr, int wc, int fr, int fq) const {
        const int row0 = u.pm * 256 + wr * 64 + fr, col0 = u.pn * 128 + wc * 32 + 8 * fq;
#pragma unroll
        for (int ai = 0; ai < 2; ++ai)
#pragma unroll
            for (int m = 0; m < 4; ++m) {
                bf16_t* p = O + (size_t)(row0 + ai * 128 + m * 16) * DFF + col0;
                const float rstd = RS ? rsqrtf(RS[row0 + ai * 128 + m * 16] * (1.0f / DM) + EPS) : 1.0f;
                const f32x4 g0 = acc[ai][0][m][0] * rstd, g1 = acc[ai][0][m][1] * rstd, u0 = acc[ai][1][m][0] * rstd, u1 = acc[ai][1][m][1] * rstd;
                u32x4 w;
                w.x = cvt_pk_bf16(siluf_(g0[0]) * u0[0], siluf_(g0[1]) * u0[1]); w.y = cvt_pk_bf16(siluf_(g0[2]) * u0[2], siluf_(g0[3]) * u0[3]);
                w.z = cvt_pk_bf16(siluf_(g1[0]) * u1[0], siluf_(g1[1]) * u1[1]); w.w = cvt_pk_bf16(siluf_(g1[2]) * u1[2], siluf_(g1[3]) * u1[3]);
                *(u32x4*)p = w; EPI_FENCE;
            }
    }
};
struct EpiResidual {
    static constexpr bool PERM = false, AFTER_DRAIN = false;
    float* X; float s; const float* Rp; const float* Rs; bf16_t* XB; float* RS;
    DI void operator()(const f32x4 (&acc)[2][2][4][2], const Unit& u, int wr, int wc, int fr, int fq) const {
        const int row0 = u.pm * 256 + wr * 64 + fr, col0 = u.pn * 256 + wc * 32 + 4 * fq;
        const float* R = (u.pm < 128) ? Rp : Rs - (size_t)MPROMPT * DM;
#pragma unroll
        for (int ai = 0; ai < 2; ++ai)
#pragma unroll
            for (int m = 0; m < 4; ++m) {
                const int row = row0 + ai * 128 + m * 16; const size_t off = (size_t)row * DM + col0;
#pragma unroll
                for (int bj = 0; bj < 2; ++bj)
#pragma unroll
                    for (int n = 0; n < 2; ++n) { const size_t o = off + bj * 128 + n * 16; f32x4 v = *(const f32x4*)(R + o); v = v + acc[ai][bj][m][n] * s; *(f32x4*)(X + o) = v;
 }
                if (m & 1) EPI_FENCE;
            }
    }
};
struct EpiGLU {
    static constexpr bool PERM = false, AFTER_DRAIN = false;
    float* X; bf16_t* XB; float* RS;
    DI void operator()(const f32x4 (&acc)[2][2][4][2], const Unit& u, int wr, int wc, int fr, int fq) const {
        const int row0 = u.pm * 256 + wr * 64 + fr, col0 = u.pn * 128 + wc * 32 + 4 * fq;
#pragma unroll
        for (int ai = 0; ai < 2; ++ai)
#pragma unroll
            for (int m = 0; m < 4; ++m) {
                const int row = row0 + ai * 128 + m * 16; const size_t off = (size_t)row * DM + col0;
#pragma unroll
                for (int n = 0; n < 2; ++n) { const size_t o = off + n * 16; f32x4 v = *(const f32x4*)(X + o); const f32x4 a = acc[ai][0][m][n], g = acc[ai][1][m][n];
                    v[0] += a[0] * sigmoidf_(g[0]); v[1] += a[1] * sigmoidf_(g[1]); v[2] += a[2] * sigmoidf_(g[2]); v[3] += a[3] * sigmoidf_(g[3]); *(f32x4*)(X + o) = v;
 }
                if (m & 1) EPI_FENCE;
            }
    }
};
struct EpiGate {
    static constexpr bool PERM = false, AFTER_DRAIN = false;
    const bf16_t* XC; float* AB; float* UB; const float *ba, *bx, *lam;
    DI void operator()(const f32x4 (&acc)[2][2][4][2], const Unit& u, int wr, int wc, int fr, int fq) const {
        const int row0 = u.pm * 256 + wr * 64 + fr, ch0 = u.pn * 128 + wc * 32 + 4 * fq;
#pragma unroll
        for (int n = 0; n < 2; ++n) {
            const int ch = ch0 + 16 * n;
            const f32x4 b_a = *(const f32x4*)(ba + ch), b_x = *(const f32x4*)(bx + ch), lm = *(const f32x4*)(lam + ch);
            f32x4 sp;
#pragma unroll
            for (int e = 0; e < 4; ++e) sp[e] = -8.0f * log1pf(expf(-lm[e]));
#pragma unroll
            for (int ai = 0; ai < 2; ++ai)
#pragma unroll
                for (int m = 0; m < 4; ++m) {
                    const size_t off = (size_t)(row0 + ai * 128 + m * 16) * 512 + ch;
                    const u32x2 xr = *(const u32x2*)(XC + off);
                    const float xc[4] = {__uint_as_float(xr.x << 16), __uint_as_float(xr.x & 0xffff0000u), __uint_as_float(xr.y << 16), __uint_as_float(xr.y & 0xffff0000u)};
                    const f32x4 rr = acc[ai][0][m][n] + b_a, ii = acc[ai][1][m][n] + b_x;
                    f32x4 av, uv;
#pragma unroll
                    for (int e = 0; e < 4; ++e) {
                        const float r = sigmoidf_(rr[e]), ig = sigmoidf_(ii[e]);
                        const float la = sp[e] * r;
                        const float a_ = fexp(la);
                        av[e] = a_;
                        uv[e] = __builtin_sqrtf(fmaxf(1.0f - a_ * a_, 0.0f)) * (ig * xc[e]);
                    }
                    *(f32x4*)(AB + off) = av; *(f32x4*)(UB + off) = uv; EPI_FENCE;
                }
        }
    }
};
struct EpiQKV {
    static constexpr bool PERM = true, AFTER_DRAIN = false;
    bf16_t *XA, *GA, *Q, *KB, *VT; float* out; const float *qg, *kg; const float* RS;
    DI void operator()(const f32x4 (&acc)[2][2][4][2], const Unit& u, int wr, int wc, int fr, int fq) const {
        const int pn = u.pn, row0 = u.pm * 256 + wr * 64 + fr;
        const bool needout = (u.pm >= 128) || ((u.pm & 31) >= 30);
        float* okb; float* ovb; int orow0;
        if (u.pm >= 128) { okb = out + O_SK; ovb = out + O_SV; orow0 = row0 - MPROMPT; }
        else { okb = out + O_PK; ovb = out + O_PV; orow0 = (u.pm >> 5) * 512 + ((u.pm & 31) - 30) * 256 + wr * 64 + fr; }
        if (pn < 4) {
            bf16_t* base = (pn < 2) ? XA : GA; const int col0 = (pn & 1) * 256 + wc * 32 + 8 * fq;
#pragma unroll
            for (int ai = 0; ai < 2; ++ai)
#pragma unroll
                for (int m = 0; m < 4; ++m)
#pragma unroll
                    for (int bj = 0; bj < 2; ++bj) {
                        const float rstd = RS ? rsqrtf(RS[row0 + ai * 128 + m * 16] * (1.0f / DM) + EPS) : 1.0f;
                        const f32x4 v0 = acc[ai][bj][m][0] * rstd, v1 = acc[ai][bj][m][1] * rstd; u32x4 w;
                        w.x = cvt_pk_bf16(v0[0], v0[1]); w.y = cvt_pk_bf16(v0[2], v0[3]); w.z = cvt_pk_bf16(v1[0], v1[1]); w.w = cvt_pk_bf16(v1[2], v1[3]);
                        *(u32x4*)(base + (size_t)(row0 + ai * 128 + m * 16) * 512 + col0 + bj * 128) = w; EPI_FENCE;
                    }
        } else if (pn < 8) {
            const bool isq = pn < 6; const int head = (pn & 1) * 4 + wc;
            const float* gp = isq ? qg : kg; const float gs = isq ? 0.125f : 1.0f;
            bf16_t* dst = isq ? Q : KB;
            f32x4 gn[2][2];
#pragma unroll
            for (int bj = 0; bj < 2; ++bj)
#pragma unroll
                for (int n = 0; n < 2; ++n) gn[bj][n] = *(const f32x4*)(gp + 32 * bj + 8 * fq + 4 * n);
#pragma unroll
            for (int ai = 0; ai < 2; ++ai)
#pragma unroll
                for (int m = 0; m < 4; ++m) {
                    float ss = 0.f;
                    const int rloc = ai * 128 + m * 16;
                    const float rstd = RS ? rsqrtf(RS[row0 + rloc] * (1.0f / DM) + EPS) : 1.0f;
#pragma unroll
                    for (int bj = 0; bj < 2; ++bj)
#pragma unroll
                        for (int n = 0; n < 2; ++n) { const f32x4 x = acc[ai][bj][m][n]; ss += (x[0] * x[0] + x[1] * x[1]) + (x[2] * x[2] + x[3] * x[3]); }
                    ss += __shfl_xor(ss, 16); ss += __shfl_xor(ss, 32);
                    const float rs = rstd * rsqrtf(ss * (rstd * rstd) * (1.0f / 64.0f) + EPS);
#pragma unroll
                    for (int bj = 0; bj < 2; ++bj) {
                        const f32x4 v0 = acc[ai][bj][m][0] * rs * gn[bj][0], v1 = acc[ai][bj][m][1] * rs * gn[bj][1];
                        u32x4 w; w.x = cvt_pk_bf16(v0[0] * gs, v0[1] * gs); w.y = cvt_pk_bf16(v0[2] * gs, v0[3] * gs); w.z = cvt_pk_bf16(v1[0] * gs, v1[1] * gs); w.w = cvt_pk_bf16(v1[2] * gs, v1[3] * gs);
                        *(u32x4*)(dst + (size_t)(row0 + rloc) * 512 + head * 64 + 32 * bj + 8 * fq) = w;
                        if (!isq && needout) { float* op = okb + (size_t)(orow0 + rloc) * 512 + head * 64 + 32 * bj + 8 * fq; *(f32x4*)op = v0; *(f32x4*)(op + 4) = v1; }
                    }
                    EPI_FENCE;
                }
        } else {
            const int col0 = (pn & 1) * 256 + wc * 32 + 8 * fq;
#pragma unroll
            for (int ai = 0; ai < 2; ++ai)
#pragma unroll
                for (int m = 0; m < 4; ++m) {
                    const int rloc = ai * 128 + m * 16;
#pragma unroll
                    for (int bj = 0; bj < 2; ++bj)
#pragma unroll
                        for (int n = 0; n < 2; ++n) {
                            const f32x4 v = acc[ai][bj][m][n] * (RS ? rsqrtf(RS[row0 + rloc] * (1.0f / DM) + EPS) : 1.0f); const int col = col0 + bj * 128 + 4 * n;
                            const unsigned p01 = cvt_pk_bf16(v[0], v[1]), p23 = cvt_pk_bf16(v[2], v[3]);
                            bf16_t* vp = VT + ((size_t)((row0 + rloc) >> 6) * 512 + col) * 64 + ((row0 + rloc) & 63);
                            vp[0] = (bf16_t)(p01 & 0xffffu); vp[64] = (bf16_t)(p01 >> 16); vp[128] = (bf16_t)(p23 & 0xffffu); vp[192] = (bf16_t)(p23 >> 16);
                            if (needout) *(f32x4*)(ovb + (size_t)(orow0 + rloc) * 512 + col) = v;
                        }
                    EPI_FENCE;
                }
        }
    }
};
struct EpiS5E {
    static constexpr bool PERM = false, AFTER_DRAIN = false;
    float* E;
    DI void operator()(const f32x4 (&acc)[2][2][4][2], const Unit& u, int wr, int wc, int fr, int fq) const {
        const int g = u.pn, ci0 = (u.pm - 9 * g) * 256 + wr * 64 + fr, col0 = wc * 32 + 4 * fq;
#pragma unroll
        for (int ai = 0; ai < 2; ++ai)
#pragma unroll
            for (int m = 0; m < 4; ++m) {
                const int ci = ci0 + ai * 128 + m * 16;
                if (ci < NCHUNK16) {
                    float* rp = E + ((size_t)g * S5ROWS + ci) * 128 + col0;
#pragma unroll
                    for (int n = 0; n < 2; ++n) *(f32x4*)(rp + 16 * n) = acc[ai][0][m][n];
                }
                EPI_FENCE;
            }
    }
};
struct EpiS5Y {
    static constexpr bool PERM = true, AFTER_DRAIN = false;
    bf16_t* Y;
    DI void operator()(const f32x4 (&acc)[2][2][4][2], const Unit& u, int wr, int wc, int fr, int fq) const {
        const int g = u.pn, ci0 = (u.pm - 9 * g) * 256 + wr * 64 + fr;
        bf16_t* yb = Y + (size_t)ci0 * (16 * DM) + (size_t)(wc * 2 + (fq >> 1)) * DM + 16 * g + 8 * (fq & 1);
#pragma unroll
        for (int ai = 0; ai < 2; ++ai)
#pragma unroll
            for (int m = 0; m < 4; ++m) {
                if (ci0 + ai * 128 + m * 16 < NCHUNK16) {
#pragma unroll
                    for (int bj = 0; bj < 2; ++bj) {
                        const f32x4 v0 = acc[ai][bj][m][0], v1 = acc[ai][bj][m][1]; u32x4 w;
                        w.x = cvt_pk_bf16(v0[0], v0[1]); w.y = cvt_pk_bf16(v0[2], v0[3]); w.z = cvt_pk_bf16(v1[0], v1[1]); w.w = cvt_pk_bf16(v1[2], v1[3]);
                        *(u32x4*)(yb + (size_t)(ai * 128 + m * 16) * (16 * DM) + (size_t)bj * (8 * DM)) = w;
                    }
                }
                EPI_FENCE;
            }
    }
};
struct GateOrder {
    pg8::StaticOrder S;
    DI bool next(int i, Unit& u) const { if (!S.next(i, u)) return false; u.ka = u.pn * 256; return true; }
    DI void a_ready(const Unit&) const {}
    DI void done(const Unit&) const {}
};
struct S5Order {
    int G, c;
    DI bool next(int i, Unit& u) const { const int L = i * G + c; if (L >= 512) return false; u.pn = L >> 3; u.pm = (L >> 3) * 9 + (L & 7); u.ka = 0; return true; }
    DI void a_ready(const Unit&) const {}
    DI void done(const Unit&) const {}
};

struct Ctx { int tid, lane, wave, gw, ngw, gtid, ngt; LAS unsigned char* lds; };

DI void transpose_item(const float* W, const float* gk, int K, int N, bf16_t* WT, int k0, int n0s, int n0d, LAS float* scr, int lane) {
    const float gl = gk ? gk[k0 + lane] : 1.0f;
    float r_[32];
#pragma unroll
    for (int i = 0; i < 32; ++i) r_[i] = W[(size_t)(k0 + 2 * i + (lane >> 5)) * N + n0s + (lane & 31)];
#pragma unroll
    for (int i = 0; i < 32; ++i) { const int kk = 2 * i + (lane >> 5); scr[kk * 33 + (lane & 31)] = r_[i] * __shfl(gl, kk); }
    asm volatile("s_waitcnt lgkmcnt(0)" ::: "memory");
    const int c = lane & 7;
#pragma unroll
    for (int j = 0; j < 4; ++j) { const int n = (lane >> 3) + 8 * j; const LAS float* s = scr + (8 * c) * 33 + n;
        u32x4 o; o.x = cvt_pk_bf16(s[0 * 33], s[1 * 33]); o.y = cvt_pk_bf16(s[2 * 33], s[3 * 33]); o.z = cvt_pk_bf16(s[4 * 33], s[5 * 33]); o.w = cvt_pk_bf16(s[6 * 33], s[7 * 33]);
        *(u32x4*)(WT + (size_t)(n0d + n) * K + k0 + 8 * c) = o; }
    asm volatile("s_waitcnt lgkmcnt(0)" ::: "memory");
}
DI int map_col(int kind, int N, int nd) {
    if (kind == 1) { const int pn = nd >> 8, bj = (nd >> 7) & 1, j = nd & 127; return bj * (N >> 1) + pn * 128 + j; }
    if (kind == 2 && nd >= 1024 && nd < 2048) { const int p = nd & 255, bj = p >> 7, wc = (p >> 5) & 3, j = p & 31; return (nd & ~255) + 64 * wc + 32 * bj + j; }
    return nd;
}
DI void convert_matrix_items(const Ctx& C, const float* W, const float* gk, int K, int N, bf16_t* WT, int kind, int& base) {
    const int nblk = N / 32, nitems = (K / 64) * nblk;
    LAS float* scr = (LAS float*)(C.lds + C.wave * 16384);
    int first = C.gw - (base % C.ngw); if (first < 0) first += C.ngw;
    for (int it = first; it < nitems; it += C.ngw) {
        const int kb = it / nblk, nb = it % nblk;
        transpose_item(W, gk, K, N, WT, 64 * kb, map_col(kind, N, 32 * nb), 32 * nb, scr, C.lane);
    }
    base += nitems;
}
DI void norm_row(const float* src, float* cpy, const float* g, bf16_t* XN, bf16_t* A2, int row, int lane) {
    const f32x4* xr = (const f32x4*)src + lane;
    f32x4 v[4]; float s = 0.f;
#pragma unroll
    for (int j = 0; j < 4; ++j) { v[j] = xr[64 * j]; s += (v[j][0] * v[j][0] + v[j][1] * v[j][1]) + (v[j][2] * v[j][2] + v[j][3] * v[j][3]); }
    if (cpy) {
#pragma unroll
        for (int j = 0; j < 4; ++j) ((f32x4*)cpy)[lane + 64 * j] = v[j];
    }
    const float rstd = rsqrtf(wave_sum(s) * (1.0f / DM) + EPS);
#pragma unroll
    for (int j = 0; j < 4; ++j) {
        const int col = 4 * lane + 256 * j; const f32x4 gg = g ? *(const f32x4*)(g + col) : (f32x4){1.f, 1.f, 1.f, 1.f};
        u32x2 w; w.x = cvt_pk_bf16(v[j][0] * rstd * gg[0], v[j][1] * rstd * gg[1]); w.y = cvt_pk_bf16(v[j][2] * rstd * gg[2], v[j][3] * rstd * gg[3]);
        if (XN) *(u32x2*)(XN + (size_t)row * DM + col) = w;
        else { const int grp = col >> 4, cc = col & 15, chunk = row >> 4, jj = row & 15; *(u32x2*)(A2 + ((size_t)grp * S5ROWS + chunk) * S5LDA + 128 + jj * 16 + cc) = w; }
    }
}
DI void norm_store(const f32x4 (&v)[4], float rstd, const float* g, bf16_t* XN, bf16_t* A2, int row, int lane) {
#pragma unroll
    for (int j = 0; j < 4; ++j) {
        const int col = 4 * lane + 256 * j; const f32x4 gg = g ? *(const f32x4*)(g + col) : (f32x4){1.f, 1.f, 1.f, 1.f};
        u32x2 w; w.x = cvt_pk_bf16(v[j][0] * rstd * gg[0], v[j][1] * rstd * gg[1]); w.y = cvt_pk_bf16(v[j][2] * rstd * gg[2], v[j][3] * rstd * gg[3]);
        if (XN) *(u32x2*)(XN + (size_t)row * DM + col) = w;
        else { const int grp = col >> 4, cc = col & 15, chunk = row >> 4, jj = row & 15; *(u32x2*)(A2 + ((size_t)grp * S5ROWS + chunk) * S5LDA + 128 + jj * 16 + cc) = w; }
    }
}
DI void norm_phase(const Ctx& C, float* X, const float* g, bf16_t* XN, bf16_t* A2) {
    for (int row = C.gw; row < MTOK; row += 2 * C.ngw) {
        const int row2 = row + C.ngw; const bool has2 = row2 < MTOK;
        f32x4 v0[4], v1[4]; float s0 = 0.f, s1 = 0.f;
        const f32x4* x0 = (const f32x4*)(X + (size_t)row * DM) + C.lane; const f32x4* x1 = (const f32x4*)(X + (size_t)(has2 ? row2 : row) * DM) + C.lane;
#pragma unroll
        for (int j = 0; j < 4; ++j) { v0[j] = x0[64 * j]; v1[j] = x1[64 * j]; }
#pragma unroll
        for (int j = 0; j < 4; ++j) { s0 += (v0[j][0] * v0[j][0] + v0[j][1] * v0[j][1]) + (v0[j][2] * v0[j][2] + v0[j][3] * v0[j][3]); s1 += (v1[j][0] * v1[j][0] + v1[j][1] * v1[j][1]) + (v1[j][2] * v1[j][2] + v1[j][3] * v1[j][3]); }
        const float r0 = rsqrtf(wave_sum(s0) * (1.0f / DM) + EPS), r1 = rsqrtf(wave_sum(s1) * (1.0f / DM) + EPS);
        norm_store(v0, r0, g, XN, A2, row, C.lane);
        if (has2) norm_store(v1, r1, g, XN, A2, row2, C.lane);
    }
}

#define XB_TMO      128
#define XB_XCNT(j)  (256  + 64 * (j))
#define XB_XSUB(j)  (1280 + 64 * (j))
#define XB_XGEN(j)  (2304 + 64 * (j))
#define XB_TOP      3328
#define XB_TOPGEN   3392
#define XCD_BAR_WORDS 3456
#define XB_SPIN_CAP (1u << 18)

__device__ __forceinline__ unsigned xb_ld(unsigned* p)              { return __hip_atomic_load(p, __ATOMIC_RELAXED, __HIP_MEMORY_SCOPE_AGENT); }
__device__ __forceinline__ unsigned xb_add(unsigned* p, unsigned v) { return __hip_atomic_fetch_add(p, v, __ATOMIC_RELAXED, __HIP_MEMORY_SCOPE_AGENT); }
__device__ __forceinline__ unsigned xb_xcc_id() { return (unsigned)__builtin_amdgcn_s_getreg((3 << 11) | 20) & 0xFu; }
#define XB_SPIN(cond, bar) do { unsigned _sp = 0; while (cond) { __builtin_amdgcn_s_sleep(1); \
    if ((++_sp & 255u) == 0u) { if (xb_ld(&(bar)[XB_TMO])) break; if (_sp > XB_SPIN_CAP) { atomicAdd(&(bar)[XB_TMO], 1u); break; } } } } while (0)

struct XcdBarrier {
    unsigned* bar; unsigned x;
    volatile LAS unsigned* st;
};

__device__ __forceinline__ XcdBarrier xcd_barrier_post(unsigned* bar, volatile LAS unsigned* st) {
    XcdBarrier b; b.bar = bar; b.x = xb_xcc_id(); b.st = st;
    if (threadIdx.x == 0) (void)xb_add(&bar[XB_XCNT(b.x)], 1u);
    return b;
}
__device__ __forceinline__ void xcd_barrier_complete(unsigned* bar, unsigned x, unsigned& nloc, unsigned& nx) {
    const unsigned G = gridDim.x * gridDim.y * gridDim.z;
    unsigned sum, cnt, mine, sp = 0u;
    for (;;) {
        sum = 0u; cnt = 0u; mine = 0u;
#pragma unroll
        for (unsigned j = 0; j < 16; ++j) { const unsigned c = xb_ld(&bar[XB_XCNT(j)]); sum += c; cnt += (c > 0u) ? 1u : 0u; mine = (j == x) ? c : mine; }
        if (sum == G) break;
        __builtin_amdgcn_s_sleep(1);
        if ((++sp & 255u) == 0u) { if (xb_ld(&bar[XB_TMO])) break; if (sp > XB_SPIN_CAP) { atomicAdd(&bar[XB_TMO], 1u); break; } }
    }
    nloc = mine > 0u ? mine : 1u; nx = cnt > 0u ? cnt : 1u;
}

__device__ __forceinline__ void xcd_barrier(const XcdBarrier& b) {
    asm volatile("s_waitcnt vmcnt(0)" ::: "memory");
    __syncthreads();
    if (threadIdx.x == 0) {
        unsigned* bar = b.bar;
        __builtin_amdgcn_s_waitcnt(0);
        unsigned nloc = b.st[0], nx = b.st[1];
        if (nloc == 0u) { xcd_barrier_complete(bar, b.x, nloc, nx); b.st[0] = nloc; b.st[1] = nx; }
        const unsigned old = xb_add(&bar[XB_XSUB(b.x)], 1u);
        const unsigned gen = old / nloc;
        if (old + 1u == (gen + 1u) * nloc) {
            __builtin_amdgcn_fence(__ATOMIC_RELEASE, "agent");
            asm volatile("s_waitcnt vmcnt(0)" ::: "memory");
            const unsigned og = xb_add(&bar[XB_TOP], 1u);
            const unsigned tg = og / nx;
            if (og + 1u == (tg + 1u) * nx) xb_add(&bar[XB_TOPGEN], 1u);
            else XB_SPIN(xb_ld(&bar[XB_TOPGEN]) == tg, bar);
            __builtin_amdgcn_fence(__ATOMIC_ACQUIRE, "agent");
            xb_add(&bar[XB_XGEN(b.x)], 1u);
            asm volatile("s_waitcnt vmcnt(0)" ::: "memory");
        } else {
            XB_SPIN(xb_ld(&bar[XB_XGEN(b.x)]) == gen, bar);
            __builtin_amdgcn_fence(__ATOMIC_ACQUIRE, "agent");
            asm volatile("s_waitcnt vmcnt(0)" ::: "memory");
        }
    }
    __syncthreads();
}

constexpr size_t WS_BARW = 1 * MiB + 768 * 1024;
constexpr int LDS_BARST = LDS_BIAS + 8704;
DI void grid_barrier(KP kp, LAS unsigned char* lds) {
    XcdBarrier b; b.bar = (unsigned*)(opq((unsigned char*)kp->ws) + WS_BARW); b.x = xb_xcc_id(); b.st = (volatile LAS unsigned*)(lds + LDS_BARST);
    xcd_barrier(b);
}

DI void p0_row(const float* src, bf16_t* XB, float* RSrow, int lane) {
    const f32x4* xr = (const f32x4*)src + lane; float s = 0.f;
#pragma unroll
    for (int j = 0; j < 4; ++j) { const f32x4 v = xr[64 * j]; s += (v[0] * v[0] + v[1] * v[1]) + (v[2] * v[2] + v[3] * v[3]);
        u32x2 w; w.x = cvt_pk_bf16(v[0], v[1]); w.y = cvt_pk_bf16(v[2], v[3]); *(u32x2*)(XB + 4 * lane + 256 * j) = w; }
    s = wave_sum(s); if (lane == 0) *RSrow = s;
}

DI void stat_phase(const Ctx& C, const float* X, bf16_t* XB, float* RS) {
    for (int row = C.gw; row < MTOK; row += C.ngw) p0_row(X + (size_t)row * DM, XB + (size_t)row * DM, RS + row, C.lane);
}

DI void p0_phase(const Ctx& C, KP kp) {
    unsigned char* ws = opq(kp->ws);
    int base = 0;
    for (int l = 0; l < 2; ++l) {
        convert_matrix_items(C, kp->in[9] + (size_t)l * DM * 2 * DFF, kp->in[8] + l * DM, DM, 2 * DFF, (bf16_t*)(ws + WS_WIN + (size_t)(2 * l) * 11 * MiB), 1, base);
        convert_matrix_items(C, kp->in[13] + (size_t)l * DM * 2 * DFF, kp->in[12] + l * DM, DM, 2 * DFF, (bf16_t*)(ws + WS_WIN + (size_t)(2 * l + 1) * 11 * MiB), 1, base);
        convert_matrix_items(C, kp->in[10] + (size_t)l * DFF * DM, nullptr, DFF, DM, (bf16_t*)(ws + WS_WOUT + (size_t)(2 * l) * 11 * HALF_MIB), 0, base);
        convert_matrix_items(C, kp->in[14] + (size_t)l * DFF * DM, nullptr, DFF, DM, (bf16_t*)(ws + WS_WOUT + (size_t)(2 * l + 1) * 11 * HALF_MIB), 0, base);
    }
    convert_matrix_items(C, kp->in[15], kp->in[11], DM, 2560, (bf16_t*)(ws + WS_WPROJ), 2, base);
    convert_matrix_items(C, kp->in[26], nullptr, DM, DM, (bf16_t*)(ws + WS_WO), 0, base);
    convert_matrix_items(C, kp->in[35], nullptr, DM, 2048, (bf16_t*)(ws + WS_WGLU), 1, base);
    {
        bf16_t* XB = (bf16_t*)(ws + WS_XN);
        for (int row = C.gw; row < MTOK; row += C.ngw) {
            const float* src = row < MPROMPT ? kp->in[0] + (size_t)row * DM : kp->in[1] + (size_t)(row - MPROMPT) * DM;
            norm_row(src, nullptr, nullptr, XB, nullptr, row, C.lane);
        }
    }
    {
        bf16_t* WG = (bf16_t*)(ws + WS_WGATE); const float* wa = kp->in[18]; const float* wx = kp->in[20];
        for (int idx = C.gtid; idx < 1024 * 512 / 2; idx += C.ngt) {
            const int nd = idx >> 8, k = (idx & 255) * 2;
            const int pn = nd >> 8, bj = (nd >> 7) & 1, j = nd & 127, ch = pn * 128 + j, hb = ch >> 6, jj = ch & 63;
            float v0 = 0.f, v1 = 0.f;
            if ((k >> 6) == hb) { const float* w = bj ? wx : wa; v0 = w[((size_t)hb * 64 + (k & 63)) * 64 + jj]; v1 = w[((size_t)hb * 64 + (k & 63) + 1) * 64 + jj]; }
            *(unsigned*)(WG + (size_t)nd * 512 + k) = cvt_pk_bf16(v0, v1);
        }
    }
    {
        bf16_t* WGC = (bf16_t*)(ws + WS_WGATEC); const float* wa = kp->in[18]; const float* wx = kp->in[20];
        for (int idx = C.gtid; idx < 1024 * 128 / 2; idx += C.ngt) {
            const int nd = idx >> 6, k = (idx & 63) * 2;
            const int pn = nd >> 8, bj = (nd >> 7) & 1, j = nd & 127, ch = pn * 128 + j, hb = ch >> 6, jj = ch & 63;
            float v0 = 0.f, v1 = 0.f;
            if ((k >> 6) == (hb & 1)) { const float* w = bj ? wx : wa; v0 = w[((size_t)hb * 64 + (k & 63)) * 64 + jj]; v1 = w[((size_t)hb * 64 + (k & 63) + 1) * 64 + jj]; }
            *(unsigned*)(WGC + (size_t)nd * 128 + k) = cvt_pk_bf16(v0, v1);
        }
    }
    {
        bf16_t* KC = (bf16_t*)(ws + WS_KC); bf16_t* VC = (bf16_t*)(ws + WS_VC); const float* ck = kp->in[4]; const float* cv = kp->in[5];
        for (int idx = C.gtid; idx < 8 * 512 * 512 / 2; idx += C.ngt) {
            const f32x2 v = *(const f32x2*)(ck + (size_t)idx * 2); *(unsigned*)(KC + (size_t)idx * 2) = cvt_pk_bf16(v[0], v[1]);
        }
        for (int idx = C.gtid; idx < 8 * 512 * 512 / 2; idx += C.ngt) {
            const int b = idx >> 17, col = (idx >> 8) & 511, pos = (idx & 255) * 2;
            const float v0 = cv[((size_t)b * 512 + pos) * 512 + col], v1 = cv[((size_t)b * 512 + pos + 1) * 512 + col];
            *(unsigned*)(VC + ((size_t)(b * 8 + (pos >> 6)) * 512 + col) * 64 + (pos & 63)) = cvt_pk_bf16(v0, v1);
        }
    }
    {
        f32x2* AP = (f32x2*)(ws + WS_AP); f32x2* BB = (f32x2*)(ws + WS_BBAR);
        const float* Are = kp->in[27]; const float* Aim = kp->in[28]; const float* Bre = kp->in[29]; const float* Bim = kp->in[30]; const float* ldt = kp->in[34];
        for (int idx = C.gtid; idx < 4096; idx += C.ngt) {
            const int g = idx >> 6; const float dt = expf(ldt[g]); const float ar = Are[idx], ai = Aim[idx];
            f32x2 a1 = {0.f, 0.f};
            for (int e = 0; e <= 16; ++e) {
                const float mag = expf((float)e * ar * dt); float sn, cs; sincosf((float)e * ai * dt, &sn, &cs);
                const f32x2 v = {mag * cs, mag * sn}; AP[idx * 17 + e] = v; if (e == 1) a1 = v;
            }
            const float nr = a1[0] - 1.0f, ni = a1[1], den = 1.0f / (ar * ar + ai * ai);
            const float cr = (nr * ar + ni * ai) * den, ci = (ni * ar - nr * ai) * den;
            for (int ch = 0; ch < 16; ++ch) { const float br = Bre[idx * 16 + ch], bi = Bim[idx * 16 + ch]; const f32x2 v = {cr * br - ci * bi, cr * bi + ci * br}; BB[idx * 16 + ch] = v; }
        }
    }
}
DI void s5_fill_phase(const Ctx& C, KP kp) {
    unsigned char* ws = opq(kp->ws);
    const f32x2* AP = (const f32x2*)(ws + WS_AP); const f32x2* BB = (const f32x2*)(ws + WS_BBAR);
    bf16_t* BTE = (bf16_t*)(ws + WS_BTE); bf16_t* BTY = (bf16_t*)(ws + WS_BTY);
    const float* Cre = kp->in[31]; const float* Cim = kp->in[32]; const float* Dsk = kp->in[33];
    for (int idx = C.gtid; idx < 64 * 256 * 256; idx += C.ngt) {
        const int g = idx >> 16, n = (idx >> 8) & 255, k = idx & 255;
        float val = 0.f;
        if (n < 128) { const int p = n & 63, j = k >> 4, ch = k & 15; const f32x2 a = AP[(g * 64 + p) * 17 + (15 - j)], b = BB[(g * 64 + p) * 16 + ch];
            val = (n < 64) ? (a[0] * b[0] - a[1] * b[1]) : (a[0] * b[1] + a[1] * b[0]); }
        BTE[idx] = (bf16_t)(cvt_pk_bf16(val, 0.f) & 0xffffu);
    }
    for (int idx = C.gtid; idx < 64 * 256 * 128; idx += C.ngt) {
        const int g = idx >> 15, n = (idx >> 7) & 255, k = idx & 127, i = n >> 4, o = n & 15, p = k & 63;
        const f32x2 a = AP[(g * 64 + p) * 17 + (i + 1)]; const float cr = Cre[((size_t)g * 16 + o) * 64 + p], ci = Cim[((size_t)g * 16 + o) * 64 + p];
        const float val = (k < 64) ? (cr * a[0] - ci * a[1]) : -(cr * a[1] + ci * a[0]);
        BTY[((size_t)g * 256 + n) * 384 + k] = (bf16_t)(cvt_pk_bf16(val, 0.f) & 0xffffu);
    }
    for (int idx = C.gtid; idx < 64 * 31 * 256; idx += C.ngt) {
        const int ch = idx & 15, o = (idx >> 4) & 15, t = idx >> 8, dd = t % 31, g = t / 31, d = dd - 15;
        if (d >= 0) {
            float T = 0.f;
            for (int p = 0; p < 64; ++p) {
                const f32x2 a = AP[(g * 64 + p) * 17 + d], b = BB[(g * 64 + p) * 16 + ch];
                const float cr = Cre[((size_t)g * 16 + o) * 64 + p], ci = Cim[((size_t)g * 16 + o) * 64 + p];
                const float abr = a[0] * b[0] - a[1] * b[1], abi = a[0] * b[1] + a[1] * b[0];
                T += cr * abr - ci * abi;
            }
            if (d == 0 && o == ch) T += Dsk[g * 16 + o];
            const bf16_t tv = (bf16_t)(cvt_pk_bf16(T, 0.f) & 0xffffu);
            for (int i = d; i < 16; ++i) BTY[((size_t)g * 256 + i * 16 + o) * 384 + 128 + (i - d) * 16 + ch] = tv;
        } else {
            for (int j = -d; j < 16; ++j) BTY[((size_t)g * 256 + (j + d) * 16 + o) * 384 + 128 + j * 16 + ch] = (bf16_t)0;
        }
    }
}
DI void conv_phase(const Ctx& C, KP kp) {
    unsigned char* ws = opq(kp->ws);
    const bf16_t* XA = (const bf16_t*)(ws + WS_XA); bf16_t* XC = (bf16_t*)(ws + WS_XC);
    const float* cw = kp->in[16]; const float* cb = kp->in[17]; const float* st = kp->in[2];
    for (int idx = C.gtid; idx < (MTOK / 8) * 64; idx += C.ngt) {
        const int row0 = (idx >> 6) * 8, c8 = (idx & 63) * 8;
        int t0, b; const bool smp = row0 >= MPROMPT;
        if (smp) { const int r = row0 - MPROMPT; b = r >> 6; t0 = r & 63; } else { b = row0 >> 13; t0 = row0 & 8191; }
        u32x4 raw[11];
#pragma unroll
        for (int j = 0; j < 11; ++j) { raw[j] = (u32x4){0u, 0u, 0u, 0u}; if (t0 - 3 + j >= 0) raw[j] = *(const u32x4*)(XA + (size_t)(row0 - 3 + j) * 512 + c8); }
        float xf[11][8];
#pragma unroll
        for (int j = 0; j < 11; ++j) { const u32x4 r = raw[j];
            xf[j][0] = __uint_as_float(r.x << 16); xf[j][1] = __uint_as_float(r.x & 0xffff0000u); xf[j][2] = __uint_as_float(r.y << 16); xf[j][3] = __uint_as_float(r.y & 0xffff0000u);
            xf[j][4] = __uint_as_float(r.z << 16); xf[j][5] = __uint_as_float(r.z & 0xffff0000u); xf[j][6] = __uint_as_float(r.w << 16); xf[j][7] = __uint_as_float(r.w & 0xffff0000u); }
        if (smp && t0 == 0) {
#pragma unroll
            for (int j = 0; j < 3; ++j) { const float* sp = st + ((size_t)b * 3 + j) * 512 + c8; const f32x4 s0 = *(const f32x4*)sp, s1 = *(const f32x4*)(sp + 4);
                xf[j][0] = s0[0]; xf[j][1] = s0[1]; xf[j][2] = s0[2]; xf[j][3] = s0[3]; xf[j][4] = s1[0]; xf[j][5] = s1[1]; xf[j][6] = s1[2]; xf[j][7] = s1[3]; }
        }
        float wgt[4][8], bias[8];
#pragma unroll
        for (int k = 0; k < 4; ++k) { const f32x4 w0 = *(const f32x4*)(cw + k * 512 + c8), w1 = *(const f32x4*)(cw + k * 512 + c8 + 4);
            wgt[k][0] = w0[0]; wgt[k][1] = w0[1]; wgt[k][2] = w0[2]; wgt[k][3] = w0[3]; wgt[k][4] = w1[0]; wgt[k][5] = w1[1]; wgt[k][6] = w1[2]; wgt[k][7] = w1[3]; }
        { const f32x4 b0 = *(const f32x4*)(cb + c8), b1 = *(const f32x4*)(cb + c8 + 4); bias[0] = b0[0]; bias[1] = b0[1]; bias[2] = b0[2]; bias[3] = b0[3]; bias[4] = b1[0]; bias[5] = b1[1]; bias[6] = b1[2]; bias[7] = b1[3]; }
#pragma unroll
        for (int r = 0; r < 8; ++r) {
            float a[8];
#pragma unroll
            for (int e2 = 0; e2 < 8; ++e2) { float v = bias[e2];
#pragma unroll
                for (int k = 0; k < 4; ++k) v += xf[r + k][e2] * wgt[k][e2];
                a[e2] = v; }
            u32x4 w; w.x = cvt_pk_bf16(a[0], a[1]); w.y = cvt_pk_bf16(a[2], a[3]); w.z = cvt_pk_bf16(a[4], a[5]); w.w = cvt_pk_bf16(a[6], a[7]);
            *(u32x4*)(XC + (size_t)(row0 + r) * 512 + c8) = w;
        }
        const int S = smp ? 64 : 8192;
        if (t0 + 8 == S) {
            float* op = (smp ? kp->out + O_SCONV : kp->out + O_PCONV) + (size_t)b * 3 * 512 + c8;
#pragma unroll
            for (int j = 0; j < 3; ++j) { *(f32x4*)(op + j * 512) = (f32x4){xf[8 + j][0], xf[8 + j][1], xf[8 + j][2], xf[8 + j][3]}; *(f32x4*)(op + j * 512 + 4) = (f32x4){xf[8 + j][4], xf[8 + j][5], xf[8 + j][6], xf[8 + j][7]}; }
        }
    }
}
#define MFMA32(a, b, c) __builtin_amdgcn_mfma_f32_32x32x16_bf16((a), (b), (c), 0, 0, 0)
DI int crow(int reg, int h) { return (reg & 3) + 8 * (reg >> 2) + 4 * h; }
DI bf16x8 pack_step(const f32x16& x, int s) {
    u32x4 p; p.x = cvt_pk_bf16(x[8 * s], x[8 * s + 1]); p.y = cvt_pk_bf16(x[8 * s + 2], x[8 * s + 3]); p.z = cvt_pk_bf16(x[8 * s + 4], x[8 * s + 5]); p.w = cvt_pk_bf16(x[8 * s + 6], x[8 * s + 7]);
    return __builtin_bit_cast(bf16x8, p);
}
DI void attn_tile_ptrs(int cs, int jt, int qrow0, int h, const bf16_t* KB, const bf16_t* VT, const bf16_t* KC, const bf16_t* VC, const char*& Kpc, const char*& Vpc) {
    if (cs < 512 || jt == 8) { const int krow = qrow0 - (8 - jt) * 64; Kpc = (const char*)(KB + (size_t)krow * 512 + h * 64); Vpc = (const char*)(VT + ((size_t)(krow >> 6) * 512 + h * 64) * 64); }
    else { const int b = cs - 512; Kpc = (const char*)(KC + ((size_t)b * 512 + jt * 64) * 512 + h * 64); Vpc = (const char*)(VC + ((size_t)(b * 8 + jt) * 512 + h * 64) * 64); }
}
DI void attn_phase(const Ctx& C, KP kp) {
    unsigned char* ws = opq(kp->ws);
    const bf16_t* Q = (const bf16_t*)(ws + WS_Q); const bf16_t* KB = (const bf16_t*)(ws + WS_KB); const bf16_t* VT = (const bf16_t*)(ws + WS_VT);
    const bf16_t* KC = (const bf16_t*)(ws + WS_KC); const bf16_t* VC = (const bf16_t*)(ws + WS_VC); bf16_t* MIX = (bf16_t*)(ws + WS_MIX);
    LAS float* bt = (LAS float*)(C.lds + LDS_BIAS);
    for (int i = C.tid; i < 257 * 8; i += 512) { const int r = i >> 3, h = i & 7; bt[h * 257 + r] = kp->in[25][i]; }
    __syncthreads();
    const int l31 = C.lane & 31, hh = C.lane >> 5;
    LAS unsigned char* kbuf = C.lds + C.wave * LDS_ATTW;
    LAS unsigned char* vbuf = kbuf + 9216;
    const unsigned kvoff = (unsigned)((C.lane >> 3) * 1024 + (C.lane & 7) * 16), vvoff = (unsigned)C.lane * 16u, loff = (unsigned)((C.lane >> 3) * 144 + (C.lane & 7) * 16);
    for (int id = C.gw; id < 8320; id += C.ngw) {
        const int qt = id & 1, wv = id >> 1;
        int h, cs;
        if (wv < 64) { h = wv & 7; cs = 512 + (wv >> 3); }
        else if (wv < 4096) { const int j = wv - 64, q = j >> 3; h = j & 7; cs = (q / 126) * 128 + 2 + (q % 126); }
        else { const int j = wv - 4096, q = j >> 3; h = j & 7; cs = (q >> 1) * 128 + (q & 1); }
        const int qrow0 = cs * 64;
        int jt0 = 0;
        if (cs < 512) { const int c = cs & 127; jt0 = c >= 8 ? 0 : 8 - c; }
        bf16x8 qf[4];
#pragma unroll
        for (int ks = 0; ks < 4; ++ks) qf[ks] = *(const bf16x8*)(Q + (size_t)(qrow0 + 32 * qt + l31) * 512 + h * 64 + 16 * ks + 8 * hh);
        f32x16 O[2];
#pragma unroll
        for (int a = 0; a < 2; ++a)
#pragma unroll
            for (int r = 0; r < 16; ++r) O[a][r] = 0.f;
        float mrun = -1e30f, lsum = 0.f;
        const LAS float* bth = bt + h * 257;
        const float cfar = bth[256];
        u32x4 kr[8], vr[8];
        { const char* Kpc; const char* Vpc; attn_tile_ptrs(cs, jt0, qrow0, h, KB, VT, KC, VC, Kpc, Vpc);
#pragma unroll
          for (int i = 0; i < 8; ++i) { kr[i] = *(const u32x4*)(Kpc + (kvoff + (unsigned)i * 8192u)); vr[i] = *(const u32x4*)(Vpc + (vvoff + (unsigned)i * 1024u)); } }
        for (int jt = jt0; jt < 9; ++jt) {
#pragma unroll
            for (int i = 0; i < 8; ++i) *(LAS u32x4*)(kbuf + loff + i * 1152) = kr[i];
#pragma unroll
            for (int i = 0; i < 8; ++i) *(LAS u32x4*)(vbuf + loff + i * 1152) = vr[i];
            if (jt < 8) { const char* Kpc; const char* Vpc; attn_tile_ptrs(cs, jt + 1, qrow0, h, KB, VT, KC, VC, Kpc, Vpc);
#pragma unroll
                for (int i = 0; i < 8; ++i) { kr[i] = *(const u32x4*)(Kpc + (kvoff + (unsigned)i * 8192u)); vr[i] = *(const u32x4*)(Vpc + (vvoff + (unsigned)i * 1024u)); } }
            f32x16 S[2];
#pragma unroll
            for (int kt = 0; kt < 2; ++kt) {
                f32x16 acc;
#pragma unroll
                for (int r = 0; r < 16; ++r) acc[r] = 0.f;
#pragma unroll
                for (int ks = 0; ks < 4; ++ks) { const bf16x8 kf = *(const LAS bf16x8*)(kbuf + (32 * kt + l31) * 144 + 32 * ks + 16 * hh); acc = MFMA32(kf, qf[ks], acc); }
                S[kt] = acc;
            }
            const int dd = 8 - jt;
            if (dd >= 3) {
#pragma unroll
                for (int kt = 0; kt < 2; ++kt)
#pragma unroll
                    for (int r = 0; r < 16; ++r) S[kt][r] += cfar;
            } else {
                int qk0 = l31 + 32 * qt - 4 * hh + 64 * dd; asm volatile("" : "+v"(qk0));
#pragma unroll
                for (int kt = 0; kt < 2; ++kt)
#pragma unroll
                    for (int r = 0; r < 16; ++r) { const int rel = qk0 - 32 * kt - ((r & 3) + 8 * (r >> 2)); const int ix = (rel > 128 ? 128 : rel) + 128; S[kt][r] += bth[ix]; }
            }
            {
                float mx = S[0][0];
#pragma unroll
                for (int r = 1; r < 16; ++r) mx = fmaxf(mx, S[0][r]);
#pragma unroll
                for (int r = 0; r < 16; ++r) mx = fmaxf(mx, S[1][r]);
                mx = fmaxf(mx, __shfl_xor(mx, 32));
                const float mn = fmaxf(mrun, mx), alpha = fexp(mrun - mn); mrun = mn;
                float ps = 0.f;
#pragma unroll
                for (int kt = 0; kt < 2; ++kt)
#pragma unroll
                    for (int r = 0; r < 16; ++r) { const float p = fexp(S[kt][r] - mn); S[kt][r] = p; ps += p; }
                lsum = lsum * alpha + ps;
#pragma unroll
                for (int dt = 0; dt < 2; ++dt)
#pragma unroll
                    for (int r = 0; r < 16; ++r) O[dt][r] *= alpha;
            }
#pragma unroll
            for (int kt = 0; kt < 2; ++kt)
#pragma unroll
                for (int s = 0; s < 2; ++s) {
                    const bf16x8 pf = pack_step(S[kt], s);
#pragma unroll
                    for (int dt = 0; dt < 2; ++dt) {
                        const LAS unsigned char* vp = vbuf + (32 * dt + l31) * 144 + (32 * kt + 16 * s + 4 * hh) * 2;
                        const u32x2 lo = *(const LAS u32x2*)vp, hi = *(const LAS u32x2*)(vp + 16);
                        u32x4 w; w.x = lo.x; w.y = lo.y; w.z = hi.x; w.w = hi.y;
                        O[dt] = MFMA32(__builtin_bit_cast(bf16x8, w), pf, O[dt]);
                    }
                }
        }
        {
            const float lt = lsum + __shfl_xor(lsum, 32), inv = 1.0f / lt;
            bf16_t* op = MIX + (size_t)(qrow0 + 32 * qt + l31) * DM + 512 + h * 64;
#pragma unroll
            for (int dt = 0; dt < 2; ++dt)
#pragma unroll
                for (int g4 = 0; g4 < 4; ++g4) {
                    u32x2 w; w.x = cvt_pk_bf16(O[dt][4 * g4] * inv, O[dt][4 * g4 + 1] * inv); w.y = cvt_pk_bf16(O[dt][4 * g4 + 2] * inv, O[dt][4 * g4 + 3] * inv);
                    *(u32x2*)(op + 32 * dt + 8 * g4 + 4 * hh) = w;
                }
        }
    }
}
DI void scan_a_phase(const Ctx& C, KP kp) {
    unsigned char* ws = opq(kp->ws); const float* AB = (const float*)(ws + WS_AB); const float* UB = (const float*)(ws + WS_UB);
    float* SP = (float*)(ws + WS_SP); float* SHs = (float*)(ws + WS_SH);
    for (int idx = C.gtid; idx < 520 * 512; idx += C.ngt) {
        const int ch = idx & 511, cs = idx >> 9; const size_t o0 = (size_t)cs * 64 * 512 + ch;
        float pp = 1.f, hv = 0.f;
#pragma unroll 1
        for (int t0 = 0; t0 < 64; t0 += 32) {
            float a[32], u[32];
#pragma unroll
            for (int i = 0; i < 32; ++i) { a[i] = AB[o0 + (size_t)(t0 + i) * 512]; u[i] = UB[o0 + (size_t)(t0 + i) * 512]; }
#pragma unroll
            for (int i = 0; i < 32; ++i) { hv = a[i] * hv + u[i]; pp *= a[i]; }
        }
        SP[idx] = pp; SHs[idx] = hv;
    }
}
DI void scan_b_phase(const Ctx& C, KP kp) {
    unsigned char* ws = opq(kp->ws); const float* AB = (const float*)(ws + WS_AB); const float* UB = (const float*)(ws + WS_UB);
    const float* SP = (const float*)(ws + WS_SP); const float* SHs = (const float*)(ws + WS_SH);
    const bf16_t* GA = (const bf16_t*)(ws + WS_GA); bf16_t* MIX = (bf16_t*)(ws + WS_MIX);
    for (int idx = C.gtid; idx < 520 * 512; idx += C.ngt) {
        const int ch = idx & 511, cs = idx >> 9; const size_t o0 = (size_t)cs * 64 * 512 + ch;
        float hv = 0.f; bool last; float* oh;
        if (cs < 512) {
            const int c = cs & 127, b = cs >> 7;
            int j = 0;
            for (; j + 8 <= c; j += 8) { float p_[8], h_[8];
#pragma unroll
                for (int i = 0; i < 8; ++i) { const int si = (b * 128 + j + i) * 512 + ch; p_[i] = SP[si]; h_[i] = SHs[si]; }
#pragma unroll
                for (int i = 0; i < 8; ++i) hv = p_[i] * hv + h_[i]; }
            for (; j < c; ++j) { const int si = (b * 128 + j) * 512 + ch; hv = SP[si] * hv + SHs[si]; }
            last = (c == 127); oh = kp->out + O_PH + b * 512 + ch;
        } else { const int b = cs - 512; hv = kp->in[3][b * 512 + ch]; last = true; oh = kp->out + O_SH + b * 512 + ch; }
#pragma unroll 1
        for (int t0 = 0; t0 < 64; t0 += 32) {
            float a[32], u[32], g[32];
#pragma unroll
            for (int i = 0; i < 32; ++i) { a[i] = AB[o0 + (size_t)(t0 + i) * 512]; u[i] = UB[o0 + (size_t)(t0 + i) * 512]; g[i] = bf2f(GA[o0 + (size_t)(t0 + i) * 512]); }
#pragma unroll
            for (int i = 0; i < 32; ++i) { hv = a[i] * hv + u[i]; const float y = hv * gelu_tanh(g[i]); MIX[((size_t)cs * 64 + t0 + i) * DM + ch] = (bf16_t)(cvt_pk_bf16(y, 0.f) & 0xffffu); }
        }
        if (last) *oh = hv;
    }
}
DI void s5_chain_phase(const Ctx& C, KP kp) {
    unsigned char* ws = opq(kp->ws); const f32x2* AP = (const f32x2*)(ws + WS_AP); const float* E = (const float*)(ws + WS_E); bf16_t* A2 = (bf16_t*)(ws + WS_A2);
    for (int idx = C.gtid; idx < 12 * 4096; idx += C.ngt) {
        const int gp = idx & 4095, g = gp >> 6, p = gp & 63, sid = idx >> 12;
        int nsteps, chunk0; float sr = 0.f, si = 0.f; float* ore; float* oim;
        if (sid < 4) { nsteps = 512; chunk0 = sid * 512; ore = kp->out + O_PRE + sid * 4096 + gp; oim = kp->out + O_PIM + sid * 4096 + gp; }
        else { const int b = sid - 4; nsteps = 4; chunk0 = 2048 + b * 4; sr = kp->in[6][b * 4096 + gp]; si = kp->in[7][b * 4096 + gp]; ore = kp->out + O_SRE + b * 4096 + gp; oim = kp->out + O_SIM + b * 4096 + gp; }
        const f32x2 a16 = AP[gp * 17 + 16];
        const size_t r0 = (size_t)g * S5ROWS + chunk0;
        if (nsteps >= 32) {
#pragma unroll 1
        for (int c0 = 0; c0 < nsteps; c0 += 32) {
            float er[32], ei[32];
#pragma unroll
            for (int i = 0; i < 32; ++i) { er[i] = E[(r0 + c0 + i) * 128 + p]; ei[i] = E[(r0 + c0 + i) * 128 + 64 + p]; }
#pragma unroll
            for (int i = 0; i < 32; ++i) {
                bf16_t* ap = A2 + (r0 + c0 + i) * S5LDA;
                ap[p] = (bf16_t)(cvt_pk_bf16(sr, 0.f) & 0xffffu); ap[64 + p] = (bf16_t)(cvt_pk_bf16(si, 0.f) & 0xffffu);
                const float nr = a16[0] * sr - a16[1] * si + er[i], ni = a16[0] * si + a16[1] * sr + ei[i]; sr = nr; si = ni;
            }
        }
        } else
#pragma unroll 1
        for (int c0 = 0; c0 < nsteps; c0 += 4) {
            float er[4], ei[4];
#pragma unroll
            for (int i = 0; i < 4; ++i) { er[i] = E[(r0 + c0 + i) * 128 + p]; ei[i] = E[(r0 + c0 + i) * 128 + 64 + p]; }
#pragma unroll
            for (int i = 0; i < 4; ++i) {
                bf16_t* ap = A2 + (r0 + c0 + i) * S5LDA;
                ap[p] = (bf16_t)(cvt_pk_bf16(sr, 0.f) & 0xffffu); ap[64 + p] = (bf16_t)(cvt_pk_bf16(si, 0.f) & 0xffffu);
                const float nr = a16[0] * sr - a16[1] * si + er[i], ni = a16[0] * si + a16[1] * sr + ei[i]; sr = nr; si = ni;
            }
        }
        *ore = sr; *oim = si;
    }
}


constexpr int SOUT_LD = 132;
template <class F>
DI void small_gemm(const Ctx& C, const bf16_t* A, int lda, const bf16_t* Bt, int K, int nunits, const F f) {
    const int l31 = C.lane & 31, hh = C.lane >> 5, w = C.wave;
    LAS float* part = (LAS float*)C.lds;
    const int kw = K >> 3, nks = kw >> 4, k0 = w * kw;
    for (int ui = blockIdx.x; ui < nunits; ui += gridDim.x) {
        int arow0, brow[4]; { int b0_, b1_, b2_, b3_; f.unit(ui, arow0, b0_, b1_, b2_, b3_); brow[0] = b0_; brow[1] = b1_; brow[2] = b2_; brow[3] = b3_; }
        f32x16 acc[4];
#pragma unroll
        for (int t = 0; t < 4; ++t)
#pragma unroll
            for (int r = 0; r < 16; ++r) acc[t][r] = 0.f;
        const bf16_t* ap = A + (size_t)(arow0 + l31) * lda + k0 + 8 * hh;
        const bf16_t* bp[4];
#pragma unroll
        for (int t = 0; t < 4; ++t) bp[t] = Bt + (size_t)(brow[t] + l31) * K + k0 + 8 * hh;
#pragma unroll 2
        for (int ks = 0; ks < nks; ++ks) {
            const bf16x8 a = *(const bf16x8*)(ap + 16 * ks);
            bf16x8 b[4];
#pragma unroll
            for (int t = 0; t < 4; ++t) b[t] = *(const bf16x8*)(bp[t] + 16 * ks);
#pragma unroll
            for (int t = 0; t < 4; ++t) acc[t] = MFMA32(b[t], a, acc[t]);
        }
        __syncthreads();
#pragma unroll
        for (int t = 0; t < 4; ++t)
#pragma unroll
            for (int g = 0; g < 4; ++g)
                *(LAS f32x4*)(part + (w * 32 + l31) * SOUT_LD + 32 * t + 8 * g + 4 * hh) = (f32x4){acc[t][4 * g], acc[t][4 * g + 1], acc[t][4 * g + 2], acc[t][4 * g + 3]};
        __syncthreads();
#pragma unroll
        for (int it = 0; it < 2; ++it) {
            const int item = it * 512 + C.tid, row = item >> 5, c4 = item & 31;
            f32x4 s = *(const LAS f32x4*)(part + row * SOUT_LD + 4 * c4);
#pragma unroll
            for (int p = 1; p < 8; ++p) s = s + *(const LAS f32x4*)(part + (p * 32 + row) * SOUT_LD + 4 * c4);
            *(LAS f32x4*)(part + row * SOUT_LD + 4 * c4) = s;
        }
        __syncthreads();
        f.epi(ui, part, C.tid);
    }
    __syncthreads();
}
constexpr int SG_KC = 256;
constexpr int SG_LD = SG_KC * 2 + 16;
constexpr int SG_A = 0, SG_B = 64 * SG_LD, SG_OUT = SG_B + 128 * SG_LD;
static_assert(SG_OUT + 64 * SOUT_LD * 4 <= LDS_BIAS, "small-GEMM LDS map");
template <class F>
DI void small_gemm2(const Ctx& C, const bf16_t* A, int lda, const bf16_t* Bt, int K, int nunits64, const F f) {
    const int l31 = C.lane & 31, hh = C.lane >> 5, w = C.wave, rt = w >> 2, ct = w & 3;
    LAS unsigned char* lds = C.lds; LAS float* out = (LAS float*)(lds + SG_OUT);
    const int nch = K / SG_KC;
    const int prow = C.tid >> 5, ppart = C.tid & 31;
    for (int u64 = blockIdx.x; u64 < nunits64; u64 += gridDim.x) {
        const int uA = ((u64 >> 3) << 4) | ((u64 & 7) << 1);
        int arow0, brow[4]; { int b0_, b1_, b2_, b3_; f.unit(uA, arow0, b0_, b1_, b2_, b3_); brow[0] = b0_; brow[1] = b1_; brow[2] = b2_; brow[3] = b3_; }
        const bf16_t* ag = A + (size_t)(arow0 + prow) * lda + ppart * 8;
        const bf16_t* bg[8];
#pragma unroll
        for (int i = 0; i < 8; ++i) bg[i] = Bt + (size_t)(brow[i >> 1] + prow + 16 * (i & 1)) * K + ppart * 8;
        u32x4 ra[4], rb[8];
#pragma unroll
        for (int i = 0; i < 4; ++i) ra[i] = *(const u32x4*)(ag + (size_t)(16 * i) * lda);
#pragma unroll
        for (int i = 0; i < 8; ++i) rb[i] = *(const u32x4*)(bg[i]);
        f32x16 acc;
#pragma unroll
        for (int r = 0; r < 16; ++r) acc[r] = 0.f;
        for (int ch = 0; ch < nch; ++ch) {
            __syncthreads();
#pragma unroll
            for (int i = 0; i < 4; ++i) *(LAS u32x4*)(lds + SG_A + (prow + 16 * i) * SG_LD + ppart * 16) = ra[i];
#pragma unroll
            for (int i = 0; i < 8; ++i) *(LAS u32x4*)(lds + SG_B + (prow + 16 * i) * SG_LD + ppart * 16) = rb[i];
            __syncthreads();
            if (ch + 1 < nch) {
#pragma unroll
                for (int i = 0; i < 4; ++i) ra[i] = *(const u32x4*)(ag + (size_t)(16 * i) * lda + (ch + 1) * SG_KC);
#pragma unroll
                for (int i = 0; i < 8; ++i) rb[i] = *(const u32x4*)(bg[i] + (ch + 1) * SG_KC);
            }
#pragma unroll
            for (int ks = 0; ks < SG_KC / 16; ++ks) {
                const bf16x8 a = *(const LAS bf16x8*)(lds + SG_A + (32 * rt + l31) * SG_LD + 32 * ks + 16 * hh);
                const bf16x8 b = *(const LAS bf16x8*)(lds + SG_B + (32 * ct + l31) * SG_LD + 32 * ks + 16 * hh);
                acc = MFMA32(b, a, acc);
            }
        }
#pragma unroll
        for (int g = 0; g < 4; ++g) *(LAS f32x4*)(out + (32 * rt + l31) * SOUT_LD + 32 * ct + 8 * g + 4 * hh) = (f32x4){acc[4 * g], acc[4 * g + 1], acc[4 * g + 2], acc[4 * g + 3]};
        __syncthreads();
        f.epi(uA, out, C.tid); f.epi(uA + 1, out + 32 * SOUT_LD, C.tid);
    }
    __syncthreads();
}
DI void pair_rows(int q, int rowbase, int& br0, int& br1, int& br2, int& br3) { const int gb = rowbase + 256 * (q >> 1) + 64 * (q & 1); br0 = gb; br1 = gb + 32; br2 = gb + 128; br3 = gb + 160; }

struct SF_SwiGLU {
    bf16_t* HB; const float* RS;
    DI void unit(int ui, int& arow0, int& br0, int& br1, int& br2, int& br3) const { arow0 = MPROMPT + 32 * (ui & 15); pair_rows(ui >> 4, 0, br0, br1, br2, br3); }
    DI void epi(int ui, const LAS float* out, int tid) const {
        const int t = tid >> 4, c4 = tid & 15, row = MPROMPT + 32 * (ui & 15) + t, q = ui >> 4;
        const float rstd = RS ? rsqrtf(RS[row] * (1.0f / DM) + EPS) : 1.0f;
        const f32x4 g = *(const LAS f32x4*)(out + t * SOUT_LD + 4 * c4) * rstd, u = *(const LAS f32x4*)(out + t * SOUT_LD + 64 + 4 * c4) * rstd;
        u32x2 w; w.x = cvt_pk_bf16(siluf_(g[0]) * u[0], siluf_(g[1]) * u[1]); w.y = cvt_pk_bf16(siluf_(g[2]) * u[2], siluf_(g[3]) * u[3]);
        *(u32x2*)(HB + (size_t)row * DFF + 64 * q + 4 * c4) = w;
    }
};
struct SF_Residual {
    float* X; float s; const float* Rs; bf16_t* XB; float* RS;
    DI void unit(int ui, int& arow0, int& br0, int& br1, int& br2, int& br3) const { arow0 = MPROMPT + 32 * (ui & 15); const int cg = ui >> 4; br0 = 128 * cg; br1 = 128 * cg + 32; br2 = 128 * cg + 64; br3 = 128 * cg + 96; }
    DI void epi(int ui, const LAS float* out, int tid) const {
        const float sc = s; const float* const rsrc = Rs;
#pragma unroll
        for (int it = 0; it < 2; ++it) {
            const int item = it * 512 + tid, t = item >> 5, c4 = item & 31, rl = 32 * (ui & 15) + t, row = MPROMPT + rl, col = 128 * (ui >> 4) + 4 * c4;
            const f32x4 pv = *(const LAS f32x4*)(out + t * SOUT_LD + 4 * c4);
            f32x4 v = *(const f32x4*)(rsrc + (size_t)rl * DM + col); v[0] += pv[0] * sc; v[1] += pv[1] * sc; v[2] += pv[2] * sc; v[3] += pv[3] * sc;
            *(f32x4*)(X + (size_t)row * DM + col) = v;
        }
    }
};
struct SF_GLU {
    float* X; bf16_t* XB; float* RS;
    DI void unit(int ui, int& arow0, int& br0, int& br1, int& br2, int& br3) const { arow0 = MPROMPT + 32 * (ui & 15); pair_rows(ui >> 4, 0, br0, br1, br2, br3); }
    DI void epi(int ui, const LAS float* out, int tid) const {
        const int t = tid >> 4, c4 = tid & 15, row = MPROMPT + 32 * (ui & 15) + t, col = 64 * (ui >> 4) + 4 * c4;
        const f32x4 a = *(const LAS f32x4*)(out + t * SOUT_LD + 4 * c4), g = *(const LAS f32x4*)(out + t * SOUT_LD + 64 + 4 * c4);
        f32x4 v = *(const f32x4*)(X + (size_t)row * DM + col);
        v[0] += a[0] * sigmoidf_(g[0]); v[1] += a[1] * sigmoidf_(g[1]); v[2] += a[2] * sigmoidf_(g[2]); v[3] += a[3] * sigmoidf_(g[3]);
        *(f32x4*)(X + (size_t)row * DM + col) = v;
    }
};
struct SF_Gate {
    const bf16_t* XC; float* AB; float* UB; const float *ba, *bx, *lam;
    DI void unit(int ui, int& arow0, int& br0, int& br1, int& br2, int& br3) const { arow0 = MPROMPT + 32 * (ui & 15); pair_rows(ui >> 4, 0, br0, br1, br2, br3); }
    DI void epi(int ui, const LAS float* out, int tid) const {
        const int t = tid >> 4, c4 = tid & 15, row = MPROMPT + 32 * (ui & 15) + t, ch = 64 * (ui >> 4) + 4 * c4;
        const f32x4 rr = *(const LAS f32x4*)(out + t * SOUT_LD + 4 * c4) + *(const f32x4*)(ba + ch), ii = *(const LAS f32x4*)(out + t * SOUT_LD + 64 + 4 * c4) + *(const f32x4*)(bx + ch);
        const f32x4 lm = *(const f32x4*)(lam + ch);
        const size_t off = (size_t)row * 512 + ch; const u32x2 xr = *(const u32x2*)(XC + off);
        const float xc[4] = {__uint_as_float(xr.x << 16), __uint_as_float(xr.x & 0xffff0000u), __uint_as_float(xr.y << 16), __uint_as_float(xr.y & 0xffff0000u)};
        f32x4 av, uv;
#pragma unroll
        for (int e = 0; e < 4; ++e) { const float r = sigmoidf_(rr[e]), ig = sigmoidf_(ii[e]); const float la = -8.0f * log1pf(expf(-lm[e])) * r; const float a_ = fexp(la); av[e] = a_; uv[e] = __builtin_sqrtf(fmaxf(1.0f - a_ * a_, 0.0f)) * (ig * xc[e]); }
        *(f32x4*)(AB + off) = av; *(f32x4*)(UB + off) = uv;
    }
};
struct SF_QKV {
    bf16_t *XA, *GA, *Q, *KB, *VT; float* out; const float *qg, *kg; const float* RS;
    DI void unit(int ui, int& arow0, int& br0, int& br1, int& br2, int& br3) const {
        arow0 = MPROMPT + 32 * (ui & 15); const int cg = ui >> 4, pn = cg >> 1, hf = cg & 1;
        if (pn >= 4 && pn < 8) { const int b0 = 256 * pn + 64 * hf; br0 = b0; br1 = b0 + 128; br2 = b0 + 32; br3 = b0 + 160; }
        else { br0 = 128 * cg; br1 = 128 * cg + 32; br2 = 128 * cg + 64; br3 = 128 * cg + 96; }
    }
    DI void epi(int ui, const LAS float* o, int tid) const {
        const int cg = ui >> 4, pn = cg >> 1, hf = cg & 1;
#pragma unroll
        for (int it = 0; it < 2; ++it) {
            const int item = it * 512 + tid, t = item >> 5, c4 = item & 31, rl = 32 * (ui & 15) + t, row = MPROMPT + rl;
            const float rstd = RS ? rsqrtf(RS[row] * (1.0f / DM) + EPS) : 1.0f;
            f32x4 v = *(const LAS f32x4*)(o + t * SOUT_LD + 4 * c4) * rstd;
            if (pn < 4) {
                bf16_t* base = (pn < 2) ? XA : GA; u32x2 w; w.x = cvt_pk_bf16(v[0], v[1]); w.y = cvt_pk_bf16(v[2], v[3]);
                *(u32x2*)(base + (size_t)row * 512 + 128 * (cg & 3) + 4 * c4) = w;
            } else if (pn < 8) {
                const bool isq = pn < 6; const int head = (pn & 1) * 4 + 2 * hf + (c4 >> 4), dim = 4 * (c4 & 15);
                float ss = (v[0] * v[0] + v[1] * v[1]) + (v[2] * v[2] + v[3] * v[3]);
                ss += __shfl_xor(ss, 1); ss += __shfl_xor(ss, 2); ss += __shfl_xor(ss, 4); ss += __shfl_xor(ss, 8);
                const float rs = rsqrtf(ss * (1.0f / 64.0f) + EPS);
                const f32x4 gn = *(const f32x4*)((isq ? qg : kg) + dim);
                v = v * rs * gn;
                const float gs = isq ? 0.125f : 1.0f;
                u32x2 w; w.x = cvt_pk_bf16(v[0] * gs, v[1] * gs); w.y = cvt_pk_bf16(v[2] * gs, v[3] * gs);
                *(u32x2*)((isq ? Q : KB) + (size_t)row * 512 + head * 64 + dim) = w;
                if (!isq) *(f32x4*)(out + O_SK + (size_t)rl * 512 + head * 64 + dim) = v;
            } else {
                const int col = 128 * (cg & 3) + 4 * c4;
                const unsigned p01 = cvt_pk_bf16(v[0], v[1]), p23 = cvt_pk_bf16(v[2], v[3]);
                bf16_t* vp = VT + ((size_t)(row >> 6) * 512 + col) * 64 + (row & 63);
                vp[0] = (bf16_t)(p01 & 0xffffu); vp[64] = (bf16_t)(p01 >> 16); vp[128] = (bf16_t)(p23 & 0xffffu); vp[192] = (bf16_t)(p23 >> 16);
                *(f32x4*)(out + O_SV + (size_t)rl * 512 + col) = v;
            }
        }
    }
};
struct SF_S5E {
    float* E;
    DI void unit(int ui, int& arow0, int& br0, int& br1, int& br2, int& br3) const { arow0 = ui * S5ROWS + 2048; br0 = ui * 256; br1 = ui * 256 + 32; br2 = ui * 256 + 64; br3 = ui * 256 + 96; }
    DI void epi(int ui, const LAS float* out, int tid) const {
#pragma unroll
        for (int it = 0; it < 2; ++it) { const int item = it * 512 + tid, t = item >> 5, c4 = item & 31;
            *(f32x4*)(E + ((size_t)ui * S5ROWS + 2048 + t) * 128 + 4 * c4) = *(const LAS f32x4*)(out + t * SOUT_LD + 4 * c4); }
    }
};
struct SF_S5Y {
    bf16_t* Y;
    DI void unit(int ui, int& arow0, int& br0, int& br1, int& br2, int& br3) const { const int g = ui >> 1, hf = ui & 1; arow0 = g * S5ROWS + 2048; const int b0 = g * 256 + 128 * hf; br0 = b0; br1 = b0 + 32; br2 = b0 + 64; br3 = b0 + 96; }
    DI void epi(int ui, const LAS float* out, int tid) const {
        const int g = ui >> 1, hf = ui & 1;
#pragma unroll
        for (int it = 0; it < 2; ++it) { const int item = it * 512 + tid, t = item >> 5, c4 = item & 31, n = 128 * hf + 4 * c4, i16 = n >> 4, o = n & 15;
            const f32x4 v = *(const LAS f32x4*)(out + t * SOUT_LD + 4 * c4); u32x2 w; w.x = cvt_pk_bf16(v[0], v[1]); w.y = cvt_pk_bf16(v[2], v[3]);
            *(u32x2*)(Y + ((size_t)(2048 + t) * 16 + i16) * DM + 16 * g + o) = w; }
    }
};

template <class Epi, class Sched>
DI void run_gemm(LAS unsigned char* lds, const bf16_t* A, int lda, const bf16_t* Bt, int K, const Sched& S, const Epi& E) {
    pg8::Gemm g{A, Bt, K, lda};
    pg8::gemm_phase<Epi, Sched, true, true>(lds, g, S, E);
}

#ifndef PHMASK
#define PHMASK 0xffffffffu
#endif
#define PH_ON(b) (((PHMASK) >> (b)) & 1u)
__global__ void __launch_bounds__(512) fwd_megakernel(Params P) {
    extern __shared__ __attribute__((aligned(16))) unsigned char lds_raw[];
    int ph = 0;
    { volatile LAS unsigned* st_ = (volatile LAS unsigned*)((LAS unsigned char*)lds_raw + LDS_BARST); if (threadIdx.x == 0) { st_[0] = 0u; st_[1] = 0u; } __syncthreads();
      (void)xcd_barrier_post((unsigned*)(opq((unsigned char*)get_kp()->ws) + WS_BARW), st_); }
#define PHASE_BEGIN { KP kp = get_kp(); if (ph >= kp->ph_lo && ph < kp->ph_hi) { Ctx C; { int t_ = threadIdx.x; asm volatile("" : "+v"(t_)); C.tid = t_; } C.lane = C.tid & 63; C.wave = __builtin_amdgcn_readfirstlane(C.tid >> 6); \
    C.gw = blockIdx.x * 8 + C.wave; C.ngw = gridDim.x * 8; C.gtid = blockIdx.x * 512 + C.tid; C.ngt = gridDim.x * 512; C.lds = (LAS unsigned char*)lds_raw; \
    const int G = gridDim.x, c = blockIdx.x; (void)G; (void)c; \
    unsigned char* ws = opq((unsigned char*)kp->ws); float* X = opq((float*)kp->out); bf16_t* XN = (bf16_t*)(ws + WS_XN); bf16_t* HB = (bf16_t*)(ws + WS_HB); (void)X; (void)XN; (void)HB;
#define PHASE_END   if (ph + 1 < get_kp()->ph_hi) { if (ph == 0) cg::this_grid().sync(); else grid_barrier(get_kp(), C.lds); } } } ++ph;

    PHASE_BEGIN if (PH_ON(0)) p0_phase(C, get_kp()); PHASE_END
#define WIN_(i)  ((const bf16_t*)(ws + WS_WIN + (size_t)(i) * 11 * MiB))
#define WOUT_(i) ((const bf16_t*)(ws + WS_WOUT + (size_t)(i) * 11 * HALF_MIB))
#define RS_(slot) ((float*)nullptr)
#define XS_ (X + (size_t)MPROMPT * DM)
#define GEMM_FFN_IN(wi, slot)  PHASE_BEGIN if (PH_ON(2)) { pg8::StaticOrder S; S.init(MPROMPT, 2 * DFF, G, c); EpiSwiGLU E{HB, RS_(slot)}; run_gemm(C.lds, XN, DM, WIN_(wi), DM, S, E); SF_SwiGLU F{HB, RS_(slot)}; small_gemm2(C, XN, DM, WIN_(wi), DM, 352, F); } PHASE_END
#define GEMM_FFN_OUT(wi, rp, rs, xb, rsp) PHASE_BEGIN if (PH_ON(3)) { pg8::StaticOrder S; S.init(MPROMPT, DM, G, c); EpiResidual E{X, 0.5f, rp, rs, xb, rsp}; run_gemm(C.lds, HB, DFF, WOUT_(wi), DFF, S, E); SF_Residual F{X, 0.5f, rs, xb, rsp}; small_gemm2(C, HB, DFF, WOUT_(wi), DFF, 64, F); } PHASE_END
    GEMM_FFN_IN(0, 4)
    GEMM_FFN_OUT(0, kp->in[0], kp->in[1], (bf16_t*)nullptr, (float*)nullptr)
    PHASE_BEGIN norm_phase(C, X, nullptr, XN, nullptr); if (PH_ON(4)) s5_fill_phase(C, get_kp()); PHASE_END
    PHASE_BEGIN if (PH_ON(5)) { pg8::StaticOrder S; S.init(MPROMPT, 2560, G, c);
        EpiQKV E{(bf16_t*)(ws + WS_XA), (bf16_t*)(ws + WS_GA), (bf16_t*)(ws + WS_Q), (bf16_t*)(ws + WS_KB), (bf16_t*)(ws + WS_VT), X, kp->in[23], kp->in[24], RS_(0)};
        run_gemm(C.lds, XN, DM, (const bf16_t*)(ws + WS_WPROJ), DM, S, E);
        SF_QKV F{E.XA, E.GA, E.Q, E.KB, E.VT, E.out, E.qg, E.kg, E.RS}; small_gemm2(C, XN, DM, (const bf16_t*)(ws + WS_WPROJ), DM, 160, F); } PHASE_END
    PHASE_BEGIN if (PH_ON(6)) conv_phase(C, get_kp()); if (PH_ON(7)) attn_phase(C, get_kp()); PHASE_END
    PHASE_BEGIN if (PH_ON(8)) { GateOrder S; S.S.init(MPROMPT, 1024, G, c);
        EpiGate E{(const bf16_t*)(ws + WS_XC), (float*)(ws + WS_AB), (float*)(ws + WS_UB), kp->in[19], kp->in[21], kp->in[22]};
        run_gemm(C.lds, (const bf16_t*)(ws + WS_XC), 512, (const bf16_t*)(ws + WS_WGATEC), 128, S, E);
        SF_Gate F{E.XC, E.AB, E.UB, E.ba, E.bx, E.lam}; small_gemm2(C, (const bf16_t*)(ws + WS_XC), 512, (const bf16_t*)(ws + WS_WGATE), 512, 64, F); } PHASE_END
    PHASE_BEGIN if (PH_ON(9)) scan_a_phase(C, get_kp()); PHASE_END
    PHASE_BEGIN if (PH_ON(10)) scan_b_phase(C, get_kp()); PHASE_END
    PHASE_BEGIN if (PH_ON(3)) { pg8::StaticOrder S; S.init(MPROMPT, DM, G, c); EpiResidual E{X, 1.0f, X, XS_, (bf16_t*)nullptr, (float*)nullptr}; run_gemm(C.lds, (const bf16_t*)(ws + WS_MIX), DM, (const bf16_t*)(ws + WS_WO), DM, S, E); SF_Residual F{X, 1.0f, XS_, (bf16_t*)nullptr, (float*)nullptr}; small_gemm2(C, (const bf16_t*)(ws + WS_MIX), DM, (const bf16_t*)(ws + WS_WO), DM, 64, F); } PHASE_END
    PHASE_BEGIN norm_phase(C, X, nullptr, XN, nullptr); PHASE_END
    GEMM_FFN_IN(1, 1)
    GEMM_FFN_OUT(1, X, XS_, (bf16_t*)nullptr, (float*)nullptr)
    PHASE_BEGIN norm_phase(C, X, nullptr, XN, nullptr); PHASE_END
    GEMM_FFN_IN(2, 2)
    GEMM_FFN_OUT(2, X, XS_, (bf16_t*)nullptr, (float*)nullptr)
    PHASE_BEGIN if (PH_ON(1)) norm_phase(C, X, kp->in[11] + DM, nullptr, (bf16_t*)(ws + WS_A2)); PHASE_END
    PHASE_BEGIN if (PH_ON(11)) { S5Order S{G, c}; EpiS5E E{(float*)(ws + WS_E)}; run_gemm(C.lds, (const bf16_t*)(ws + WS_A2) + 128, S5LDA, (const bf16_t*)(ws + WS_BTE), 256, S, E); SF_S5E F{E.E}; small_gemm(C, (const bf16_t*)(ws + WS_A2) + 128, S5LDA, (const bf16_t*)(ws + WS_BTE), 256, 64, F); } PHASE_END
    PHASE_BEGIN if (PH_ON(12)) s5_chain_phase(C, get_kp()); PHASE_END
    PHASE_BEGIN if (PH_ON(13)) { S5Order S{G, c}; EpiS5Y E{(bf16_t*)(ws + WS_Y)}; run_gemm(C.lds, (const bf16_t*)(ws + WS_A2), S5LDA, (const bf16_t*)(ws + WS_BTY), 384, S, E); SF_S5Y F{E.Y}; small_gemm(C, (const bf16_t*)(ws + WS_A2), S5LDA, (const bf16_t*)(ws + WS_BTY), 384, 128, F); } PHASE_END
    PHASE_BEGIN if (PH_ON(14)) { pg8::StaticOrder S; S.init(MPROMPT, 2048, G, c); EpiGLU E{X, (bf16_t*)nullptr, (float*)nullptr}; run_gemm(C.lds, (const bf16_t*)(ws + WS_Y), DM, (const bf16_t*)(ws + WS_WGLU), DM, S, E); SF_GLU F{X, (bf16_t*)nullptr, (float*)nullptr}; small_gemm2(C, (const bf16_t*)(ws + WS_Y), DM, (const bf16_t*)(ws + WS_WGLU), DM, 128, F); } PHASE_END
    PHASE_BEGIN norm_phase(C, X, nullptr, XN, nullptr); PHASE_END
    GEMM_FFN_IN(3, 3)
    GEMM_FFN_OUT(3, X, XS_, (bf16_t*)nullptr, (float*)nullptr)
}
constexpr int N_PHASES = 24;

extern "C" void kernel_launch(void* const* d_in, const int* in_sizes, int n_in, void* d_out, int out_size, void* d_ws, size_t ws_size, hipStream_t stream) {
    static int grid = 0;
    if (grid == 0) {
        if (n_in != 36 || ws_size < WS_END) { fprintf(stderr, "kernel_launch: unexpected n_in %d or ws_size %zu (< %zu)\n", n_in, ws_size, (size_t)WS_END); grid = -1; return; }
        int dev = 0, cus = 0, per_cu = 0;
        hipGetDevice(&dev); hipDeviceGetAttribute(&cus, hipDeviceAttributeMultiprocessorCount, dev);
        if (hipFuncSetAttribute((const void*)fwd_megakernel, hipFuncAttributeMaxDynamicSharedMemorySize, LDS_BYTES) != hipSuccess) { fprintf(stderr, "kernel_launch: hipFuncSetAttribute failed\n"); grid = -1; return; }
        hipOccupancyMaxActiveBlocksPerMultiprocessor(&per_cu, (const void*)fwd_megakernel, 512, LDS_BYTES);
        if (per_cu < 1) { fprintf(stderr, "kernel_launch: occupancy query says %d blocks per CU\n", per_cu); per_cu = 1; }
        (void)hipGetLastError();
        grid = cus * 1;
    }
    if (grid < 0) return;
    if (hipMemsetAsync((char*)d_ws + WS_BARW, 0, 16384, stream) != hipSuccess) { fprintf(stderr, "kernel_launch: memset of barrier words failed\n"); return; }
    Params p{};
    for (int i = 0; i < 36; ++i) p.in[i] = (const float*)d_in[i];
    p.out = (float*)d_out; p.ws = (unsigned char*)d_ws; p.ph_lo = 0; p.ph_hi = N_PHASES;
    void* args[] = {&p};
    hipError_t e = hipLaunchCooperativeKernel((const void*)fwd_megakernel, dim3(grid), dim3(512), args, LDS_BYTES, stream);
    if (e != hipSuccess) fprintf(stderr, "cooperative launch failed: %s (grid %d)\n", hipGetErrorString(e), grid);
}
```

```cpp
#include <hip/hip_runtime.h>
#include <hip/hip_cooperative_groups.h>
#include <cstdio>
#include <cstdint>
namespace cg = cooperative_groups;
namespace pg8 {
#define PG8_LAS __attribute__((address_space(3)))
typedef unsigned short bf16_t;
typedef short bf16x8 __attribute__((ext_vector_type(8)));
typedef float f32x4 __attribute__((ext_vector_type(4)));
typedef unsigned u32x4 __attribute__((ext_vector_type(4)));
constexpr int BM = 256, BK = 64, HALF = 128, HTB = HALF * BK * 2  , STAGE_BYTES = 8 * HTB, NXCD = 8, WGM = 8;

__host__ __device__ __forceinline__ int lds_byte(int r, int c) { const int st = (r >> 4) * 2 + (c >> 5), rr = r & 15, cc = c & 31, ob = rr * 64 + cc * 2; return st * 1024 + (ob ^ (((ob >> 9) & 1) << 5)); }
__host__ __device__ __forceinline__ void stage_rc(int b, int& R, int& C) { const int st = b / 1024, sb = b % 1024, swz = sb ^ (((sb >> 9) & 1) << 5); R = (st >> 1) * 16 + swz / 64; C = (st & 1) * 32 + (swz % 64) / 2; }
__host__ __device__ __forceinline__ int perm32(int rho) { const int n = rho >> 4, i = rho & 15; return 8 * (i >> 2) + 4 * n + (i & 3); }

struct Unit { int pm, pn, ka; };
struct Gemm { const bf16_t* A; const bf16_t* Bt; int K, lda; };

struct StaticOrder {
    int nM, nN, nwg, G, c;
    __host__ __device__ void init(int M, int N, int G_, int c_) { nM = M / BM; nN = N / BM; nwg = nM * nN; G = G_; c = c_; }
    __host__ __device__ bool next(int i, Unit& u) const {
        const long L = (long)i * G + c; if (L >= nwg) return false;
        int wgid = (int)L; { const int q = nwg / NXCD, r = nwg % NXCD, xcd = wgid % NXCD, off = wgid / NXCD; wgid = (xcd < r ? xcd * (q + 1) : r * (q + 1) + (xcd - r) * q) + off; }
        const int nig = WGM * nN, gid = wgid / nig, fm = gid * WGM, gsz = (nM - fm) < WGM ? (nM - fm) : WGM;
        u.pm = fm + ((wgid % nig) % gsz); u.pn = (wgid % nig) / gsz; u.ka = 0; return true;
    }
    __device__ __forceinline__ void a_ready(const Unit&) const {}
    __device__ __forceinline__ void done(const Unit&) const {}
};

typedef float f32x2 __attribute__((ext_vector_type(2)));
typedef __bf16 bf16v2_t __attribute__((ext_vector_type(2)));
__device__ __forceinline__ unsigned cvt_pk_bf16(float lo, float hi) { f32x2 v = {lo, hi}; return __builtin_bit_cast(unsigned, __builtin_convertvector(v, bf16v2_t)); }
template <class Epi, class Sched, bool ALIGN_EPI = false, bool SP2 = false>
__device__ __forceinline__ void gemm_phase(PG8_LAS unsigned char* lds, const Gemm g, const Sched& S, const Epi& E) {
    int tid_ = threadIdx.x; asm volatile("" : "+v"(tid_));
    const int tid = tid_, wid = __builtin_amdgcn_readfirstlane(tid >> 6), lane = tid & 63, wr = wid >> 2, wc = wid & 3, fr = lane & 15, fq = lane >> 4;
    int K_ = g.K, lda_ = g.lda; asm volatile("" : "+s"(K_), "+s"(lda_));
    const int K = K_, lda = lda_, nt = K / BK;
    unsigned voffA[2], voffB[2];
#pragma unroll
    for (int i = 0; i < 2; ++i) { int R, C; stage_rc(tid * 16 + i * 8192, R, C); const int Rb = Epi::PERM ? ((R & ~31) + perm32(R & 31)) : R;
        voffA[i] = (unsigned)(R * lda + C) * 2u; voffB[i] = (unsigned)(Rb * K + C) * 2u; }
    const size_t kstep = (size_t)(BK * 2);
    const size_t hsA = (size_t)HALF * lda * 2, hsB = (size_t)HALF * K * 2;
    const size_t tsA = 2 * hsA, tsB = 2 * hsB;
    const unsigned ldsw = (unsigned)wid * 1024u;
    const int aoff = lds_byte(wr * 64 + fr, fq * 8), boff = lds_byte(wc * 32 + fr, fq * 8);
#define PG8_SA(b, h) (((b) * 2 + (h)) * HTB)
#define PG8_SB(b, h) ((4 + (b) * 2 + (h)) * HTB)
#define PG8_STAGE(bufoff, gbase, voff) do { _Pragma("unroll") for (int _i = 0; _i < 2; ++_i) \
        __builtin_amdgcn_global_load_lds((const unsigned*)((const char*)(gbase) + (voff)[_i]), (PG8_LAS unsigned*)(lds + (bufoff) + ldsw + _i * 8192), 16, 0, 0); } while (0)
#define PG8_LDA(dst, b, h) do { _Pragma("unroll") for (int m = 0; m < 4; ++m) _Pragma("unroll") for (int k = 0; k < 2; ++k) dst[m][k] = *(const PG8_LAS bf16x8*)(lds + PG8_SA(b, h) + aoff + m * 2048 + k * 1024); } while (0)
#define PG8_LDB(dst, b, h) do { _Pragma("unroll") for (int n = 0; n < 2; ++n) _Pragma("unroll") for (int k = 0; k < 2; ++k) dst[n][k] = *(const PG8_LAS bf16x8*)(lds + PG8_SB(b, h) + boff + n * 2048 + k * 1024); } while (0)
#define PG8_MMA(ai, bj, At, Bt) do { __builtin_amdgcn_s_setprio(1); _Pragma("unroll") for (int m = 0; m < 4; ++m) _Pragma("unroll") for (int n = 0; n < 2; ++n) _Pragma("unroll") for (int k = 0; k < 2; ++k) \
        acc[ai][bj][m][n] = __builtin_amdgcn_mfma_f32_16x16x32_bf16(Bt[n][k], At[m][k], acc[ai][bj][m][n], 0, 0, 0); __builtin_amdgcn_s_setprio(0); } while (0)
#define PG8_WAIT_V(n) asm volatile("s_waitcnt vmcnt(" #n ")" ::: "memory")
#define PG8_WAIT_L(n) asm volatile("s_waitcnt lgkmcnt(" #n ")" ::: "memory")
#define PG8_BAR __builtin_amdgcn_s_barrier()
#define PG8_SCHED __builtin_amdgcn_sched_barrier(0)
    Unit cur, nxt; int ui = 0;
    if (!S.next(0, cur)) return;
    f32x4 acc[2][2][4][2];
#pragma unroll
    for (int a = 0; a < 2; ++a)
#pragma unroll
        for (int b = 0; b < 2; ++b)
#pragma unroll
            for (int m = 0; m < 4; ++m)
#pragma unroll
                for (int n = 0; n < 2; ++n) acc[a][b][m][n] = (f32x4){0.f, 0.f, 0.f, 0.f};
    bf16x8 At[4][2], B0[2][2], B1[2][2];
    const char* cA = (const char*)g.A + (size_t)cur.pm * tsA + cur.ka; const char* cB = (const char*)g.Bt + (size_t)cur.pn * tsB;
    S.a_ready(cur);
    if constexpr (SP2) {
        PG8_STAGE(PG8_SB(0, 0), cB, voffB); PG8_STAGE(PG8_SB(0, 1), cB + hsB, voffB); PG8_STAGE(PG8_SA(0, 0), cA, voffA); PG8_STAGE(PG8_SA(0, 1), cA + hsA, voffA);
        if (wr == 1) PG8_BAR;
        PG8_WAIT_V(2); PG8_BAR;
        PG8_STAGE(PG8_SB(1, 0), cB + kstep, voffB); PG8_STAGE(PG8_SA(1, 0), cA + kstep, voffA); PG8_STAGE(PG8_SB(1, 1), cB + hsB + kstep, voffB);
        PG8_WAIT_V(6); PG8_BAR;
    } else {
        PG8_STAGE(PG8_SB(0, 0), cB, voffB); PG8_STAGE(PG8_SA(0, 0), cA, voffA); PG8_STAGE(PG8_SB(0, 1), cB + hsB, voffB); PG8_STAGE(PG8_SA(0, 1), cA + hsA, voffA);
        if (wr == 1) PG8_BAR;
        PG8_WAIT_V(4); PG8_BAR;
        PG8_STAGE(PG8_SB(1, 0), cB + kstep, voffB); PG8_STAGE(PG8_SA(1, 0), cA + kstep, voffA); PG8_STAGE(PG8_SB(1, 1), cB + hsB + kstep, voffB);
        PG8_WAIT_V(6); PG8_BAR;
    }
    for (;;) {
        const bool has_next = S.next(ui + 1, nxt);
        const char* nA = has_next ? (const char*)g.A + (size_t)nxt.pm * tsA + nxt.ka : cA; const char* nB = has_next ? (const char*)g.Bt + (size_t)nxt.pn * tsB : cB;
        for (int t = 0; t < nt; t += 2) {
            const bool last = (t == nt - 2);
            const char* a1 = cA + (size_t)(t + 1) * kstep;
            const char* a2 = last ? nA : cA + (size_t)(t + 2) * kstep; const char* b2 = last ? nB : cB + (size_t)(t + 2) * kstep;
            const char* a3 = a2 + kstep; const char* b3 = b2 + kstep;
            if (last && has_next) S.a_ready(nxt);
            if constexpr (SP2) {
            PG8_LDB(B0, 0, 0); PG8_LDB(B1, 0, 1); PG8_SCHED; PG8_LDA(At, 0, 0); PG8_STAGE(PG8_SA(1, 1), a1 + hsA, voffA);
            PG8_WAIT_V(8); PG8_WAIT_L(0); PG8_BAR; PG8_MMA(0, 0, At, B0); PG8_MMA(0, 1, At, B1); PG8_BAR; PG8_SCHED;
            PG8_LDA(At, 0, 1); PG8_STAGE(PG8_SB(0, 0), b2, voffB); PG8_STAGE(PG8_SB(0, 1), b2 + hsB, voffB); PG8_STAGE(PG8_SA(0, 0), a2, voffA);
            PG8_WAIT_V(8); PG8_WAIT_L(0); PG8_BAR; PG8_MMA(1, 0, At, B0); PG8_MMA(1, 1, At, B1); PG8_BAR; PG8_SCHED;
            PG8_LDB(B0, 1, 0); PG8_LDB(B1, 1, 1); PG8_SCHED; PG8_LDA(At, 1, 0); PG8_STAGE(PG8_SA(0, 1), a2 + hsA, voffA);
            PG8_WAIT_V(8); PG8_WAIT_L(0); PG8_BAR; PG8_MMA(0, 0, At, B0); PG8_MMA(0, 1, At, B1); PG8_BAR; PG8_SCHED;
            PG8_LDA(At, 1, 1); PG8_STAGE(PG8_SB(1, 0), b3, voffB); PG8_STAGE(PG8_SB(1, 1), b3 + hsB, voffB); PG8_STAGE(PG8_SA(1, 0), a3, voffA);
            PG8_WAIT_V(8); PG8_WAIT_L(0); PG8_BAR; PG8_MMA(1, 0, At, B0); PG8_MMA(1, 1, At, B1); PG8_BAR; PG8_SCHED;
            } else {
            PG8_LDB(B0, 0, 0); PG8_SCHED; PG8_LDA(At, 0, 0); PG8_STAGE(PG8_SA(1, 1), a1 + hsA, voffA);
            PG8_WAIT_L(8); PG8_BAR; PG8_WAIT_L(0); PG8_MMA(0, 0, At, B0); PG8_BAR; PG8_SCHED;
            PG8_LDB(B1, 0, 1); PG8_STAGE(PG8_SB(0, 0), b2, voffB);
            PG8_BAR; PG8_WAIT_L(0); PG8_MMA(0, 1, At, B1); PG8_BAR;
            PG8_LDA(At, 0, 1); PG8_STAGE(PG8_SA(0, 0), a2, voffA);
            PG8_BAR; PG8_WAIT_L(0); PG8_MMA(1, 0, At, B0); PG8_BAR; PG8_SCHED;
            PG8_STAGE(PG8_SB(0, 1), b2 + hsB, voffB);
            PG8_WAIT_V(6); PG8_BAR; PG8_MMA(1, 1, At, B1); PG8_BAR;
            PG8_LDB(B0, 1, 0); PG8_SCHED; PG8_LDA(At, 1, 0); PG8_STAGE(PG8_SA(0, 1), a2 + hsA, voffA);
            PG8_WAIT_L(8); PG8_BAR; PG8_WAIT_L(0); PG8_MMA(0, 0, At, B0); PG8_BAR; PG8_SCHED;
            PG8_LDB(B1, 1, 1); PG8_STAGE(PG8_SB(1, 0), b3, voffB);
            PG8_BAR; PG8_WAIT_L(0); PG8_MMA(0, 1, At, B1); PG8_BAR;
            PG8_LDA(At, 1, 1); PG8_STAGE(PG8_SA(1, 0), a3, voffA);
            PG8_BAR; PG8_WAIT_L(0); PG8_MMA(1, 0, At, B0); PG8_BAR; PG8_SCHED;
            PG8_STAGE(PG8_SB(1, 1), b3 + hsB, voffB);
            PG8_WAIT_V(6); PG8_BAR; PG8_MMA(1, 1, At, B1); PG8_BAR;
            }
        }
        if constexpr (ALIGN_EPI) { if (wr == 0) PG8_BAR; }
        if constexpr (!Epi::AFTER_DRAIN) { E(acc, cur, wr, wc, fr, fq); S.done(cur); }
        if (!has_next) break;
#pragma unroll
        for (int a = 0; a < 2; ++a)
#pragma unroll
            for (int b = 0; b < 2; ++b)
#pragma unroll
                for (int m = 0; m < 4; ++m)
#pragma unroll
                    for (int n = 0; n < 2; ++n) acc[a][b][m][n] = (f32x4){0.f, 0.f, 0.f, 0.f};
        cur = nxt; cA = nA; cB = nB; ++ui;
        if constexpr (ALIGN_EPI) { if (wr == 1) PG8_BAR; }
    }
    PG8_WAIT_V(0);
    if constexpr (!ALIGN_EPI) { if (wr == 0) PG8_BAR; }
    PG8_BAR;
    if constexpr (Epi::AFTER_DRAIN) { E.fused(acc, cur, wr, wc, fr, fq, lds, wid, lane); S.done(cur); }
#undef PG8_SA
#undef PG8_SB
#undef PG8_STAGE
#undef PG8_LDA
#undef PG8_LDB
#undef PG8_MMA
#undef PG8_WAIT_V
#undef PG8_WAIT_L
#undef PG8_BAR
#undef PG8_SCHED
}
}

using pg8::f32x2; using pg8::bf16_t; using pg8::bf16x8; using pg8::f32x4; using pg8::u32x4; using pg8::Unit; using pg8::cvt_pk_bf16;
#define LAS __attribute__((address_space(3)))
#define DI __device__ __forceinline__
typedef float f32x16 __attribute__((ext_vector_type(16)));
template <class T> DI T* opq(T* p) { asm volatile("" : "+s"(p)); return p; }
#define EPI_FENCE asm volatile("" ::: "memory")
typedef unsigned u32x2 __attribute__((ext_vector_type(2)));

constexpr int MTOK = 33280;
constexpr int MPROMPT = 32768;
constexpr int DM = 1024, DFF = 2816;
constexpr int NCHUNK16 = 2080;
constexpr int S5ROWS = 2304;
constexpr int S5LDA = 384;
constexpr float EPS = 1e-6f;

constexpr size_t MiB = 1u << 20;
constexpr size_t WS_AP = 0, WS_BBAR = 1 * MiB, WS_SP = 2 * MiB, WS_SH = 4 * MiB, WS_KC = 6 * MiB, WS_VC = 10 * MiB;
constexpr size_t WS_WGATEC = 14 * MiB;
constexpr size_t WS_RS = 14 * MiB + 512 * 1024;
constexpr size_t WS_WIN = 16 * MiB;
constexpr size_t WS_WOUT = 60 * MiB;
constexpr size_t WS_WPROJ = 82 * MiB, WS_WO = 87 * MiB, WS_WGLU = 89 * MiB, WS_WGATE = 93 * MiB, WS_BTE = 94 * MiB, WS_BTY = 102 * MiB;
constexpr size_t WS_XN = 114 * MiB;
constexpr size_t WS_SCR = 179 * MiB;
constexpr size_t HALF_MIB = MiB / 2;
constexpr size_t WS_HB = WS_SCR;
constexpr size_t WS_XA = WS_SCR, WS_Q = WS_SCR + 65 * HALF_MIB, WS_KB = WS_SCR + 130 * HALF_MIB, WS_VT = WS_SCR + 195 * HALF_MIB,
                 WS_GA = WS_SCR + 260 * HALF_MIB, WS_XC = WS_SCR + 325 * HALF_MIB, WS_MIX = WS_SCR + 390 * HALF_MIB;
constexpr size_t WS_AB = WS_SCR, WS_UB = WS_SCR + 65 * MiB;
constexpr size_t WS_A2 = WS_SCR, WS_E = WS_SCR + 108 * MiB, WS_Y = WS_SCR + 180 * MiB;
constexpr size_t WS_END = WS_SCR + 260 * MiB;

constexpr size_t O_Y = 0, O_PCONV = 34078720, O_PH = 34084864, O_PK = 34086912, O_PV = 35135488, O_PRE = 36184064, O_PIM = 36200448,
                 O_SCONV = 36216832, O_SH = 36229120, O_SK = 36233216, O_SV = 36495360, O_SRE = 36757504, O_SIM = 36790272;

constexpr int LDS_RING = 131072, LDS_ATTW = 18432  , LDS_BIAS = 147456, LDS_BYTES = 163840;

struct Params { const float* in[36]; float* out; unsigned char* ws; int ph_lo, ph_hi; };
typedef const __attribute__((address_space(4))) Params* KP;
DI KP get_kp() { KP p = (KP)__builtin_amdgcn_kernarg_segment_ptr(); asm volatile("" : "+s"(p)); return p; }

DI float bf2f(unsigned short b) { return __uint_as_float(((unsigned)b) << 16); }
DI float fexp(float x) { return __builtin_amdgcn_exp2f(x * 1.4426950408889634f); }
DI float sigmoidf_(float x) { return __builtin_amdgcn_rcpf(1.0f + fexp(-x)); }
DI float siluf_(float x) { return x * sigmoidf_(x); }
DI float gelu_tanh(float x) { const float y = 0.7978845608028654f * (x + 0.044715f * x * x * x); const float t = fexp(2.0f * y); const float th = 1.0f - 2.0f * __builtin_amdgcn_rcpf(t + 1.0f); return 0.5f * x * (1.0f + th); }
DI float wave_sum(float v) {
#pragma unroll
    for (int o = 1; o < 64; o <<= 1) v += __shfl_xor(v, o);
    return v;
}

struct EpiSwiGLU {
    static constexpr bool PERM = true, AFTER_DRAIN = false;
    bf16_t* O; const float* RS;
    DI void operator()(const f32x4 (&acc)[2][2][4][2], const Unit& u, int wr, int wc, int fr, int fq) const {
        const int row0 = u.pm * 256 + wr * 64 + fr, col0 = u.pn * 128 + wc * 32 + 8 * fq;
#pragma unroll
        for (int ai = 0; ai < 2; ++ai)
#pragma unroll
            for (int m = 0; m < 4; ++m) {
                bf16_t* p = O + (size_t)(row0 + ai * 128 + m * 16) * DFF + col0;
                const float rstd = RS ? rsqrtf(RS[row0 + ai * 128 + m * 16] * (1.0f / DM) + EPS) : 1.0f;
                const f32x4 g0 = acc[ai][0][m][0] * rstd, g1 = acc[ai][0][m][1] * rstd, u0 = acc[ai][1][m][0] * rstd, u1 = acc[ai][1][m][1] * rstd;
                u32x4 w;
                w.x = cvt_pk_bf16(siluf_(g0[0]) * u0[0], siluf_(g0[1]) * u0[1]); w.y = cvt_pk_bf16(siluf_(g0[2]) * u0[2], siluf_(g0[3]) * u0[3]);
                w.z = cvt_pk_bf16(siluf_(g1[0]) * u1[0], siluf_(g1[1]) * u1[1]); w.w = cvt_pk_bf16(siluf_(g1[2]) * u1[2], siluf_(g1[3]) * u1[3]);
                *(u32x4*)p = w; EPI_FENCE;
            }
    }
};
struct EpiResidual {
    static constexpr bool PERM = false, AFTER_DRAIN = false;
    float* X; float s; const float* Rp; const float* Rs; bf16_t* XB; float* RS;
    DI void operator()(const f32x4 (&acc)[2][2][4][2], const Unit& u, int wr, int wc, int fr, int fq) const {
        const int row0 = u.pm * 256 + wr * 64 + fr, col0 = u.pn * 256 + wc * 32 + 4 * fq;
        const float* R = (u.pm < 128) ? Rp : Rs - (size_t)MPROMPT * DM;
#pragma unroll
        for (int ai = 0; ai < 2; ++ai)
#pragma unroll
            for (int m = 0; m < 4; ++m) {
                const int row = row0 + ai * 128 + m * 16; const size_t off = (size_t)row * DM + col0;
#pragma unroll
                for (int bj = 0; bj < 2; ++bj)
#pragma unroll
                    for (int n = 0; n < 2; ++n) { const size_t o = off + bj * 128 + n * 16; f32x4 v = *(const f32x4*)(R + o); v = v + acc[ai][bj][m][n] * s; *(f32x4*)(X + o) = v;
 }
                if (m & 1) EPI_FENCE;
            }
    }
};
struct EpiGLU {
    static constexpr bool PERM = false, AFTER_DRAIN = false;
    float* X; bf16_t* XB; float* RS;
    DI void operator()(const f32x4 (&acc)[2][2][4][2], const Unit& u, int wr, int wc, int fr, int fq) const {
        const int row0 = u.pm * 256 + wr * 64 + fr, col0 = u.pn * 128 + wc * 32 + 4 * fq;
#pragma unroll
        for (int ai = 0; ai < 2; ++ai)
#pragma unroll
            for (int m = 0; m < 4; ++m) {
                const int row = row0 + ai * 128 + m * 16; const size_t off = (size_t)row * DM + col0;
#pragma unroll
                for (int n = 0; n < 2; ++n) { const size_t o = off + n * 16; f32x4 v = *(const f32x4*)(X + o); const f32x4 a = acc[ai][0][m][n], g = acc[ai][1][m][n];
                    v[0] += a[0] * sigmoidf_(g[0]); v[1] += a[1] * sigmoidf_(g[1]); v[2] += a[2] * sigmoidf_(g[2]); v[3] += a[3] * sigmoidf_(g[3]); *(f32x4*)(X + o) = v;
 }
                if (m & 1) EPI_FENCE;
            }
    }
};
struct EpiGate {
    static constexpr bool PERM = false, AFTER_DRAIN = false;
    const bf16_t* XC; float* AB; float* UB; const float *ba, *bx, *lam;
    DI void operator()(const f32x4 (&acc)[2][2][4][2], const Unit& u, int wr, int wc, int fr, int fq) const {
        const int row0 = u.pm * 256 + wr * 64 + fr, ch0 = u.pn * 128 + wc * 32 + 4 * fq;
#pragma unroll
        for (int n = 0; n < 2; ++n) {
            const int ch = ch0 + 16 * n;
            const f32x4 b_a = *(const f32x4*)(ba + ch), b_x = *(const f32x4*)(bx + ch), lm = *(const f32x4*)(lam + ch);
            f32x4 sp;
#pragma unroll
            for (int e = 0; e < 4; ++e) sp[e] = -8.0f * log1pf(expf(-lm[e]));
#pragma unroll
            for (int ai = 0; ai < 2; ++ai)
#pragma unroll
                for (int m = 0; m < 4; ++m) {
                    const size_t off = (size_t)(row0 + ai * 128 + m * 16) * 512 + ch;
                    const u32x2 xr = *(const u32x2*)(XC + off);
                    const float xc[4] = {__uint_as_float(xr.x << 16), __uint_as_float(xr.x & 0xffff0000u), __uint_as_float(xr.y << 16), __uint_as_float(xr.y & 0xffff0000u)};
                    const f32x4 rr = acc[ai][0][m][n] + b_a, ii = acc[ai][1][m][n] + b_x;
                    f32x4 av, uv;
#pragma unroll
                    for (int e = 0; e < 4; ++e) {
                        const float r = sigmoidf_(rr[e]), ig = sigmoidf_(ii[e]);
                        const float la = sp[e] * r;
                        const float a_ = fexp(la);
                        av[e] = a_;
                        uv[e] = __builtin_sqrtf(fmaxf(1.0f - a_ * a_, 0.0f)) * (ig * xc[e]);
                    }
                    *(f32x4*)(AB + off) = av; *(f32x4*)(UB + off) = uv; EPI_FENCE;
                }
        }
    }
};
struct EpiQKV {
    static constexpr bool PERM = true, AFTER_DRAIN = false;
    bf16_t *XA, *GA, *Q, *KB, *VT; float* out; const float *qg, *kg; const float* RS;
    DI void operator()(const f32x4 (&acc)[2][2][4][2], const Unit& u, int wr, int wc, int fr, int fq) const {
        const int pn = u.pn, row0 = u.pm * 256 + wr * 64 + fr;
        const bool needout = (u.pm >= 128) || ((u.pm & 31) >= 30);
        float* okb; float* ovb; int orow0;
        if (u.pm >= 128) { okb = out + O_SK; ovb = out + O_SV; orow0 = row0 - MPROMPT; }
        else { okb = out + O_PK; ovb = out + O_PV; orow0 = (u.pm >> 5) * 512 + ((u.pm & 31) - 30) * 256 + wr * 64 + fr; }
        if (pn < 4) {
            bf16_t* base = (pn < 2) ? XA : GA; const int col0 = (pn & 1) * 256 + wc * 32 + 8 * fq;
#pragma unroll
            for (int ai = 0; ai < 2; ++ai)
#pragma unroll
                for (int m = 0; m < 4; ++m)
#pragma unroll
                    for (int bj = 0; bj < 2; ++bj) {
                        const float rstd = RS ? rsqrtf(RS[row0 + ai * 128 + m * 16] * (1.0f / DM) + EPS) : 1.0f;
                        const f32x4 v0 = acc[ai][bj][m][0] * rstd, v1 = acc[ai][bj][m][1] * rstd; u32x4 w;
                        w.x = cvt_pk_bf16(v0[0], v0[1]); w.y = cvt_pk_bf16(v0[2], v0[3]); w.z = cvt_pk_bf16(v1[0], v1[1]); w.w = cvt_pk_bf16(v1[2], v1[3]);
                        *(u32x4*)(base + (size_t)(row0 + ai * 128 + m * 16) * 512 + col0 + bj * 128) = w; EPI_FENCE;
                    }
        } else if (pn < 8) {
            const bool isq = pn < 6; const int head = (pn & 1) * 4 + wc;
            const float* gp = isq ? qg : kg; const float gs = isq ? 0.125f : 1.0f;
            bf16_t* dst = isq ? Q : KB;
            f32x4 gn[2][2];
#pragma unroll
            for (int bj = 0; bj < 2; ++bj)
#pragma unroll
                for (int n = 0; n < 2; ++n) gn[bj][n] = *(const f32x4*)(gp + 32 * bj + 8 * fq + 4 * n);
#pragma unroll
            for (int ai = 0; ai < 2; ++ai)
#pragma unroll
                for (int m = 0; m < 4; ++m) {
                    float ss = 0.f;
                    const int rloc = ai * 128 + m * 16;
                    const float rstd = RS ? rsqrtf(RS[row0 + rloc] * (1.0f / DM) + EPS) : 1.0f;
#pragma unroll
                    for (int bj = 0; bj < 2; ++bj)
#pragma unroll
                        for (int n = 0; n < 2; ++n) { const f32x4 x = acc[ai][bj][m][n]; ss += (x[0] * x[0] + x[1] * x[1]) + (x[2] * x[2] + x[3] * x[3]); }
                    ss += __shfl_xor(ss, 16); ss += __shfl_xor(ss, 32);
                    const float rs = rstd * rsqrtf(ss * (rstd * rstd) * (1.0f / 64.0f) + EPS);
#pragma unroll
                    for (int bj = 0; bj < 2; ++bj) {
                        const f32x4 v0 = acc[ai][bj][m][0] * rs * gn[bj][0], v1 = acc[ai][bj][m][1] * rs * gn[bj][1];
                        u32x4 w; w.x = cvt_pk_bf16(v0[0] * gs, v0[1] * gs); w.y = cvt_pk_bf16(v0[2] * gs, v0[3] * gs); w.z = cvt_pk_bf16(v1[0] * gs, v1[1] * gs); w.w = cvt_pk_bf16(v1[2] * gs, v1[3] * gs);
                        *(u32x4*)(dst + (size_t)(row0 + rloc) * 512 + head * 64 + 32 * bj + 8 * fq) = w;
                        if (!isq && needout) { float* op = okb + (size_t)(orow0 + rloc) * 512 + head * 64 + 32 * bj + 8 * fq; *(f32x4*)op = v0; *(f32x4*)(op + 4) = v1; }
                    }
                    EPI_FENCE;
                }
        } else {
            const int col0 = (pn & 1) * 256 + wc * 32 + 8 * fq;
#pragma unroll
            for (int ai = 0; ai < 2; ++ai)
#pragma unroll
                for (int m = 0; m < 4; ++m) {
                    const int rloc = ai * 128 + m * 16;
#pragma unroll
                    for (int bj = 0; bj < 2; ++bj)
#pragma unroll
                        for (int n = 0; n < 2; ++n) {
                            const f32x4 v = acc[ai][bj][m][n] * (RS ? rsqrtf(RS[row0 + rloc] * (1.0f / DM) + EPS) : 1.0f); const int col = col0 + bj * 128 + 4 * n;
                            const unsigned p01 = cvt_pk_bf16(v[0], v[1]), p23 = cvt_pk_bf16(v[2], v[3]);
                            bf16_t* vp = VT + ((size_t)((row0 + rloc) >> 6) * 512 + col) * 64 + ((row0 + rloc) & 63);
                            vp[0] = (bf16_t)(p01 & 0xffffu); vp[64] = (bf16_t)(p01 >> 16); vp[128] = (bf16_t)(p23 & 0xffffu); vp[192] = (bf16_t)(p23 >> 16);
                            if (needout) *(f32x4*)(ovb + (size_t)(orow0 + rloc) * 512 + col) = v;
                        }
                    EPI_FENCE;
                }
        }
    }
};
struct EpiS5E {
    static constexpr bool PERM = false, AFTER_DRAIN = false;
    float* E;
    DI void operator()(const f32x4 (&acc)[2][2][4][2], const Unit& u, int wr, int wc, int fr, int fq) const {
        const int g = u.pn, ci0 = (u.pm - 9 * g) * 256 + wr * 64 + fr, col0 = wc * 32 + 4 * fq;
#pragma unroll
        for (int ai = 0; ai < 2; ++ai)
#pragma unroll
            for (int m = 0; m < 4; ++m) {
                const int ci = ci0 + ai * 128 + m * 16;
                if (ci < NCHUNK16) {
                    float* rp = E + ((size_t)g * S5ROWS + ci) * 128 + col0;
#pragma unroll
                    for (int n = 0; n < 2; ++n) *(f32x4*)(rp + 16 * n) = acc[ai][0][m][n];
                }
                EPI_FENCE;
            }
    }
};
struct EpiS5Y {
    static constexpr bool PERM = true, AFTER_DRAIN = false;
    bf16_t* Y;
    DI void operator()(const f32x4 (&acc)[2][2][4][2], const Unit& u, int wr, int wc, int fr, int fq) const {
        const int g = u.pn, ci0 = (u.pm - 9 * g) * 256 + wr * 64 + fr;
        bf16_t* yb = Y + (size_t)ci0 * (16 * DM) + (size_t)(wc * 2 + (fq >> 1)) * DM + 16 * g + 8 * (fq & 1);
#pragma unroll
        for (int ai = 0; ai < 2; ++ai)
#pragma unroll
            for (int m = 0; m < 4; ++m) {
                if (ci0 + ai * 128 + m * 16 < NCHUNK16) {
#pragma unroll
                    for (int bj = 0; bj < 2; ++bj) {
                        const f32x4 v0 = acc[ai][bj][m][0], v1 = acc[ai][bj][m][1]; u32x4 w;
                        w.x = cvt_pk_bf16(v0[0], v0[1]); w.y = cvt_pk_bf16(v0[2], v0[3]); w.z = cvt_pk_bf16(v1[0], v1[1]); w.w = cvt_pk_bf16(v1[2], v1[3]);
                        *(u32x4*)(yb + (size_t)(ai * 128 + m * 16) * (16 * DM) + (size_t)bj * (8 * DM)) = w;
                    }
                }
                EPI_FENCE;
            }
    }
};
struct GateOrder {
    pg8::StaticOrder S;
    DI bool next(int i, Unit& u) const { if (!S.next(i, u)) return false; u.ka = u.pn * 256; return true; }
    DI void a_ready(const Unit&) const {}
    DI void done(const Unit&) const {}
};
struct S5Order {
    int G, c;
    DI bool next(int i, Unit& u) const { const int L = i * G + c; if (L >= 512) return false; u.pn = L >> 3; u.pm = (L >> 3) * 9 + (L & 7); u.ka = 0; return true; }
    DI void a_ready(const Unit&) const {}
    DI void done(const Unit&) const {}
};

struct Ctx { int tid, lane, wave, gw, ngw, gtid, ngt; LAS unsigned char* lds; };

DI void transpose_item(const float* W, const float* gk, int K, int N, bf16_t* WT, int k0, int n0s, int n0d, LAS float* scr, int lane) {
    const float gl = gk ? gk[k0 + lane] : 1.0f;
    float r_[32];
#pragma unroll
    for (int i = 0; i < 32; ++i) r_[i] = W[(size_t)(k0 + 2 * i + (lane >> 5)) * N + n0s + (lane & 31)];
#pragma unroll
    for (int i = 0; i < 32; ++i) { const int kk = 2 * i + (lane >> 5); scr[kk * 33 + (lane & 31)] = r_[i] * __shfl(gl, kk); }
    asm volatile("s_waitcnt lgkmcnt(0)" ::: "memory");
    const int c = lane & 7;
#pragma unroll
    for (int j = 0; j < 4; ++j) { const int n = (lane >> 3) + 8 * j; const LAS float* s = scr + (8 * c) * 33 + n;
        u32x4 o; o.x = cvt_pk_bf16(s[0 * 33], s[1 * 33]); o.y = cvt_pk_bf16(s[2 * 33], s[3 * 33]); o.z = cvt_pk_bf16(s[4 * 33], s[5 * 33]); o.w = cvt_pk_bf16(s[6 * 33], s[7 * 33]);
        *(u32x4*)(WT + (size_t)(n0d + n) * K + k0 + 8 * c) = o; }
    asm volatile("s_waitcnt lgkmcnt(0)" ::: "memory");
}
DI int map_col(int kind, int N, int nd) {
    if (kind == 1) { const int pn = nd >> 8, bj = (nd >> 7) & 1, j = nd & 127; return bj * (N >> 1) + pn * 128 + j; }
    if (kind == 2 && nd >= 1024 && nd < 2048) { const int p = nd & 255, bj = p >> 7, wc = (p >> 5) & 3, j = p & 31; return (nd & ~255) + 64 * wc + 32 * bj + j; }
    return nd;
}
DI void convert_matrix_items(const Ctx& C, const float* W, const float* gk, int K, int N, bf16_t* WT, int kind, int& base) {
    const int nblk = N / 32, nitems = (K / 64) * nblk;
    LAS float* scr = (LAS float*)(C.lds + C.wave * 16384);
    int first = C.gw - (base % C.ngw); if (first < 0) first += C.ngw;
    for (int it = first; it < nitems; it += C.ngw) {
        const int kb = it / nblk, nb = it % nblk;
        transpose_item(W, gk, K, N, WT, 64 * kb, map_col(kind, N, 32 * nb), 32 * nb, scr, C.lane);
    }
    base += nitems;
}
DI void norm_row(const float* src, float* cpy, const float* g, bf16_t* XN, bf16_t* A2, int row, int lane) {
    const f32x4* xr = (const f32x4*)src + lane;
    f32x4 v[4]; float s = 0.f;
#pragma unroll
    for (int j = 0; j < 4; ++j) { v[j] = xr[64 * j]; s += (v[j][0] * v[j][0] + v[j][1] * v[j][1]) + (v[j][2] * v[j][2] + v[j][3] * v[j][3]); }
    if (cpy) {
#pragma unroll
        for (int j = 0; j < 4; ++j) ((f32x4*)cpy)[lane + 64 * j] = v[j];
    }
    const float rstd = rsqrtf(wave_sum(s) * (1.0f / DM) + EPS);
#pragma unroll
    for (int j = 0; j < 4; ++j) {
        const int col = 4 * lane + 256 * j; const f32x4 gg = g ? *(const f32x4*)(g + col) : (f32x4){1.f, 1.f, 1.f, 1.f};
        u32x2 w; w.x = cvt_pk_bf16(v[j][0] * rstd * gg[0], v[j][1] * rstd * gg[1]); w.y = cvt_pk_bf16(v[j][2] * rstd * gg[2], v[j][3] * rstd * gg[3]);
        if (XN) *(u32x2*)(XN + (size_t)row * DM + col) = w;
        else { const int grp = col >> 4, cc = col & 15, chunk = row >> 4, jj = row & 15; *(u32x2*)(A2 + ((size_t)grp * S5ROWS + chunk) * S5LDA + 128 + jj * 16 + cc) = w; }
    }
}
DI void norm_store(const f32x4 (&v)[4], float rstd, const float* g, bf16_t* XN, bf16_t* A2, int row, int lane) {
#pragma unroll
    for (int j = 0; j < 4; ++j) {
        const int col = 4 * lane + 256 * j; const f32x4 gg = g ? *(const f32x4*)(g + col) : (f32x4){1.f, 1.f, 1.f, 1.f};
        u32x2 w; w.x = cvt_pk_bf16(v[j][0] * rstd * gg[0], v[j][1] * rstd * gg[1]); w.y = cvt_pk_bf16(v[j][2] * rstd * gg[2], v[j][3] * rstd * gg[3]);
        if (XN) *(u32x2*)(XN + (size_t)row * DM + col) = w;
        else { const int grp = col >> 4, cc = col & 15, chunk = row >> 4, jj = row & 15; *(u32x2*)(A2 + ((size_t)grp * S5ROWS + chunk) * S5LDA + 128 + jj * 16 + cc) = w; }
    }
}
DI void norm_phase(const Ctx& C, float* X, const float* g, bf16_t* XN, bf16_t* A2) {
    for (int row = C.gw; row < MTOK; row += 2 * C.ngw) {
        const int row2 = row + C.ngw; const bool has2 = row2 < MTOK;
        f32x4 v0[4], v1[4]; float s0 = 0.f, s1 = 0.f;
        const f32x4* x0 = (const f32x4*)(X + (size_t)row * DM) + C.lane; const f32x4* x1 = (const f32x4*)(X + (size_t)(has2 ? row2 : row) * DM) + C.lane;
#pragma unroll
        for (int j = 0; j < 4; ++j) { v0[j] = x0[64 * j]; v1[j] = x1[64 * j]; }
#pragma unroll
        for (int j = 0; j < 4; ++j) { s0 += (v0[j][0] * v0[j][0] + v0[j][1] * v0[j][1]) + (v0[j][2] * v0[j][2] + v0[j][3] * v0[j][3]); s1 += (v1[j][0] * v1[j][0] + v1[j][1] * v1[j][1]) + (v1[j][2] * v1[j][2] + v1[j][3] * v1[j][3]); }
        const float r0 = rsqrtf(wave_sum(s0) * (1.0f / DM) + EPS), r1 = rsqrtf(wave_sum(s1) * (1.0f / DM) + EPS);
        norm_store(v0, r0, g, XN, A2, row, C.lane);
        if (has2) norm_store(v1, r1, g, XN, A2, row2, C.lane);
    }
}

#define XB_TMO      128
#define XB_XCNT(j)  (256  + 64 * (j))
#define XB_XSUB(j)  (1280 + 64 * (j))
#define XB_XGEN(j)  (2304 + 64 * (j))
#define XB_TOP      3328
#define XB_TOPGEN   3392
#define XCD_BAR_WORDS 3456
#define XB_SPIN_CAP (1u << 18)

__device__ __forceinline__ unsigned xb_ld(unsigned* p)              { return __hip_atomic_load(p, __ATOMIC_RELAXED, __HIP_MEMORY_SCOPE_AGENT); }
__device__ __forceinline__ unsigned xb_add(unsigned* p, unsigned v) { return __hip_atomic_fetch_add(p, v, __ATOMIC_RELAXED, __HIP_MEMORY_SCOPE_AGENT); }
__device__ __forceinline__ unsigned xb_xcc_id() { return (unsigned)__builtin_amdgcn_s_getreg((3 << 11) | 20) & 0xFu; }
#define XB_SPIN(cond, bar) do { unsigned _sp = 0; while (cond) { __builtin_amdgcn_s_sleep(1); \
    if ((++_sp & 255u) == 0u) { if (xb_ld(&(bar)[XB_TMO])) break; if (_sp > XB_SPIN_CAP) { atomicAdd(&(bar)[XB_TMO], 1u); break; } } } } while (0)

struct XcdBarrier {
    unsigned* bar; unsigned x;
    volatile LAS unsigned* st;
};

__device__ __forceinline__ XcdBarrier xcd_barrier_post(unsigned* bar, volatile LAS unsigned* st) {
    XcdBarrier b; b.bar = bar; b.x = xb_xcc_id(); b.st = st;
    if (threadIdx.x == 0) (void)xb_add(&bar[XB_XCNT(b.x)], 1u);
    return b;
}
__device__ __forceinline__ void xcd_barrier_complete(unsigned* bar, unsigned x, unsigned& nloc, unsigned& nx) {
    const unsigned G = gridDim.x * gridDim.y * gridDim.z;
    unsigned sum, cnt, mine, sp = 0u;
    for (;;) {
        sum = 0u; cnt = 0u; mine = 0u;
#pragma unroll
        for (unsigned j = 0; j < 16; ++j) { const unsigned c = xb_ld(&bar[XB_XCNT(j)]); sum += c; cnt += (c > 0u) ? 1u : 0u; mine = (j == x) ? c : mine; }
        if (sum == G) break;
        __builtin_amdgcn_s_sleep(1);
        if ((++sp & 255u) == 0u) { if (xb_ld(&bar[XB_TMO])) break; if (sp > XB_SPIN_CAP) { atomicAdd(&bar[XB_TMO], 1u); break; } }
    }
    nloc = mine > 0u ? mine : 1u; nx = cnt > 0u ? cnt : 1u;
}

__device__ __forceinline__ void xcd_barrier(const XcdBarrier& b) {
    asm volatile("s_waitcnt vmcnt(0)" ::: "memory");
    __syncthreads();
    if (threadIdx.x == 0) {
        unsigned* bar = b.bar;
        __builtin_amdgcn_s_waitcnt(0);
        unsigned nloc = b.st[0], nx = b.st[1];
        if (nloc == 0u) { xcd_barrier_complete(bar, b.x, nloc, nx); b.st[0] = nloc; b.st[1] = nx; }
        const unsigned old = xb_add(&bar[XB_XSUB(b.x)], 1u);
        const unsigned gen = old / nloc;
        if (old + 1u == (gen + 1u) * nloc) {
            __builtin_amdgcn_fence(__ATOMIC_RELEASE, "agent");
            asm volatile("s_waitcnt vmcnt(0)" ::: "memory");
            const unsigned og = xb_add(&bar[XB_TOP], 1u);
            const unsigned tg = og / nx;
            if (og + 1u == (tg + 1u) * nx) xb_add(&bar[XB_TOPGEN], 1u);
            else XB_SPIN(xb_ld(&bar[XB_TOPGEN]) == tg, bar);
            __builtin_amdgcn_fence(__ATOMIC_ACQUIRE, "agent");
            xb_add(&bar[XB_XGEN(b.x)], 1u);
            asm volatile("s_waitcnt vmcnt(0)" ::: "memory");
        } else {
            XB_SPIN(xb_ld(&bar[XB_XGEN(b.x)]) == gen, bar);
            __builtin_amdgcn_fence(__ATOMIC_ACQUIRE, "agent");
            asm volatile("s_waitcnt vmcnt(0)" ::: "memory");
        }
    }
    __syncthreads();
}

constexpr size_t WS_BARW = 1 * MiB + 768 * 1024;
constexpr int LDS_BARST = LDS_BIAS + 8704;
DI void grid_barrier(KP kp, LAS unsigned char* lds) {
    XcdBarrier b; b.bar = (unsigned*)(opq((unsigned char*)kp->ws) + WS_BARW); b.x = xb_xcc_id(); b.st = (volatile LAS unsigned*)(lds + LDS_BARST);
    xcd_barrier(b);
}

DI void p0_row(const float* src, bf16_t* XB, float* RSrow, int lane) {
    const f32x4* xr = (const f32x4*)src + lane; float s = 0.f;
#pragma unroll
    for (int j = 0; j < 4; ++j) { const f32x4 v = xr[64 * j]; s += (v[0] * v[0] + v[1] * v[1]) + (v[2] * v[2] + v[3] * v[3]);
        u32x2 w; w.x = cvt_pk_bf16(v[0], v[1]); w.y = cvt_pk_bf16(v[2], v[3]); *(u32x2*)(XB + 4 * lane + 256 * j) = w; }
    s = wave_sum(s); if (lane == 0) *RSrow = s;
}

DI void stat_phase(const Ctx& C, const float* X, bf16_t* XB, float* RS) {
    for (int row = C.gw; row < MTOK; row += C.ngw) p0_row(X + (size_t)row * DM, XB + (size_t)row * DM, RS + row, C.lane);
}

DI void p0_phase(const Ctx& C, KP kp) {
    unsigned char* ws = opq(kp->ws);
    int base = 0;
    for (int l = 0; l < 2; ++l) {
        convert_matrix_items(C, kp->in[9] + (size_t)l * DM * 2 * DFF, kp->in[8] + l * DM, DM, 2 * DFF, (bf16_t*)(ws + WS_WIN + (size_t)(2 * l) * 11 * MiB), 1, base);
        convert_matrix_items(C, kp->in[13] + (size_t)l * DM * 2 * DFF, kp->in[12] + l * DM, DM, 2 * DFF, (bf16_t*)(ws + WS_WIN + (size_t)(2 * l + 1) * 11 * MiB), 1, base);
        convert_matrix_items(C, kp->in[10] + (size_t)l * DFF * DM, nullptr, DFF, DM, (bf16_t*)(ws + WS_WOUT + (size_t)(2 * l) * 11 * HALF_MIB), 0, base);
        convert_matrix_items(C, kp->in[14] + (size_t)l * DFF * DM, nullptr, DFF, DM, (bf16_t*)(ws + WS_WOUT + (size_t)(2 * l + 1) * 11 * HALF_MIB), 0, base);
    }
    convert_matrix_items(C, kp->in[15], kp->in[11], DM, 2560, (bf16_t*)(ws + WS_WPROJ), 2, base);
    convert_matrix_items(C, kp->in[26], nullptr, DM, DM, (bf16_t*)(ws + WS_WO), 0, base);
    convert_matrix_items(C, kp->in[35], nullptr, DM, 2048, (bf16_t*)(ws + WS_WGLU), 1, base);
    {
        bf16_t* XB = (bf16_t*)(ws + WS_XN);
        for (int row = C.gw; row < MTOK; row += C.ngw) {
            const float* src = row < MPROMPT ? kp->in[0] + (size_t)row * DM : kp->in[1] + (size_t)(row - MPROMPT) * DM;
            norm_row(src, nullptr, nullptr, XB, nullptr, row, C.lane);
        }
    }
    {
        bf16_t* WG = (bf16_t*)(ws + WS_WGATE); const float* wa = kp->in[18]; const float* wx = kp->in[20];
        for (int idx = C.gtid; idx < 1024 * 512 / 2; idx += C.ngt) {
            const int nd = idx >> 8, k = (idx & 255) * 2;
            const int pn = nd >> 8, bj = (nd >> 7) & 1, j = nd & 127, ch = pn * 128 + j, hb = ch >> 6, jj = ch & 63;
            float v0 = 0.f, v1 = 0.f;
            if ((k >> 6) == hb) { const float* w = bj ? wx : wa; v0 = w[((size_t)hb * 64 + (k & 63)) * 64 + jj]; v1 = w[((size_t)hb * 64 + (k & 63) + 1) * 64 + jj]; }
            *(unsigned*)(WG + (size_t)nd * 512 + k) = cvt_pk_bf16(v0, v1);
        }
    }
    {
        bf16_t* WGC = (bf16_t*)(ws + WS_WGATEC); const float* wa = kp->in[18]; const float* wx = kp->in[20];
        for (int idx = C.gtid; idx < 1024 * 128 / 2; idx += C.ngt) {
            const int nd = idx >> 6, k = (idx & 63) * 2;
            const int pn = nd >> 8, bj = (nd >> 7) & 1, j = nd & 127, ch = pn * 128 + j, hb = ch >> 6, jj = ch & 63;
            float v0 = 0.f, v1 = 0.f;
            if ((k >> 6) == (hb & 1)) { const float* w = bj ? wx : wa; v0 = w[((size_t)hb * 64 + (k & 63)) * 64 + jj]; v1 = w[((size_t)hb * 64 + (k & 63) + 1) * 64 + jj]; }
            *(unsigned*)(WGC + (size_t)nd * 128 + k) = cvt_pk_bf16(v0, v1);
        }
    }
    {
        bf16_t* KC = (bf16_t*)(ws + WS_KC); bf16_t* VC = (bf16_t*)(ws + WS_VC); const float* ck = kp->in[4]; const float* cv = kp->in[5];
        for (int idx = C.gtid; idx < 8 * 512 * 512 / 2; idx += C.ngt) {
            const f32x2 v = *(const f32x2*)(ck + (size_t)idx * 2); *(unsigned*)(KC + (size_t)idx * 2) = cvt_pk_bf16(v[0], v[1]);
        }
        for (int idx = C.gtid; idx < 8 * 512 * 512 / 2; idx += C.ngt) {
            const int b = idx >> 17, col = (idx >> 8) & 511, pos = (idx & 255) * 2;
            const float v0 = cv[((size_t)b * 512 + pos) * 512 + col], v1 = cv[((size_t)b * 512 + pos + 1) * 512 + col];
            *(unsigned*)(VC + ((size_t)(b * 8 + (pos >> 6)) * 512 + col) * 64 + (pos & 63)) = cvt_pk_bf16(v0, v1);
        }
    }
    {
        f32x2* AP = (f32x2*)(ws + WS_AP); f32x2* BB = (f32x2*)(ws + WS_BBAR);
        const float* Are = kp->in[27]; const float* Aim = kp->in[28]; const float* Bre = kp->in[29]; const float* Bim = kp->in[30]; const float* ldt = kp->in[34];
        for (int idx = C.gtid; idx < 4096; idx += C.ngt) {
            const int g = idx >> 6; const float dt = expf(ldt[g]); const float ar = Are[idx], ai = Aim[idx];
            f32x2 a1 = {0.f, 0.f};
            for (int e = 0; e <= 16; ++e) {
                const float mag = expf((float)e * ar * dt); float sn, cs; sincosf((float)e * ai * dt, &sn, &cs);
                const f32x2 v = {mag * cs, mag * sn}; AP[idx * 17 + e] = v; if (e == 1) a1 = v;
            }
            const float nr = a1[0] - 1.0f, ni = a1[1], den = 1.0f / (ar * ar + ai * ai);
            const float cr = (nr * ar + ni * ai) * den, ci = (ni * ar - nr * ai) * den;
            for (int ch = 0; ch < 16; ++ch) { const float br = Bre[idx * 16 + ch], bi = Bim[idx * 16 + ch]; const f32x2 v = {cr * br - ci * bi, cr * bi + ci * br}; BB[idx * 16 + ch] = v; }
        }
    }
}
DI void s5_fill_phase(const Ctx& C, KP kp) {
    unsigned char* ws = opq(kp->ws);
    const f32x2* AP = (const f32x2*)(ws + WS_AP); const f32x2* BB = (const f32x2*)(ws + WS_BBAR);
    bf16_t* BTE = (bf16_t*)(ws + WS_BTE); bf16_t* BTY = (bf16_t*)(ws + WS_BTY);
    const float* Cre = kp->in[31]; const float* Cim = kp->in[32]; const float* Dsk = kp->in[33];
    for (int idx = C.gtid; idx < 64 * 256 * 256; idx += C.ngt) {
        const int g = idx >> 16, n = (idx >> 8) & 255, k = idx & 255;
        float val = 0.f;
        if (n < 128) { const int p = n & 63, j = k >> 4, ch = k & 15; const f32x2 a = AP[(g * 64 + p) * 17 + (15 - j)], b = BB[(g * 64 + p) * 16 + ch];
            val = (n < 64) ? (a[0] * b[0] - a[1] * b[1]) : (a[0] * b[1] + a[1] * b[0]); }
        BTE[idx] = (bf16_t)(cvt_pk_bf16(val, 0.f) & 0xffffu);
    }
    for (int idx = C.gtid; idx < 64 * 256 * 128; idx += C.ngt) {
        const int g = idx >> 15, n = (idx >> 7) & 255, k = idx & 127, i = n >> 4, o = n & 15, p = k & 63;
        const f32x2 a = AP[(g * 64 + p) * 17 + (i + 1)]; const float cr = Cre[((size_t)g * 16 + o) * 64 + p], ci = Cim[((size_t)g * 16 + o) * 64 + p];
        const float val = (k < 64) ? (cr * a[0] - ci * a[1]) : -(cr * a[1] + ci * a[0]);
        BTY[((size_t)g * 256 + n) * 384 + k] = (bf16_t)(cvt_pk_bf16(val, 0.f) & 0xffffu);
    }
    for (int idx = C.gtid; idx < 64 * 31 * 256; idx += C.ngt) {
        const int ch = idx & 15, o = (idx >> 4) & 15, t = idx >> 8, dd = t % 31, g = t / 31, d = dd - 15;
        if (d >= 0) {
            float T = 0.f;
            for (int p = 0; p < 64; ++p) {
                const f32x2 a = AP[(g * 64 + p) * 17 + d], b = BB[(g * 64 + p) * 16 + ch];
                const float cr = Cre[((size_t)g * 16 + o) * 64 + p], ci = Cim[((size_t)g * 16 + o) * 64 + p];
                const float abr = a[0] * b[0] - a[1] * b[1], abi = a[0] * b[1] + a[1] * b[0];
                T += cr * abr - ci * abi;
            }
            if (d == 0 && o == ch) T += Dsk[g * 16 + o];
            const bf16_t tv = (bf16_t)(cvt_pk_bf16(T, 0.f) & 0xffffu);
            for (int i = d; i < 16; ++i) BTY[((size_t)g * 256 + i * 16 + o) * 384 + 128 + (i - d) * 16 + ch] = tv;
        } else {
            for (int j = -d; j < 16; ++j) BTY[((size_t)g * 256 + (j + d) * 16 + o) * 384 + 128 + j * 16 + ch] = (bf16_t)0;
        }
    }
}
DI void conv_phase(const Ctx& C, KP kp) {
    unsigned char* ws = opq(kp->ws);
    const bf16_t* XA = (const bf16_t*)(ws + WS_XA); bf16_t* XC = (bf16_t*)(ws + WS_XC);
    const float* cw = kp->in[16]; const float* cb = kp->in[17]; const float* st = kp->in[2];
    for (int idx = C.gtid; idx < (MTOK / 8) * 64; idx += C.ngt) {
        const int row0 = (idx >> 6) * 8, c8 = (idx & 63) * 8;
        int t0, b; const bool smp = row0 >= MPROMPT;
        if (smp) { const int r = row0 - MPROMPT; b = r >> 6; t0 = r & 63; } else { b = row0 >> 13; t0 = row0 & 8191; }
        u32x4 raw[11];
#pragma unroll
        for (int j = 0; j < 11; ++j) { raw[j] = (u32x4){0u, 0u, 0u, 0u}; if (t0 - 3 + j >= 0) raw[j] = *(const u32x4*)(XA + (size_t)(row0 - 3 + j) * 512 + c8); }
        float xf[11][8];
#pragma unroll
        for (int j = 0; j < 11; ++j) { const u32x4 r = raw[j];
            xf[j][0] = __uint_as_float(r.x << 16); xf[j][1] = __uint_as_float(r.x & 0xffff0000u); xf[j][2] = __uint_as_float(r.y << 16); xf[j][3] = __uint_as_float(r.y & 0xffff0000u);
            xf[j][4] = __uint_as_float(r.z << 16); xf[j][5] = __uint_as_float(r.z & 0xffff0000u); xf[j][6] = __uint_as_float(r.w << 16); xf[j][7] = __uint_as_float(r.w & 0xffff0000u); }
        if (smp && t0 == 0) {
#pragma unroll
            for (int j = 0; j < 3; ++j) { const float* sp = st + ((size_t)b * 3 + j) * 512 + c8; const f32x4 s0 = *(const f32x4*)sp, s1 = *(const f32x4*)(sp + 4);
                xf[j][0] = s0[0]; xf[j][1] = s0[1]; xf[j][2] = s0[2]; xf[j][3] = s0[3]; xf[j][4] = s1[0]; xf[j][5] = s1[1]; xf[j][6] = s1[2]; xf[j][7] = s1[3]; }
        }
        float wgt[4][8], bias[8];
#pragma unroll
        for (int k = 0; k < 4; ++k) { const f32x4 w0 = *(const f32x4*)(cw + k * 512 + c8), w1 = *(const f32x4*)(cw + k * 512 + c8 + 4);
            wgt[k][0] = w0[0]; wgt[k][1] = w0[1]; wgt[k][2] = w0[2]; wgt[k][3] = w0[3]; wgt[k][4] = w1[0]; wgt[k][5] = w1[1]; wgt[k][6] = w1[2]; wgt[k][7] = w1[3]; }
        { const f32x4 b0 = *(const f32x4*)(cb + c8), b1 = *(const f32x4*)(cb + c8 + 4); bias[0] = b0[0]; bias[1] = b0[1]; bias[2] = b0[2]; bias[3] = b0[3]; bias[4] = b1[0]; bias[5] = b1[1]; bias[6] = b1[2]; bias[7] = b1[3]; }
#pragma unroll
        for (int r = 0; r < 8; ++r) {
            float a[8];
#pragma unroll
            for (int e2 = 0; e2 < 8; ++e2) { float v = bias[e2];
#pragma unroll
                for (int k = 0; k < 4; ++k) v += xf[r + k][e2] * wgt[k][e2];
                a[e2] = v; }
            u32x4 w; w.x = cvt_pk_bf16(a[0], a[1]); w.y = cvt_pk_bf16(a[2], a[3]); w.z = cvt_pk_bf16(a[4], a[5]); w.w = cvt_pk_bf16(a[6], a[7]);
            *(u32x4*)(XC + (size_t)(row0 + r) * 512 + c8) = w;
        }
        const int S = smp ? 64 : 8192;
        if (t0 + 8 == S) {
            float* op = (smp ? kp->out + O_SCONV : kp->out + O_PCONV) + (size_t)b * 3 * 512 + c8;
#pragma unroll
            for (int j = 0; j < 3; ++j) { *(f32x4*)(op + j * 512) = (f32x4){xf[8 + j][0], xf[8 + j][1], xf[8 + j][2], xf[8 + j][3]}; *(f32x4*)(op + j * 512 + 4) = (f32x4){xf[8 + j][4], xf[8 + j][5], xf[8 + j][6], xf[8 + j][7]}; }
        }
    }
}
#define MFMA32(a, b, c) __builtin_amdgcn_mfma_f32_32x32x16_bf16((a), (b), (c), 0, 0, 0)
DI int crow(int reg, int h) { return (reg & 3) + 8 * (reg >> 2) + 4 * h; }
DI bf16x8 pack_step(const f32x16& x, int s) {
    u32x4 p; p.x = cvt_pk_bf16(x[8 * s], x[8 * s + 1]); p.y = cvt_pk_bf16(x[8 * s + 2], x[8 * s + 3]); p.z = cvt_pk_bf16(x[8 * s + 4], x[8 * s + 5]); p.w = cvt_pk_bf16(x[8 * s + 6], x[8 * s + 7]);
    return __builtin_bit_cast(bf16x8, p);
}
DI void attn_tile_ptrs(int cs, int jt, int qrow0, int h, const bf16_t* KB, const bf16_t* VT, const bf16_t* KC, const bf16_t* VC, const char*& Kpc, const char*& Vpc) {
    if (cs < 512 || jt == 8) { const int krow = qrow0 - (8 - jt) * 64; Kpc = (const char*)(KB + (size_t)krow * 512 + h * 64); Vpc = (const char*)(VT + ((size_t)(krow >> 6) * 512 + h * 64) * 64); }
    else { const int b = cs - 512; Kpc = (const char*)(KC + ((size_t)b * 512 + jt * 64) * 512 + h * 64); Vpc = (const char*)(VC + ((size_t)(b * 8 + jt) * 512 + h * 64) * 64); }
}
DI void attn_phase(const Ctx& C, KP kp) {
    unsigned char* ws = opq(kp->ws);
    const bf16_t* Q = (const bf16_t*)(ws + WS_Q); const bf16_t* KB = (const bf16_t*)(ws + WS_KB); const bf16_t* VT = (const bf16_t*)(ws + WS_VT);
    const bf16_t* KC = (const bf16_t*)(ws + WS_KC); const bf16_t* VC = (const bf16_t*)(ws + WS_VC); bf16_t* MIX = (bf16_t*)(ws + WS_MIX);
    LAS float* bt = (LAS float*)(C.lds + LDS_BIAS);
    for (int i = C.tid; i < 257 * 8; i += 512) { const int r = i >> 3, h = i & 7; bt[h * 257 + r] = kp->in[25][i]; }
    __syncthreads();
    const int l31 = C.lane & 31, hh = C.lane >> 5;
    LAS unsigned char* kbuf = C.lds + C.wave * LDS_ATTW;
    LAS unsigned char* vbuf = kbuf + 9216;
    const unsigned kvoff = (unsigned)((C.lane >> 3) * 1024 + (C.lane & 7) * 16), vvoff = (unsigned)C.lane * 16u, loff = (unsigned)((C.lane >> 3) * 144 + (C.lane & 7) * 16);
    for (int id = C.gw; id < 8320; id += C.ngw) {
        const int qt = id & 1, wv = id >> 1;
        int h, cs;
        if (wv < 64) { h = wv & 7; cs = 512 + (wv >> 3); }
        else if (wv < 4096) { const int j = wv - 64, q = j >> 3; h = j & 7; cs = (q / 126) * 128 + 2 + (q % 126); }
        else { const int j = wv - 4096, q = j >> 3; h = j & 7; cs = (q >> 1) * 128 + (q & 1); }
        const int qrow0 = cs * 64;
        int jt0 = 0;
        if (cs < 512) { const int c = cs & 127; jt0 = c >= 8 ? 0 : 8 - c; }
        bf16x8 qf[4];
#pragma unroll
        for (int ks = 0; ks < 4; ++ks) qf[ks] = *(const bf16x8*)(Q + (size_t)(qrow0 + 32 * qt + l31) * 512 + h * 64 + 16 * ks + 8 * hh);
        f32x16 O[2];
#pragma unroll
        for (int a = 0; a < 2; ++a)
#pragma unroll
            for (int r = 0; r < 16; ++r) O[a][r] = 0.f;
        float mrun = -1e30f, lsum = 0.f;
        const LAS float* bth = bt + h * 257;
        const float cfar = bth[256];
        u32x4 kr[8], vr[8];
        { const char* Kpc; const char* Vpc; attn_tile_ptrs(cs, jt0, qrow0, h, KB, VT, KC, VC, Kpc, Vpc);
#pragma unroll
          for (int i = 0; i < 8; ++i) { kr[i] = *(const u32x4*)(Kpc + (kvoff + (unsigned)i * 8192u)); vr[i] = *(const u32x4*)(Vpc + (vvoff + (unsigned)i * 1024u)); } }
        for (int jt = jt0; jt < 9; ++jt) {
#pragma unroll
            for (int i = 0; i < 8; ++i) *(LAS u32x4*)(kbuf + loff + i * 1152) = kr[i];
#pragma unroll
            for (int i = 0; i < 8; ++i) *(LAS u32x4*)(vbuf + loff + i * 1152) = vr[i];
            if (jt < 8) { const char* Kpc; const char* Vpc; attn_tile_ptrs(cs, jt + 1, qrow0, h, KB, VT, KC, VC, Kpc, Vpc);
#pragma unroll
                for (int i = 0; i < 8; ++i) { kr[i] = *(const u32x4*)(Kpc + (kvoff + (unsigned)i * 8192u)); vr[i] = *(const u32x4*)(Vpc + (vvoff + (unsigned)i * 1024u)); } }
            f32x16 S[2];
#pragma unroll
            for (int kt = 0; kt < 2; ++kt) {
                f32x16 acc;
#pragma unroll
                for (int r = 0; r < 16; ++r) acc[r] = 0.f;
#pragma unroll
                for (int ks = 0; ks < 4; ++ks) { const bf16x8 kf = *(const LAS bf16x8*)(kbuf + (32 * kt + l31) * 144 + 32 * ks + 16 * hh); acc = MFMA32(kf, qf[ks], acc); }
                S[kt] = acc;
            }
            const int dd = 8 - jt;
            if (dd >= 3) {
#pragma unroll
                for (int kt = 0; kt < 2; ++kt)
#pragma unroll
                    for (int r = 0; r < 16; ++r) S[kt][r] += cfar;
            } else {
                int qk0 = l31 + 32 * qt - 4 * hh + 64 * dd; asm volatile("" : "+v"(qk0));
#pragma unroll
                for (int kt = 0; kt < 2; ++kt)
#pragma unroll
                    for (int r = 0; r < 16; ++r) { const int rel = qk0 - 32 * kt - ((r & 3) + 8 * (r >> 2)); const int ix = (rel > 128 ? 128 : rel) + 128; S[kt][r] += bth[ix]; }
            }
            {
                float mx = S[0][0];
#pragma unroll
                for (int r = 1; r < 16; ++r) mx = fmaxf(mx, S[0][r]);
#pragma unroll
                for (int r = 0; r < 16; ++r) mx = fmaxf(mx, S[1][r]);
                mx = fmaxf(mx, __shfl_xor(mx, 32));
                const float mn = fmaxf(mrun, mx), alpha = fexp(mrun - mn); mrun = mn;
                float ps = 0.f;
#pragma unroll
                for (int kt = 0; kt < 2; ++kt)
#pragma unroll
                    for (int r = 0; r < 16; ++r) { const float p = fexp(S[kt][r] - mn); S[kt][r] = p; ps += p; }
                lsum = lsum * alpha + ps;
#pragma unroll
                for (int dt = 0; dt < 2; ++dt)
#pragma unroll
                    for (int r = 0; r < 16; ++r) O[dt][r] *= alpha;
            }
#pragma unroll
            for (int kt = 0; kt < 2; ++kt)
#pragma unroll
                for (int s = 0; s < 2; ++s) {
                    const bf16x8 pf = pack_step(S[kt], s);
#pragma unroll
                    for (int dt = 0; dt < 2; ++dt) {
                        const LAS unsigned char* vp = vbuf + (32 * dt + l31) * 144 + (32 * kt + 16 * s + 4 * hh) * 2;
                        const u32x2 lo = *(const LAS u32x2*)vp, hi = *(const LAS u32x2*)(vp + 16);
                        u32x4 w; w.x = lo.x; w.y = lo.y; w.z = hi.x; w.w = hi.y;
                        O[dt] = MFMA32(__builtin_bit_cast(bf16x8, w), pf, O[dt]);
                    }
                }
        }
        {
            const float lt = lsum + __shfl_xor(lsum, 32), inv = 1.0f / lt;
            bf16_t* op = MIX + (size_t)(qrow0 + 32 * qt + l31) * DM + 512 + h * 64;
#pragma unroll
            for (int dt = 0; dt < 2; ++dt)
#pragma unroll
                for (int g4 = 0; g4 < 4; ++g4) {
                    u32x2 w; w.x = cvt_pk_bf16(O[dt][4 * g4] * inv, O[dt][4 * g4 + 1] * inv); w.y = cvt_pk_bf16(O[dt][4 * g4 + 2] * inv, O[dt][4 * g4 + 3] * inv);
                    *(u32x2*)(op + 32 * dt + 8 * g4 + 4 * hh) = w;
                }
        }
    }
}
DI void scan_a_phase(const Ctx& C, KP kp) {
    unsigned char* ws = opq(kp->ws); const float* AB = (const float*)(ws + WS_AB); const float* UB = (const float*)(ws + WS_UB);
    float* SP = (float*)(ws + WS_SP); float* SHs = (float*)(ws + WS_SH);
    for (int idx = C.gtid; idx < 520 * 512; idx += C.ngt) {
        const int ch = idx & 511, cs = idx >> 9; const size_t o0 = (size_t)cs * 64 * 512 + ch;
        float pp = 1.f, hv = 0.f;
#pragma unroll 1
        for (int t0 = 0; t0 < 64; t0 += 32) {
            float a[32], u[32];
#pragma unroll
            for (int i = 0; i < 32; ++i) { a[i] = AB[o0 + (size_t)(t0 + i) * 512]; u[i] = UB[o0 + (size_t)(t0 + i) * 512]; }
#pragma unroll
            for (int i = 0; i < 32; ++i) { hv = a[i] * hv + u[i]; pp *= a[i]; }
        }
        SP[idx] = pp; SHs[idx] = hv;
    }
}
DI void scan_b_phase(const Ctx& C, KP kp) {
    unsigned char* ws = opq(kp->ws); const float* AB = (const float*)(ws + WS_AB); const float* UB = (const float*)(ws + WS_UB);
    const float* SP = (const float*)(ws + WS_SP); const float* SHs = (const float*)(ws + WS_SH);
    const bf16_t* GA = (const bf16_t*)(ws + WS_GA); bf16_t* MIX = (bf16_t*)(ws + WS_MIX);
    int rnd = 0;
    for (int idx = C.gtid; idx < 520 * 512; idx += C.ngt, ++rnd) {
        const int ch = idx & 511; int cs = idx >> 9;
        if ((rnd & 1) && cs < 512) cs = (cs & ~127) | (127 - (cs & 127));
        const size_t o0 = (size_t)cs * 64 * 512 + ch;
        float hv = 0.f; bool last; float* oh;
        if (cs < 512) {
            const int c = cs & 127, b = cs >> 7;
            int j = 0;
            for (; j + 8 <= c; j += 8) { float p_[8], h_[8];
#pragma unroll
                for (int i = 0; i < 8; ++i) { const int si = (b * 128 + j + i) * 512 + ch; p_[i] = SP[si]; h_[i] = SHs[si]; }
#pragma unroll
                for (int i = 0; i < 8; ++i) hv = p_[i] * hv + h_[i]; }
            for (; j < c; ++j) { const int si = (b * 128 + j) * 512 + ch; hv = SP[si] * hv + SHs[si]; }
            last = (c == 127); oh = kp->out + O_PH + b * 512 + ch;
        } else { const int b = cs - 512; hv = kp->in[3][b * 512 + ch]; last = true; oh = kp->out + O_SH + b * 512 + ch; }
#pragma unroll 1
        for (int t0 = 0; t0 < 64; t0 += 32) {
            float a[32], u[32], g[32];
#pragma unroll
            for (int i = 0; i < 32; ++i) { a[i] = AB[o0 + (size_t)(t0 + i) * 512]; u[i] = UB[o0 + (size_t)(t0 + i) * 512]; g[i] = bf2f(GA[o0 + (size_t)(t0 + i) * 512]); }
#pragma unroll
            for (int i = 0; i < 32; ++i) { hv = a[i] * hv + u[i]; const float y = hv * gelu_tanh(g[i]); MIX[((size_t)cs * 64 + t0 + i) * DM + ch] = (bf16_t)(cvt_pk_bf16(y, 0.f) & 0xffffu); }
        }
        if (last) *oh = hv;
    }
}
DI void s5_chain_phase(const Ctx& C, KP kp) {
    unsigned char* ws = opq(kp->ws); const f32x2* AP = (const f32x2*)(ws + WS_AP); const float* E = (const float*)(ws + WS_E); bf16_t* A2 = (bf16_t*)(ws + WS_A2);
    for (int idx = C.gtid; idx < 12 * 4096; idx += C.ngt) {
        const int gp = idx & 4095, g = gp >> 6, p = gp & 63, sid = idx >> 12;
        int nsteps, chunk0; float sr = 0.f, si = 0.f; float* ore; float* oim;
        if (sid < 4) { nsteps = 512; chunk0 = sid * 512; ore = kp->out + O_PRE + sid * 4096 + gp; oim = kp->out + O_PIM + sid * 4096 + gp; }
        else { const int b = sid - 4; nsteps = 4; chunk0 = 2048 + b * 4; sr = kp->in[6][b * 4096 + gp]; si = kp->in[7][b * 4096 + gp]; ore = kp->out + O_SRE + b * 4096 + gp; oim = kp->out + O_SIM + b * 4096 + gp; }
        const f32x2 a16 = AP[gp * 17 + 16];
        const size_t r0 = (size_t)g * S5ROWS + chunk0;
        if (nsteps >= 32) {
#pragma unroll 1
        for (int c0 = 0; c0 < nsteps; c0 += 32) {
            float er[32], ei[32];
#pragma unroll
            for (int i = 0; i < 32; ++i) { er[i] = E[(r0 + c0 + i) * 128 + p]; ei[i] = E[(r0 + c0 + i) * 128 + 64 + p]; }
#pragma unroll
            for (int i = 0; i < 32; ++i) {
                bf16_t* ap = A2 + (r0 + c0 + i) * S5LDA;
                ap[p] = (bf16_t)(cvt_pk_bf16(sr, 0.f) & 0xffffu); ap[64 + p] = (bf16_t)(cvt_pk_bf16(si, 0.f) & 0xffffu);
                const float nr = a16[0] * sr - a16[1] * si + er[i], ni = a16[0] * si + a16[1] * sr + ei[i]; sr = nr; si = ni;
            }
        }
        } else
#pragma unroll 1
        for (int c0 = 0; c0 < nsteps; c0 += 4) {
            float er[4], ei[4];
#pragma unroll
            for (int i = 0; i < 4; ++i) { er[i] = E[(r0 + c0 + i) * 128 + p]; ei[i] = E[(r0 + c0 + i) * 128 + 64 + p]; }
#pragma unroll
            for (int i = 0; i < 4; ++i) {
                bf16_t* ap = A2 + (r0 + c0 + i) * S5LDA;
                ap[p] = (bf16_t)(cvt_pk_bf16(sr, 0.f) & 0xffffu); ap[64 + p] = (bf16_t)(cvt_pk_bf16(si, 0.f) & 0xffffu);
                const float nr = a16[0] * sr - a16[1] * si + er[i], ni = a16[0] * si + a16[1] * sr + ei[i]; sr = nr; si = ni;
            }
        }
        *ore = sr; *oim = si;
    }
}


constexpr int SOUT_LD = 132;
template <class F>
DI void small_gemm(const Ctx& C, const bf16_t* A, int lda, const bf16_t* Bt, int K, int nunits, const F f) {
    const int l31 = C.lane & 31, hh = C.lane >> 5, w = C.wave;
    LAS float* part = (LAS float*)C.lds;
    const int kw = K >> 3, nks = kw >> 4, k0 = w * kw;
    for (int ui = blockIdx.x; ui < nunits; ui += gridDim.x) {
        int arow0, brow[4]; { int b0_, b1_, b2_, b3_; f.unit(ui, arow0, b0_, b1_, b2_, b3_); brow[0] = b0_; brow[1] = b1_; brow[2] = b2_; brow[3] = b3_; }
        f32x16 acc[4];
#pragma unroll
        for (int t = 0; t < 4; ++t)
#pragma unroll
            for (int r = 0; r < 16; ++r) acc[t][r] = 0.f;
        const bf16_t* ap = A + (size_t)(arow0 + l31) * lda + k0 + 8 * hh;
        const bf16_t* bp[4];
#pragma unroll
        for (int t = 0; t < 4; ++t) bp[t] = Bt + (size_t)(brow[t] + l31) * K + k0 + 8 * hh;
#pragma unroll 2
        for (int ks = 0; ks < nks; ++ks) {
            const bf16x8 a = *(const bf16x8*)(ap + 16 * ks);
            bf16x8 b[4];
#pragma unroll
            for (int t = 0; t < 4; ++t) b[t] = *(const bf16x8*)(bp[t] + 16 * ks);
#pragma unroll
            for (int t = 0; t < 4; ++t) acc[t] = MFMA32(b[t], a, acc[t]);
        }
        __syncthreads();
#pragma unroll
        for (int t = 0; t < 4; ++t)
#pragma unroll
            for (int g = 0; g < 4; ++g)
                *(LAS f32x4*)(part + (w * 32 + l31) * SOUT_LD + 32 * t + 8 * g + 4 * hh) = (f32x4){acc[t][4 * g], acc[t][4 * g + 1], acc[t][4 * g + 2], acc[t][4 * g + 3]};
        __syncthreads();
#pragma unroll
        for (int it = 0; it < 2; ++it) {
            const int item = it * 512 + C.tid, row = item >> 5, c4 = item & 31;
            f32x4 s = *(const LAS f32x4*)(part + row * SOUT_LD + 4 * c4);
#pragma unroll
            for (int p = 1; p < 8; ++p) s = s + *(const LAS f32x4*)(part + (p * 32 + row) * SOUT_LD + 4 * c4);
            *(LAS f32x4*)(part + row * SOUT_LD + 4 * c4) = s;
        }
        __syncthreads();
        f.epi(ui, part, C.tid);
    }
    __syncthreads();
}
constexpr int SG_KC = 256;
constexpr int SG_LD = SG_KC * 2 + 16;
constexpr int SG_A = 0, SG_B = 64 * SG_LD, SG_OUT = SG_B + 128 * SG_LD;
static_assert(SG_OUT + 64 * SOUT_LD * 4 <= LDS_BIAS, "small-GEMM LDS map");
template <class F>
DI void small_gemm2(const Ctx& C, const bf16_t* A, int lda, const bf16_t* Bt, int K, int nunits64, const F f) {
    const int l31 = C.lane & 31, hh = C.lane >> 5, w = C.wave, rt = w >> 2, ct = w & 3;
    LAS unsigned char* lds = C.lds; LAS float* out = (LAS float*)(lds + SG_OUT);
    const int nch = K / SG_KC;
    const int prow = C.tid >> 5, ppart = C.tid & 31;
    for (int u64 = blockIdx.x; u64 < nunits64; u64 += gridDim.x) {
        const int uA = ((u64 >> 3) << 4) | ((u64 & 7) << 1);
        int arow0, brow[4]; { int b0_, b1_, b2_, b3_; f.unit(uA, arow0, b0_, b1_, b2_, b3_); brow[0] = b0_; brow[1] = b1_; brow[2] = b2_; brow[3] = b3_; }
        const bf16_t* ag = A + (size_t)(arow0 + prow) * lda + ppart * 8;
        const bf16_t* bg[8];
#pragma unroll
        for (int i = 0; i < 8; ++i) bg[i] = Bt + (size_t)(brow[i >> 1] + prow + 16 * (i & 1)) * K + ppart * 8;
        u32x4 ra[4], rb[8];
#pragma unroll
        for (int i = 0; i < 4; ++i) ra[i] = *(const u32x4*)(ag + (size_t)(16 * i) * lda);
#pragma unroll
        for (int i = 0; i < 8; ++i) rb[i] = *(const u32x4*)(bg[i]);
        f32x16 acc;
#pragma unroll
        for (int r = 0; r < 16; ++r) acc[r] = 0.f;
        for (int ch = 0; ch < nch; ++ch) {
            __syncthreads();
#pragma unroll
            for (int i = 0; i < 4; ++i) *(LAS u32x4*)(lds + SG_A + (prow + 16 * i) * SG_LD + ppart * 16) = ra[i];
#pragma unroll
            for (int i = 0; i < 8; ++i) *(LAS u32x4*)(lds + SG_B + (prow + 16 * i) * SG_LD + ppart * 16) = rb[i];
            __syncthreads();
            if (ch + 1 < nch) {
#pragma unroll
                for (int i = 0; i < 4; ++i) ra[i] = *(const u32x4*)(ag + (size_t)(16 * i) * lda + (ch + 1) * SG_KC);
#pragma unroll
                for (int i = 0; i < 8; ++i) rb[i] = *(const u32x4*)(bg[i] + (ch + 1) * SG_KC);
            }
#pragma unroll
            for (int ks = 0; ks < SG_KC / 16; ++ks) {
                const bf16x8 a = *(const LAS bf16x8*)(lds + SG_A + (32 * rt + l31) * SG_LD + 32 * ks + 16 * hh);
                const bf16x8 b = *(const LAS bf16x8*)(lds + SG_B + (32 * ct + l31) * SG_LD + 32 * ks + 16 * hh);
                acc = MFMA32(b, a, acc);
            }
        }
#pragma unroll
        for (int g = 0; g < 4; ++g) *(LAS f32x4*)(out + (32 * rt + l31) * SOUT_LD + 32 * ct + 8 * g + 4 * hh) = (f32x4){acc[4 * g], acc[4 * g + 1], acc[4 * g + 2], acc[4 * g + 3]};
        __syncthreads();
        f.epi(uA, out, C.tid); f.epi(uA + 1, out + 32 * SOUT_LD, C.tid);
    }
    __syncthreads();
}
DI void pair_rows(int q, int rowbase, int& br0, int& br1, int& br2, int& br3) { const int gb = rowbase + 256 * (q >> 1) + 64 * (q & 1); br0 = gb; br1 = gb + 32; br2 = gb + 128; br3 = gb + 160; }

struct SF_SwiGLU {
    bf16_t* HB; const float* RS;
    DI void unit(int ui, int& arow0, int& br0, int& br1, int& br2, int& br3) const { arow0 = MPROMPT + 32 * (ui & 15); pair_rows(ui >> 4, 0, br0, br1, br2, br3); }
    DI void epi(int ui, const LAS float* out, int tid) const {
        const int t = tid >> 4, c4 = tid & 15, row = MPROMPT + 32 * (ui & 15) + t, q = ui >> 4;
        const float rstd = RS ? rsqrtf(RS[row] * (1.0f / DM) + EPS) : 1.0f;
        const f32x4 g = *(const LAS f32x4*)(out + t * SOUT_LD + 4 * c4) * rstd, u = *(const LAS f32x4*)(out + t * SOUT_LD + 64 + 4 * c4) * rstd;
        u32x2 w; w.x = cvt_pk_bf16(siluf_(g[0]) * u[0], siluf_(g[1]) * u[1]); w.y = cvt_pk_bf16(siluf_(g[2]) * u[2], siluf_(g[3]) * u[3]);
        *(u32x2*)(HB + (size_t)row * DFF + 64 * q + 4 * c4) = w;
    }
};
struct SF_Residual {
    float* X; float s; const float* Rs; bf16_t* XB; float* RS;
    DI void unit(int ui, int& arow0, int& br0, int& br1, int& br2, int& br3) const { arow0 = MPROMPT + 32 * (ui & 15); const int cg = ui >> 4; br0 = 128 * cg; br1 = 128 * cg + 32; br2 = 128 * cg + 64; br3 = 128 * cg + 96; }
    DI void epi(int ui, const LAS float* out, int tid) const {
        const float sc = s; const float* const rsrc = Rs;
#pragma unroll
        for (int it = 0; it < 2; ++it) {
            const int item = it * 512 + tid, t = item >> 5, c4 = item & 31, rl = 32 * (ui & 15) + t, row = MPROMPT + rl, col = 128 * (ui >> 4) + 4 * c4;
            const f32x4 pv = *(const LAS f32x4*)(out + t * SOUT_LD + 4 * c4);
            f32x4 v = *(const f32x4*)(rsrc + (size_t)rl * DM + col); v[0] += pv[0] * sc; v[1] += pv[1] * sc; v[2] += pv[2] * sc; v[3] += pv[3] * sc;
            *(f32x4*)(X + (size_t)row * DM + col) = v;
        }
    }
};
struct SF_GLU {
    float* X; bf16_t* XB; float* RS;
    DI void unit(int ui, int& arow0, int& br0, int& br1, int& br2, int& br3) const { arow0 = MPROMPT + 32 * (ui & 15); pair_rows(ui >> 4, 0, br0, br1, br2, br3); }
    DI void epi(int ui, const LAS float* out, int tid) const {
        const int t = tid >> 4, c4 = tid & 15, row = MPROMPT + 32 * (ui & 15) + t, col = 64 * (ui >> 4) + 4 * c4;
        const f32x4 a = *(const LAS f32x4*)(out + t * SOUT_LD + 4 * c4), g = *(const LAS f32x4*)(out + t * SOUT_LD + 64 + 4 * c4);
        f32x4 v = *(const f32x4*)(X + (size_t)row * DM + col);
        v[0] += a[0] * sigmoidf_(g[0]); v[1] += a[1] * sigmoidf_(g[1]); v[2] += a[2] * sigmoidf_(g[2]); v[3] += a[3] * sigmoidf_(g[3]);
        *(f32x4*)(X + (size_t)row * DM + col) = v;
    }
};
struct SF_Gate {
    const bf16_t* XC; float* AB; float* UB; const float *ba, *bx, *lam;
    DI void unit(int ui, int& arow0, int& br0, int& br1, int& br2, int& br3) const { arow0 = MPROMPT + 32 * (ui & 15); pair_rows(ui >> 4, 0, br0, br1, br2, br3); }
    DI void epi(int ui, const LAS float* out, int tid) const {
        const int t = tid >> 4, c4 = tid & 15, row = MPROMPT + 32 * (ui & 15) + t, ch = 64 * (ui >> 4) + 4 * c4;
        const f32x4 rr = *(const LAS f32x4*)(out + t * SOUT_LD + 4 * c4) + *(const f32x4*)(ba + ch), ii = *(const LAS f32x4*)(out + t * SOUT_LD + 64 + 4 * c4) + *(const f32x4*)(bx + ch);
        const f32x4 lm = *(const f32x4*)(lam + ch);
        const size_t off = (size_t)row * 512 + ch; const u32x2 xr = *(const u32x2*)(XC + off);
        const float xc[4] = {__uint_as_float(xr.x << 16), __uint_as_float(xr.x & 0xffff0000u), __uint_as_float(xr.y << 16), __uint_as_float(xr.y & 0xffff0000u)};
        f32x4 av, uv;
#pragma unroll
        for (int e = 0; e < 4; ++e) { const float r = sigmoidf_(rr[e]), ig = sigmoidf_(ii[e]); const float la = -8.0f * log1pf(expf(-lm[e])) * r; const float a_ = fexp(la); av[e] = a_; uv[e] = __builtin_sqrtf(fmaxf(1.0f - a_ * a_, 0.0f)) * (ig * xc[e]); }
        *(f32x4*)(AB + off) = av; *(f32x4*)(UB + off) = uv;
    }
};
struct SF_QKV {
    bf16_t *XA, *GA, *Q, *KB, *VT; float* out; const float *qg, *kg; const float* RS;
    DI void unit(int ui, int& arow0, int& br0, int& br1, int& br2, int& br3) const {
        arow0 = MPROMPT + 32 * (ui & 15); const int cg = ui >> 4, pn = cg >> 1, hf = cg & 1;
        if (pn >= 4 && pn < 8) { const int b0 = 256 * pn + 64 * hf; br0 = b0; br1 = b0 + 128; br2 = b0 + 32; br3 = b0 + 160; }
        else { br0 = 128 * cg; br1 = 128 * cg + 32; br2 = 128 * cg + 64; br3 = 128 * cg + 96; }
    }
    DI void epi(int ui, const LAS float* o, int tid) const {
        const int cg = ui >> 4, pn = cg >> 1, hf = cg & 1;
#pragma unroll
        for (int it = 0; it < 2; ++it) {
            const int item = it * 512 + tid, t = item >> 5, c4 = item & 31, rl = 32 * (ui & 15) + t, row = MPROMPT + rl;
            const float rstd = RS ? rsqrtf(RS[row] * (1.0f / DM) + EPS) : 1.0f;
            f32x4 v = *(const LAS f32x4*)(o + t * SOUT_LD + 4 * c4) * rstd;
            if (pn < 4) {
                bf16_t* base = (pn < 2) ? XA : GA; u32x2 w; w.x = cvt_pk_bf16(v[0], v[1]); w.y = cvt_pk_bf16(v[2], v[3]);
                *(u32x2*)(base + (size_t)row * 512 + 128 * (cg & 3) + 4 * c4) = w;
            } else if (pn < 8) {
                const bool isq = pn < 6; const int head = (pn & 1) * 4 + 2 * hf + (c4 >> 4), dim = 4 * (c4 & 15);
                float ss = (v[0] * v[0] + v[1] * v[1]) + (v[2] * v[2] + v[3] * v[3]);
                ss += __shfl_xor(ss, 1); ss += __shfl_xor(ss, 2); ss += __shfl_xor(ss, 4); ss += __shfl_xor(ss, 8);
                const float rs = rsqrtf(ss * (1.0f / 64.0f) + EPS);
                const f32x4 gn = *(const f32x4*)((isq ? qg : kg) + dim);
                v = v * rs * gn;
                const float gs = isq ? 0.125f : 1.0f;
                u32x2 w; w.x = cvt_pk_bf16(v[0] * gs, v[1] * gs); w.y = cvt_pk_bf16(v[2] * gs, v[3] * gs);
                *(u32x2*)((isq ? Q : KB) + (size_t)row * 512 + head * 64 + dim) = w;
                if (!isq) *(f32x4*)(out + O_SK + (size_t)rl * 512 + head * 64 + dim) = v;
            } else {
                const int col = 128 * (cg & 3) + 4 * c4;
                const unsigned p01 = cvt_pk_bf16(v[0], v[1]), p23 = cvt_pk_bf16(v[2], v[3]);
                bf16_t* vp = VT + ((size_t)(row >> 6) * 512 + col) * 64 + (row & 63);
                vp[0] = (bf16_t)(p01 & 0xffffu); vp[64] = (bf16_t)(p01 >> 16); vp[128] = (bf16_t)(p23 & 0xffffu); vp[192] = (bf16_t)(p23 >> 16);
                *(f32x4*)(out + O_SV + (size_t)rl * 512 + col) = v;
            }
        }
    }
};
struct SF_S5E {
    float* E;
    DI void unit(int ui, int& arow0, int& br0, int& br1, int& br2, int& br3) const { arow0 = ui * S5ROWS + 2048; br0 = ui * 256; br1 = ui * 256 + 32; br2 = ui * 256 + 64; br3 = ui * 256 + 96; }
    DI void epi(int ui, const LAS float* out, int tid) const {
#pragma unroll
        for (int it = 0; it < 2; ++it) { const int item = it * 512 + tid, t = item >> 5, c4 = item & 31;
            *(f32x4*)(E + ((size_t)ui * S5ROWS + 2048 + t) * 128 + 4 * c4) = *(const LAS f32x4*)(out + t * SOUT_LD + 4 * c4); }
    }
};
struct SF_S5Y {
    bf16_t* Y;
    DI void unit(int ui, int& arow0, int& br0, int& br1, int& br2, int& br3) const { const int g = ui >> 1, hf = ui & 1; arow0 = g * S5ROWS + 2048; const int b0 = g * 256 + 128 * hf; br0 = b0; br1 = b0 + 32; br2 = b0 + 64; br3 = b0 + 96; }
    DI void epi(int ui, const LAS float* out, int tid) const {
        const int g = ui >> 1, hf = ui & 1;
#pragma unroll
        for (int it = 0; it < 2; ++it) { const int item = it * 512 + tid, t = item >> 5, c4 = item & 31, n = 128 * hf + 4 * c4, i16 = n >> 4, o = n & 15;
            const f32x4 v = *(const LAS f32x4*)(out + t * SOUT_LD + 4 * c4); u32x2 w; w.x = cvt_pk_bf16(v[0], v[1]); w.y = cvt_pk_bf16(v[2], v[3]);
            *(u32x2*)(Y + ((size_t)(2048 + t) * 16 + i16) * DM + 16 * g + o) = w; }
    }
};

template <class Epi, class Sched>
DI void run_gemm(LAS unsigned char* lds, const bf16_t* A, int lda, const bf16_t* Bt, int K, const Sched& S, const Epi& E) {
    pg8::Gemm g{A, Bt, K, lda};
    pg8::gemm_phase<Epi, Sched, true, true>(lds, g, S, E);
}

#ifndef PHMASK
#define PHMASK 0xffffffffu
#endif
#define PH_ON(b) (((PHMASK) >> (b)) & 1u)
__global__ void __launch_bounds__(512) fwd_megakernel(Params P) {
    extern __shared__ __attribute__((aligned(16))) unsigned char lds_raw[];
    int ph = 0;
    { volatile LAS unsigned* st_ = (volatile LAS unsigned*)((LAS unsigned char*)lds_raw + LDS_BARST); if (threadIdx.x == 0) { st_[0] = 0u; st_[1] = 0u; } __syncthreads();
      (void)xcd_barrier_post((unsigned*)(opq((unsigned char*)get_kp()->ws) + WS_BARW), st_); }
#define PHASE_BEGIN { KP kp = get_kp(); if (ph >= kp->ph_lo && ph < kp->ph_hi) { Ctx C; { int t_ = threadIdx.x; asm volatile("" : "+v"(t_)); C.tid = t_; } C.lane = C.tid & 63; C.wave = __builtin_amdgcn_readfirstlane(C.tid >> 6); \
    C.gw = blockIdx.x * 8 + C.wave; C.ngw = gridDim.x * 8; C.gtid = blockIdx.x * 512 + C.tid; C.ngt = gridDim.x * 512; C.lds = (LAS unsigned char*)lds_raw; \
    const int G = gridDim.x, c = blockIdx.x; (void)G; (void)c; \
    unsigned char* ws = opq((unsigned char*)kp->ws); float* X = opq((float*)kp->out); bf16_t* XN = (bf16_t*)(ws + WS_XN); bf16_t* HB = (bf16_t*)(ws + WS_HB); (void)X; (void)XN; (void)HB;
#define PHASE_END   if (ph + 1 < get_kp()->ph_hi) { if (ph == 0) cg::this_grid().sync(); else grid_barrier(get_kp(), C.lds); } } } ++ph;

    PHASE_BEGIN if (PH_ON(0)) p0_phase(C, get_kp()); PHASE_END
#define WIN_(i)  ((const bf16_t*)(ws + WS_WIN + (size_t)(i) * 11 * MiB))
#define WOUT_(i) ((const bf16_t*)(ws + WS_WOUT + (size_t)(i) * 11 * HALF_MIB))
#define RS_(slot) ((float*)nullptr)
#define XS_ (X + (size_t)MPROMPT * DM)
#define GEMM_FFN_IN(wi, slot)  PHASE_BEGIN if (PH_ON(2)) { pg8::StaticOrder S; S.init(MPROMPT, 2 * DFF, G, c); EpiSwiGLU E{HB, RS_(slot)}; run_gemm(C.lds, XN, DM, WIN_(wi), DM, S, E); SF_SwiGLU F{HB, RS_(slot)}; small_gemm2(C, XN, DM, WIN_(wi), DM, 352, F); } PHASE_END
#define GEMM_FFN_OUT(wi, rp, rs, xb, rsp) PHASE_BEGIN if (PH_ON(3)) { pg8::StaticOrder S; S.init(MPROMPT, DM, G, c); EpiResidual E{X, 0.5f, rp, rs, xb, rsp}; run_gemm(C.lds, HB, DFF, WOUT_(wi), DFF, S, E); SF_Residual F{X, 0.5f, rs, xb, rsp}; small_gemm2(C, HB, DFF, WOUT_(wi), DFF, 64, F); } PHASE_END
    GEMM_FFN_IN(0, 4)
    GEMM_FFN_OUT(0, kp->in[0], kp->in[1], (bf16_t*)nullptr, (float*)nullptr)
    PHASE_BEGIN norm_phase(C, X, nullptr, XN, nullptr); if (PH_ON(4)) s5_fill_phase(C, get_kp()); PHASE_END
    PHASE_BEGIN if (PH_ON(5)) { pg8::StaticOrder S; S.init(MPROMPT, 2560, G, c);
        EpiQKV E{(bf16_t*)(ws + WS_XA), (bf16_t*)(ws + WS_GA), (bf16_t*)(ws + WS_Q), (bf16_t*)(ws + WS_KB), (bf16_t*)(ws + WS_VT), X, kp->in[23], kp->in[24], RS_(0)};
        run_gemm(C.lds, XN, DM, (const bf16_t*)(ws + WS_WPROJ), DM, S, E);
        SF_QKV F{E.XA, E.GA, E.Q, E.KB, E.VT, E.out, E.qg, E.kg, E.RS}; small_gemm2(C, XN, DM, (const bf16_t*)(ws + WS_WPROJ), DM, 160, F); } PHASE_END
    PHASE_BEGIN if (PH_ON(6)) conv_phase(C, get_kp()); if (PH_ON(7)) attn_phase(C, get_kp()); PHASE_END
    PHASE_BEGIN if (PH_ON(8)) { GateOrder S; S.S.init(MPROMPT, 1024, G, c);
        EpiGate E{(const bf16_t*)(ws + WS_XC), (float*)(ws + WS_AB), (float*)(ws + WS_UB), kp->in[19], kp->in[21], kp->in[22]};
        run_gemm(C.lds, (const bf16_t*)(ws + WS_XC), 512, (const bf16_t*)(ws + WS_WGATEC), 128, S, E);
        SF_Gate F{E.XC, E.AB, E.UB, E.ba, E.bx, E.lam}; small_gemm2(C, (const bf16_t*)(ws + WS_XC), 512, (const bf16_t*)(ws + WS_WGATE), 512, 64, F); } PHASE_END
    PHASE_BEGIN if (PH_ON(9)) scan_a_phase(C, get_kp()); PHASE_END
    PHASE_BEGIN if (PH_ON(10)) scan_b_phase(C, get_kp()); PHASE_END
    PHASE_BEGIN if (PH_ON(3)) { pg8::StaticOrder S; S.init(MPROMPT, DM, G, c); EpiResidual E{X, 1.0f, X, XS_, (bf16_t*)nullptr, (float*)nullptr}; run_gemm(C.lds, (const bf16_t*)(ws + WS_MIX), DM, (const bf16_t*)(ws + WS_WO), DM, S, E); SF_Residual F{X, 1.0f, XS_, (bf16_t*)nullptr, (float*)nullptr}; small_gemm2(C, (const bf16_t*)(ws + WS_MIX), DM, (const bf16_t*)(ws + WS_WO), DM, 64, F); } PHASE_END
    PHASE_BEGIN norm_phase(C, X, nullptr, XN, nullptr); PHASE_END
    GEMM_FFN_IN(1, 1)
    GEMM_FFN_OUT(1, X, XS_, (bf16_t*)nullptr, (float*)nullptr)
    PHASE_BEGIN norm_phase(C, X, nullptr, XN, nullptr); PHASE_END
    GEMM_FFN_IN(2, 2)
    GEMM_FFN_OUT(2, X, XS_, (bf16_t*)nullptr, (float*)nullptr)
    PHASE_BEGIN if (PH_ON(1)) norm_phase(C, X, kp->in[11] + DM, nullptr, (bf16_t*)(ws + WS_A2)); PHASE_END
    PHASE_BEGIN if (PH_ON(11)) { S5Order S{G, c}; EpiS5E E{(float*)(ws + WS_E)}; run_gemm(C.lds, (const bf16_t*)(ws + WS_A2) + 128, S5LDA, (const bf16_t*)(ws + WS_BTE), 256, S, E); SF_S5E F{E.E}; small_gemm(C, (const bf16_t*)(ws + WS_A2) + 128, S5LDA, (const bf16_t*)(ws + WS_BTE), 256, 64, F); } PHASE_END
    PHASE_BEGIN if (PH_ON(12)) s5_chain_phase(C, get_kp()); PHASE_END
    PHASE_BEGIN if (PH_ON(13)) { S5Order S{G, c}; EpiS5Y E{(bf16_t*)(ws + WS_Y)}; run_gemm(C.lds, (const bf16_t*)(ws + WS_A2), S5LDA, (const bf16_t*)(ws + WS_BTY), 384, S, E); SF_S5Y F{E.Y}; small_gemm(C, (const bf16_t*)(ws + WS_A2), S5LDA, (const bf16_t*)(ws + WS_BTY), 384, 128, F); } PHASE_END
    PHASE_BEGIN if (PH_ON(14)) { pg8::StaticOrder S; S.init(MPROMPT, 2048, G, c); EpiGLU E{X, (bf16_t*)nullptr, (float*)nullptr}; run_gemm(C.lds, (const bf16_t*)(ws + WS_Y), DM, (const bf16_t*)(ws + WS_WGLU), DM, S, E); SF_GLU F{X, (bf16_t*)nullptr, (float*)nullptr}; small_gemm2(C, (const bf16_t*)(ws + WS_Y), DM, (const bf16_t*)(ws + WS_WGLU), DM, 128, F); } PHASE_END
    PHASE_BEGIN norm_phase(C, X, nullptr, XN, nullptr); PHASE_END
    GEMM_FFN_IN(3, 3)
    GEMM_FFN_OUT(3, X, XS_, (bf16_t*)nullptr, (float*)nullptr)
}
constexpr int N_PHASES = 24;

extern "C" void kernel_launch(void* const* d_in, const int* in_sizes, int n_in, void* d_out, int out_size, void* d_ws, size_t ws_size, hipStream_t stream) {
    static int grid = 0;
    if (grid == 0) {
        if (n_in != 36 || ws_size < WS_END) { fprintf(stderr, "kernel_launch: unexpected n_in %d or ws_size %zu (< %zu)\n", n_in, ws_size, (size_t)WS_END); grid = -1; return; }
        int dev = 0, cus = 0, per_cu = 0;
        hipGetDevice(&dev); hipDeviceGetAttribute(&cus, hipDeviceAttributeMultiprocessorCount, dev);
        if (hipFuncSetAttribute((const void*)fwd_megakernel, hipFuncAttributeMaxDynamicSharedMemorySize, LDS_BYTES) != hipSuccess) { fprintf(stderr, "kernel_launch: hipFuncSetAttribute failed\n"); grid = -1; return; }
        hipOccupancyMaxActiveBlocksPerMultiprocessor(&per_cu, (const void*)fwd_megakernel, 512, LDS_BYTES);
        if (per_cu < 1) { fprintf(stderr, "kernel_launch: occupancy query says %d blocks per CU\n", per_cu); per_cu = 1; }
        (void)hipGetLastError();
        grid = cus * 1;
    }
    if (grid < 0) return;
    if (hipMemsetAsync((char*)d_ws + WS_BARW, 0, 16384, stream) != hipSuccess) { fprintf(stderr, "kernel_launch: memset of barrier words failed\n"); return; }
    Params p{};
    for (int i = 0; i < 36; ++i) p.in[i] = (const float*)d_in[i];
    p.out = (float*)d_out; p.ws = (unsigned char*)d_ws; p.ph_lo = 0; p.ph_hi = N_PHASES;
    void* args[] = {&p};
    hipError_t e = hipLaunchCooperativeKernel((const void*)fwd_megakernel, dim3(grid), dim3(512), args, LDS_BYTES, stream);
    if (e != hipSuccess) fprintf(stderr, "cooperative launch failed: %s (grid %d)\n", hipGetErrorString(e), grid);
}
```

```cpp
#include <hip/hip_runtime.h>
#include <hip/hip_cooperative_groups.h>
#include <cstdio>
#include <cstdint>
namespace cg = cooperative_groups;
namespace pg8 {
#define PG8_LAS __attribute__((address_space(3)))
typedef unsigned short bf16_t;
typedef short bf16x8 __attribute__((ext_vector_type(8)));
typedef float f32x4 __attribute__((ext_vector_type(4)));
typedef unsigned u32x4 __attribute__((ext_vector_type(4)));
constexpr int BM = 256, BK = 64, HALF = 128, HTB = HALF * BK * 2  , STAGE_BYTES = 8 * HTB, NXCD = 8, WGM = 8;

__host__ __device__ __forceinline__ int lds_byte(int r, int c) { const int st = (r >> 4) * 2 + (c >> 5), rr = r & 15, cc = c & 31, ob = rr * 64 + cc * 2; return st * 1024 + (ob ^ (((ob >> 9) & 1) << 5)); }
__host__ __device__ __forceinline__ void stage_rc(int b, int& R, int& C) { const int st = b / 1024, sb = b % 1024, swz = sb ^ (((sb >> 9) & 1) << 5); R = (st >> 1) * 16 + swz / 64; C = (st & 1) * 32 + (swz % 64) / 2; }
__host__ __device__ __forceinline__ int perm32(int rho) { const int n = rho >> 4, i = rho & 15; return 8 * (i >> 2) + 4 * n + (i & 3); }

struct Unit { int pm, pn, ka; };
struct Gemm { const bf16_t* A; const bf16_t* Bt; int K, lda; };

struct StaticOrder {
    int nM, nN, nwg, G, c;
    __host__ __device__ void init(int M, int N, int G_, int c_) { nM = M / BM; nN = N / BM; nwg = nM * nN; G = G_; c = c_; }
    __host__ __device__ bool next(int i, Unit& u) const {
        const long L = (long)i * G + c; if (L >= nwg) return false;
        int wgid = (int)L; { const int q = nwg / NXCD, r = nwg % NXCD, xcd = wgid % NXCD, off = wgid / NXCD; wgid = (xcd < r ? xcd * (q + 1) : r * (q + 1) + (xcd - r) * q) + off; }
        const int nig = WGM * nN, gid = wgid / nig, fm = gid * WGM, gsz = (nM - fm) < WGM ? (nM - fm) : WGM;
        u.pm = fm + ((wgid % nig) % gsz); u.pn = (wgid % nig) / gsz; u.ka = 0; return true;
    }
    __device__ __forceinline__ void a_ready(const Unit&) const {}
    __device__ __forceinline__ void done(const Unit&) const {}
};

typedef float f32x2 __attribute__((ext_vector_type(2)));
typedef __bf16 bf16v2_t __attribute__((ext_vector_type(2)));
__device__ __forceinline__ unsigned cvt_pk_bf16(float lo, float hi) { f32x2 v = {lo, hi}; return __builtin_bit_cast(unsigned, __builtin_convertvector(v, bf16v2_t)); }
template <class Epi, class Sched, bool ALIGN_EPI = false, bool SP2 = false>
__device__ __forceinline__ void gemm_phase(PG8_LAS unsigned char* lds, const Gemm g, const Sched& S, const Epi& E) {
    int tid_ = threadIdx.x; asm volatile("" : "+v"(tid_));
    const int tid = tid_, wid = __builtin_amdgcn_readfirstlane(tid >> 6), lane = tid & 63, wr = wid >> 2, wc = wid & 3, fr = lane & 15, fq = lane >> 4;
    int K_ = g.K, lda_ = g.lda; asm volatile("" : "+s"(K_), "+s"(lda_));
    const int K = K_, lda = lda_, nt = K / BK;
    unsigned voffA[2], voffB[2];
#pragma unroll
    for (int i = 0; i < 2; ++i) { int R, C; stage_rc(tid * 16 + i * 8192, R, C); const int Rb = Epi::PERM ? ((R & ~31) + perm32(R & 31)) : R;
        voffA[i] = (unsigned)(R * lda + C) * 2u; voffB[i] = (unsigned)(Rb * K + C) * 2u; }
    const size_t kstep = (size_t)(BK * 2);
    const size_t hsA = (size_t)HALF * lda * 2, hsB = (size_t)HALF * K * 2;
    const size_t tsA = 2 * hsA, tsB = 2 * hsB;
    const unsigned ldsw = (unsigned)wid * 1024u;
    const int aoff = lds_byte(wr * 64 + fr, fq * 8), boff = lds_byte(wc * 32 + fr, fq * 8);
#define PG8_SA(b, h) (((b) * 2 + (h)) * HTB)
#define PG8_SB(b, h) ((4 + (b) * 2 + (h)) * HTB)
#define PG8_STAGE(bufoff, gbase, voff) do { _Pragma("unroll") for (int _i = 0; _i < 2; ++_i) \
        __builtin_amdgcn_global_load_lds((const unsigned*)((const char*)(gbase) + (voff)[_i]), (PG8_LAS unsigned*)(lds + (bufoff) + ldsw + _i * 8192), 16, 0, 0); } while (0)
#define PG8_LDA(dst, b, h) do { _Pragma("unroll") for (int m = 0; m < 4; ++m) _Pragma("unroll") for (int k = 0; k < 2; ++k) dst[m][k] = *(const PG8_LAS bf16x8*)(lds + PG8_SA(b, h) + aoff + m * 2048 + k * 1024); } while (0)
#define PG8_LDB(dst, b, h) do { _Pragma("unroll") for (int n = 0; n < 2; ++n) _Pragma("unroll") for (int k = 0; k < 2; ++k) dst[n][k] = *(const PG8_LAS bf16x8*)(lds + PG8_SB(b, h) + boff + n * 2048 + k * 1024); } while (0)
#define PG8_MMA(ai, bj, At, Bt) do { __builtin_amdgcn_s_setprio(1); _Pragma("unroll") for (int m = 0; m < 4; ++m) _Pragma("unroll") for (int n = 0; n < 2; ++n) _Pragma("unroll") for (int k = 0; k < 2; ++k) \
        acc[ai][bj][m][n] = __builtin_amdgcn_mfma_f32_16x16x32_bf16(Bt[n][k], At[m][k], acc[ai][bj][m][n], 0, 0, 0); __builtin_amdgcn_s_setprio(0); } while (0)
#define PG8_WAIT_V(n) asm volatile("s_waitcnt vmcnt(" #n ")" ::: "memory")
#define PG8_WAIT_L(n) asm volatile("s_waitcnt lgkmcnt(" #n ")" ::: "memory")
#define PG8_BAR __builtin_amdgcn_s_barrier()
#define PG8_SCHED __builtin_amdgcn_sched_barrier(0)
    Unit cur, nxt; int ui = 0;
    if (!S.next(0, cur)) return;
    f32x4 acc[2][2][4][2];
#pragma unroll
    for (int a = 0; a < 2; ++a)
#pragma unroll
        for (int b = 0; b < 2; ++b)
#pragma unroll
            for (int m = 0; m < 4; ++m)
#pragma unroll
                for (int n = 0; n < 2; ++n) acc[a][b][m][n] = (f32x4){0.f, 0.f, 0.f, 0.f};
    bf16x8 At[4][2], B0[2][2], B1[2][2];
    const char* cA = (const char*)g.A + (size_t)cur.pm * tsA + cur.ka; const char* cB = (const char*)g.Bt + (size_t)cur.pn * tsB;
    S.a_ready(cur);
    if constexpr (SP2) {
        PG8_STAGE(PG8_SB(0, 0), cB, voffB); PG8_STAGE(PG8_SB(0, 1), cB + hsB, voffB); PG8_STAGE(PG8_SA(0, 0), cA, voffA); PG8_STAGE(PG8_SA(0, 1), cA + hsA, voffA);
        if (wr == 1) PG8_BAR;
        PG8_WAIT_V(2); PG8_BAR;
        PG8_STAGE(PG8_SB(1, 0), cB + kstep, voffB); PG8_STAGE(PG8_SA(1, 0), cA + kstep, voffA); PG8_STAGE(PG8_SB(1, 1), cB + hsB + kstep, voffB);
        PG8_WAIT_V(6); PG8_BAR;
    } else {
        PG8_STAGE(PG8_SB(0, 0), cB, voffB); PG8_STAGE(PG8_SA(0, 0), cA, voffA); PG8_STAGE(PG8_SB(0, 1), cB + hsB, voffB); PG8_STAGE(PG8_SA(0, 1), cA + hsA, voffA);
        if (wr == 1) PG8_BAR;
        PG8_WAIT_V(4); PG8_BAR;
        PG8_STAGE(PG8_SB(1, 0), cB + kstep, voffB); PG8_STAGE(PG8_SA(1, 0), cA + kstep, voffA); PG8_STAGE(PG8_SB(1, 1), cB + hsB + kstep, voffB);
        PG8_WAIT_V(6); PG8_BAR;
    }
    for (;;) {
        const bool has_next = S.next(ui + 1, nxt);
        const char* nA = has_next ? (const char*)g.A + (size_t)nxt.pm * tsA + nxt.ka : cA; const char* nB = has_next ? (const char*)g.Bt + (size_t)nxt.pn * tsB : cB;
        for (int t = 0; t < nt; t += 2) {
            const bool last = (t == nt - 2);
            const char* a1 = cA + (size_t)(t + 1) * kstep;
            const char* a2 = last ? nA : cA + (size_t)(t + 2) * kstep; const char* b2 = last ? nB : cB + (size_t)(t + 2) * kstep;
            const char* a3 = a2 + kstep; const char* b3 = b2 + kstep;
            if (last && has_next) S.a_ready(nxt);
            if constexpr (SP2) {
            PG8_LDB(B0, 0, 0); PG8_LDB(B1, 0, 1); PG8_SCHED; PG8_LDA(At, 0, 0); PG8_STAGE(PG8_SA(1, 1), a1 + hsA, voffA);
            PG8_WAIT_V(8); PG8_WAIT_L(0); PG8_BAR; PG8_MMA(0, 0, At, B0); PG8_MMA(0, 1, At, B1); PG8_BAR; PG8_SCHED;
            PG8_LDA(At, 0, 1); PG8_STAGE(PG8_SB(0, 0), b2, voffB); PG8_STAGE(PG8_SB(0, 1), b2 + hsB, voffB); PG8_STAGE(PG8_SA(0, 0), a2, voffA);
            PG8_WAIT_V(8); PG8_WAIT_L(0); PG8_BAR; PG8_MMA(1, 0, At, B0); PG8_MMA(1, 1, At, B1); PG8_BAR; PG8_SCHED;
            PG8_LDB(B0, 1, 0); PG8_LDB(B1, 1, 1); PG8_SCHED; PG8_LDA(At, 1, 0); PG8_STAGE(PG8_SA(0, 1), a2 + hsA, voffA);
            PG8_WAIT_V(8); PG8_WAIT_L(0); PG8_BAR; PG8_MMA(0, 0, At, B0); PG8_MMA(0, 1, At, B1); PG8_BAR; PG8_SCHED;
            PG8_LDA(At, 1, 1); PG8_STAGE(PG8_SB(1, 0), b3, voffB); PG8_STAGE(PG8_SB(1, 1), b3 + hsB, voffB); PG8_STAGE(PG8_SA(1, 0), a3, voffA);
            PG8_WAIT_V(8); PG8_WAIT_L(0); PG8_BAR; PG8_MMA(1, 0, At, B0); PG8_MMA(1, 1, At, B1); PG8_BAR; PG8_SCHED;
            } else {
            PG8_LDB(B0, 0, 0); PG8_SCHED; PG8_LDA(At, 0, 0); PG8_STAGE(PG8_SA(1, 1), a1 + hsA, voffA);
            PG8_WAIT_L(8); PG8_BAR; PG8_WAIT_L(0); PG8_MMA(0, 0, At, B0); PG8_BAR; PG8_SCHED;
            PG8_LDB(B1, 0, 1); PG8_STAGE(PG8_SB(0, 0), b2, voffB);
            PG8_BAR; PG8_WAIT_L(0); PG8_MMA(0, 1, At, B1); PG8_BAR;
            PG8_LDA(At, 0, 1); PG8_STAGE(PG8_SA(0, 0), a2, voffA);
            PG8_BAR; PG8_WAIT_L(0); PG8_MMA(1, 0, At, B0); PG8_BAR; PG8_SCHED;
            PG8_STAGE(PG8_SB(0, 1), b2 + hsB, voffB);
            PG8_WAIT_V(6); PG8_BAR; PG8_MMA(1, 1, At, B1); PG8_BAR;
            PG8_LDB(B0, 1, 0); PG8_SCHED; PG8_LDA(At, 1, 0); PG8_STAGE(PG8_SA(0, 1), a2 + hsA, voffA);
            PG8_WAIT_L(8); PG8_BAR; PG8_WAIT_L(0); PG8_MMA(0, 0, At, B0); PG8_BAR; PG8_SCHED;
            PG8_LDB(B1, 1, 1); PG8_STAGE(PG8_SB(1, 0), b3, voffB);
            PG8_BAR; PG8_WAIT_L(0); PG8_MMA(0, 1, At, B1); PG8_BAR;
            PG8_LDA(At, 1, 1); PG8_STAGE(PG8_SA(1, 0), a3, voffA);
            PG8_BAR; PG8_WAIT_L(0); PG8_MMA(1, 0, At, B0); PG8_BAR; PG8_SCHED;
            PG8_STAGE(PG8_SB(1, 1), b3 + hsB, voffB);
            PG8_WAIT_V(6); PG8_BAR; PG8_MMA(1, 1, At, B1); PG8_BAR;
            }
        }
        if constexpr (ALIGN_EPI) { if (wr == 0) PG8_BAR; }
        if constexpr (!Epi::AFTER_DRAIN) { E(acc, cur, wr, wc, fr, fq); S.done(cur); }
        if (!has_next) break;
#pragma unroll
        for (int a = 0; a < 2; ++a)
#pragma unroll
            for (int b = 0; b < 2; ++b)
#pragma unroll
                for (int m = 0; m < 4; ++m)
#pragma unroll
                    for (int n = 0; n < 2; ++n) acc[a][b][m][n] = (f32x4){0.f, 0.f, 0.f, 0.f};
        cur = nxt; cA = nA; cB = nB; ++ui;
        if constexpr (ALIGN_EPI) { if (wr == 1) PG8_BAR; }
    }
    PG8_WAIT_V(0);
    if constexpr (!ALIGN_EPI) { if (wr == 0) PG8_BAR; }
    PG8_BAR;
    if constexpr (Epi::AFTER_DRAIN) { E.fused(acc, cur, wr, wc, fr, fq, lds, wid, lane); S.done(cur); }
#undef PG8_SA
#undef PG8_SB
#undef PG8_STAGE
#undef PG8_LDA
#undef PG8_LDB
#undef PG8_MMA
#undef PG8_WAIT_V
#undef PG8_WAIT_L
#undef PG8_BAR
#undef PG8_SCHED
}
}

using pg8::f32x2; using pg8::bf16_t; using pg8::bf16x8; using pg8::f32x4; using pg8::u32x4; using pg8::Unit; using pg8::cvt_pk_bf16;
#define LAS __attribute__((address_space(3)))
#define DI __device__ __forceinline__
typedef float f32x16 __attribute__((ext_vector_type(16)));
template <class T> DI T* opq(T* p) { asm volatile("" : "+s"(p)); return p; }
#define EPI_FENCE asm volatile("" ::: "memory")
typedef unsigned u32x2 __attribute__((ext_vector_type(2)));

constexpr int MTOK = 33280;
constexpr int MPROMPT = 32768;
constexpr int DM = 1024, DFF = 2816;
constexpr int NCHUNK16 = 2080;
constexpr int S5ROWS = 2304;
constexpr int S5LDA = 384;
constexpr float EPS = 1e-6f;

constexpr size_t MiB = 1u << 20;
constexpr size_t WS_AP = 0, WS_BBAR = 1 * MiB, WS_SP = 2 * MiB, WS_SH = 4 * MiB, WS_KC = 6 * MiB, WS_VC = 10 * MiB;
constexpr size_t WS_WGATEC = 14 * MiB;
constexpr size_t WS_RS = 14 * MiB + 512 * 1024;
constexpr size_t WS_WIN = 16 * MiB;
constexpr size_t WS_WOUT = 60 * MiB;
constexpr size_t WS_WPROJ = 82 * MiB, WS_WO = 87 * MiB, WS_WGLU = 89 * MiB, WS_WGATE = 93 * MiB, WS_BTE = 94 * MiB, WS_BTY = 102 * MiB;
constexpr size_t WS_XN = 114 * MiB;
constexpr size_t WS_SCR = 179 * MiB;
constexpr size_t HALF_MIB = MiB / 2;
constexpr size_t WS_HB = WS_SCR;
constexpr size_t WS_XA = WS_SCR, WS_Q = WS_SCR + 65 * HALF_MIB, WS_KB = WS_SCR + 130 * HALF_MIB, WS_VT = WS_SCR + 195 * HALF_MIB,
                 WS_GA = WS_SCR + 260 * HALF_MIB, WS_XC = WS_SCR + 325 * HALF_MIB, WS_MIX = WS_SCR + 390 * HALF_MIB;
constexpr size_t WS_AB = WS_SCR, WS_UB = WS_SCR + 65 * MiB;
constexpr size_t WS_A2 = WS_SCR, WS_E = WS_SCR + 108 * MiB, WS_Y = WS_SCR + 180 * MiB;
constexpr size_t WS_END = WS_SCR + 260 * MiB;

constexpr size_t O_Y = 0, O_PCONV = 34078720, O_PH = 34084864, O_PK = 34086912, O_PV = 35135488, O_PRE = 36184064, O_PIM = 36200448,
                 O_SCONV = 36216832, O_SH = 36229120, O_SK = 36233216, O_SV = 36495360, O_SRE = 36757504, O_SIM = 36790272;

constexpr int LDS_RING = 131072, LDS_ATTW = 18432  , LDS_BIAS = 147456, LDS_BYTES = 163840;

struct Params { const float* in[36]; float* out; unsigned char* ws; int ph_lo, ph_hi; };
typedef const __attribute__((address_space(4))) Params* KP;
DI KP get_kp() { KP p = (KP)__builtin_amdgcn_kernarg_segment_ptr(); asm volatile("" : "+s"(p)); return p; }

DI float bf2f(unsigned short b) { return __uint_as_float(((unsigned)b) << 16); }
DI float fexp(float x) { return __builtin_amdgcn_exp2f(x * 1.4426950408889634f); }
DI float sigmoidf_(float x) { return __builtin_amdgcn_rcpf(1.0f + fexp(-x)); }
DI float siluf_(float x) { return x * sigmoidf_(x); }
DI float gelu_tanh(float x) { const float y = 0.7978845608028654f * (x + 0.044715f * x * x * x); const float t = fexp(2.0f * y); const float th = 1.0f - 2.0f * __builtin_amdgcn_rcpf(t + 1.0f); return 0.5f * x * (1.0f + th); }
DI float wave_sum(float v) {
#pragma unroll
    for (int o = 1; o < 64; o <<= 1) v += __shfl_xor(v, o);
    return v;
}

struct EpiSwiGLU {
    static constexpr bool PERM = true, AFTER_DRAIN = false;
    bf16_t* O; const float* RS;
    DI void operator()(const f32x4 (&acc)[2][2][4][2], const Unit& u, int wr, int wc, int fr, int fq) const {
        const int row0 = u.pm * 256 + wr * 64 + fr, col0 = u.pn * 128 + wc * 32 + 8 * fq;
#pragma unroll
        for (int ai = 0; ai < 2; ++ai)
#pragma unroll
            for (int m = 0; m < 4; ++m) {
                bf16_t* p = O + (size_t)(row0 + ai * 128 + m * 16) * DFF + col0;
                const float rstd = RS ? rsqrtf(RS[row0 + ai * 128 + m * 16] * (1.0f / DM) + EPS) : 1.0f;
                const f32x4 g0 = acc[ai][0][m][0] * rstd, g1 = acc[ai][0][m][1] * rstd, u0 = acc[ai][1][m][0] * rstd, u1 = acc[ai][1][m][1] * rstd;
                u32x4 w;
                w.x = cvt_pk_bf16(siluf_(g0[0]) * u0[0], siluf_(g0[1]) * u0[1]); w.y = cvt_pk_bf16(siluf_(g0[2]) * u0[2], siluf_(g0[3]) * u0[3]);
                w.z = cvt_pk_bf16(siluf_(g1[0]) * u1[0], siluf_(g1[1]) * u1[1]); w.w = cvt_pk_bf16(siluf_(g1[2]) * u1[2], siluf_(g1[3]) * u1[3]);
                *(u32x4*)p = w; EPI_FENCE;
            }
    }
};
struct EpiResidual {
    static constexpr bool PERM = false, AFTER_DRAIN = false;
    float* X; float s; const float* Rp; const float* Rs; bf16_t* XB; float* RS;
    DI void operator()(const f32x4 (&acc)[2][2][4][2], const Unit& u, int wr, int wc, int fr, int fq) const {
        const int row0 = u.pm * 256 + wr * 64 + fr, col0 = u.pn * 256 + wc * 32 + 4 * fq;
        const float* R = (u.pm < 128) ? Rp : Rs - (size_t)MPROMPT * DM;
#pragma unroll
        for (int ai = 0; ai < 2; ++ai)
#pragma unroll
            for (int m = 0; m < 4; ++m) {
                const int row = row0 + ai * 128 + m * 16; const size_t off = (size_t)row * DM + col0;
#pragma unroll
                for (int bj = 0; bj < 2; ++bj)
#pragma unroll
                    for (int n = 0; n < 2; ++n) { const size_t o = off + bj * 128 + n * 16; f32x4 v = *(const f32x4*)(R + o); v = v + acc[ai][bj][m][n] * s; *(f32x4*)(X + o) = v;
 }
                if (m & 1) EPI_FENCE;
            }
    }
};
struct EpiGLU {
    static constexpr bool PERM = false, AFTER_DRAIN = false;
    float* X; bf16_t* XB; float* RS;
    DI void operator()(const f32x4 (&acc)[2][2][4][2], const Unit& u, int wr, int wc, int fr, int fq) const {
        const int row0 = u.pm * 256 + wr * 64 + fr, col0 = u.pn * 128 + wc * 32 + 4 * fq;
#pragma unroll
        for (int ai = 0; ai < 2; ++ai)
#pragma unroll
            for (int m = 0; m < 4; ++m) {
                const int row = row0 + ai * 128 + m * 16; const size_t off = (size_t)row * DM + col0;
#pragma unroll
                for (int n = 0; n < 2; ++n) { const size_t o = off + n * 16; f32x4 v = *(const f32x4*)(X + o); const f32x4 a = acc[ai][0][m][n], g = acc[ai][1][m][n];
                    v[0] += a[0] * sigmoidf_(g[0]); v[1] += a[1] * sigmoidf_(g[1]); v[2] += a[2] * sigmoidf_(g[2]); v[3] += a[3] * sigmoidf_(g[3]); *(f32x4*)(X + o) = v;
 }
                if (m & 1) EPI_FENCE;
            }
    }
};
struct EpiGate {
    static constexpr bool PERM = false, AFTER_DRAIN = false;
    const bf16_t* XC; float* AB; float* UB; const float *ba, *bx, *lam;
    DI void operator()(const f32x4 (&acc)[2][2][4][2], const Unit& u, int wr, int wc, int fr, int fq) const {
        const int row0 = u.pm * 256 + wr * 64 + fr, ch0 = u.pn * 128 + wc * 32 + 4 * fq;
#pragma unroll
        for (int n = 0; n < 2; ++n) {
            const int ch = ch0 + 16 * n;
            const f32x4 b_a = *(const f32x4*)(ba + ch), b_x = *(const f32x4*)(bx + ch), lm = *(const f32x4*)(lam + ch);
            f32x4 sp;
#pragma unroll
            for (int e = 0; e < 4; ++e) sp[e] = -8.0f * log1pf(expf(-lm[e]));
#pragma unroll
            for (int ai = 0; ai < 2; ++ai)
#pragma unroll
                for (int m = 0; m < 4; ++m) {
                    const size_t off = (size_t)(row0 + ai * 128 + m * 16) * 512 + ch;
                    const u32x2 xr = *(const u32x2*)(XC + off);
                    const float xc[4] = {__uint_as_float(xr.x << 16), __uint_as_float(xr.x & 0xffff0000u), __uint_as_float(xr.y << 16), __uint_as_float(xr.y & 0xffff0000u)};
                    const f32x4 rr = acc[ai][0][m][n] + b_a, ii = acc[ai][1][m][n] + b_x;
                    f32x4 av, uv;
#pragma unroll
                    for (int e = 0; e < 4; ++e) {
                        const float r = sigmoidf_(rr[e]), ig = sigmoidf_(ii[e]);
                        const float la = sp[e] * r;
                        const float a_ = fexp(la);
                        av[e] = a_;
                        uv[e] = __builtin_sqrtf(fmaxf(1.0f - a_ * a_, 0.0f)) * (ig * xc[e]);
                    }
                    *(f32x4*)(AB + off) = av; *(f32x4*)(UB + off) = uv; EPI_FENCE;
                }
        }
    }
};
struct EpiQKV {
    static constexpr bool PERM = true, AFTER_DRAIN = false;
    bf16_t *XA, *GA, *Q, *KB, *VT; float* out; const float *qg, *kg; const float* RS;
    DI void operator()(const f32x4 (&acc)[2][2][4][2], const Unit& u, int wr, int wc, int fr, int fq) const {
        const int pn = u.pn, row0 = u.pm * 256 + wr * 64 + fr;
        const bool needout = (u.pm >= 128) || ((u.pm & 31) >= 30);
        float* okb; float* ovb; int orow0;
        if (u.pm >= 128) { okb = out + O_SK; ovb = out + O_SV; orow0 = row0 - MPROMPT; }
        else { okb = out + O_PK; ovb = out + O_PV; orow0 = (u.pm >> 5) * 512 + ((u.pm & 31) - 30) * 256 + wr * 64 + fr; }
        if (pn < 4) {
            bf16_t* base = (pn < 2) ? XA : GA; const int col0 = (pn & 1) * 256 + wc * 32 + 8 * fq;
#pragma unroll
            for (int ai = 0; ai < 2; ++ai)
#pragma unroll
                for (int m = 0; m < 4; ++m)
#pragma unroll
                    for (int bj = 0; bj < 2; ++bj) {
                        const float rstd = RS ? rsqrtf(RS[row0 + ai * 128 + m * 16] * (1.0f / DM) + EPS) : 1.0f;
                        const f32x4 v0 = acc[ai][bj][m][0] * rstd, v1 = acc[ai][bj][m][1] * rstd; u32x4 w;
                        w.x = cvt_pk_bf16(v0[0], v0[1]); w.y = cvt_pk_bf16(v0[2], v0[3]); w.z = cvt_pk_bf16(v1[0], v1[1]); w.w = cvt_pk_bf16(v1[2], v1[3]);
                        *(u32x4*)(base + (size_t)(row0 + ai * 128 + m * 16) * 512 + col0 + bj * 128) = w; EPI_FENCE;
                    }
        } else if (pn < 8) {
            const bool isq = pn < 6; const int head = (pn & 1) * 4 + wc;
            const float* gp = isq ? qg : kg; const float gs = isq ? 0.125f : 1.0f;
            bf16_t* dst = isq ? Q : KB;
            f32x4 gn[2][2];
#pragma unroll
            for (int bj = 0; bj < 2; ++bj)
#pragma unroll
                for (int n = 0; n < 2; ++n) gn[bj][n] = *(const f32x4*)(gp + 32 * bj + 8 * fq + 4 * n);
#pragma unroll
            for (int ai = 0; ai < 2; ++ai)
#pragma unroll
                for (int m = 0; m < 4; ++m) {
                    float ss = 0.f;
                    const int rloc = ai * 128 + m * 16;
                    const float rstd = RS ? rsqrtf(RS[row0 + rloc] * (1.0f / DM) + EPS) : 1.0f;
#pragma unroll
                    for (int bj = 0; bj < 2; ++bj)
#pragma unroll
                        for (int n = 0; n < 2; ++n) { const f32x4 x = acc[ai][bj][m][n]; ss += (x[0] * x[0] + x[1] * x[1]) + (x[2] * x[2] + x[3] * x[3]); }
                    ss += __shfl_xor(ss, 16); ss += __shfl_xor(ss, 32);
                    const float rs = rstd * rsqrtf(ss * (rstd * rstd) * (1.0f / 64.0f) + EPS);
#pragma unroll
                    for (int bj = 0; bj < 2; ++bj) {
                        const f32x4 v0 = acc[ai][bj][m][0] * rs * gn[bj][0], v1 = acc[ai][bj][m][1] * rs * gn[bj][1];
                        u32x4 w; w.x = cvt_pk_bf16(v0[0] * gs, v0[1] * gs); w.y = cvt_pk_bf16(v0[2] * gs, v0[3] * gs); w.z = cvt_pk_bf16(v1[0] * gs, v1[1] * gs); w.w = cvt_pk_bf16(v1[2] * gs, v1[3] * gs);
                        *(u32x4*)(dst + (size_t)(row0 + rloc) * 512 + head * 64 + 32 * bj + 8 * fq) = w;
                        if (!isq && needout) { float* op = okb + (size_t)(orow0 + rloc) * 512 + head * 64 + 32 * bj + 8 * fq; *(f32x4*)op = v0; *(f32x4*)(op + 4) = v1; }
                    }
                    EPI_FENCE;
                }
        } else {
            const int col0 = (pn & 1) * 256 + wc * 32 + 8 * fq;
#pragma unroll
            for (int ai = 0; ai < 2; ++ai)
#pragma unroll
                for (int m = 0; m < 4; ++m) {
                    const int rloc = ai * 128 + m * 16;
#pragma unroll
                    for (int bj = 0; bj < 2; ++bj)
#pragma unroll
                        for (int n = 0; n < 2; ++n) {
                            const f32x4 v = acc[ai][bj][m][n] * (RS ? rsqrtf(RS[row0 + rloc] * (1.0f / DM) + EPS) : 1.0f); const int col = col0 + bj * 128 + 4 * n;
                            const unsigned p01 = cvt_pk_bf16(v[0], v[1]), p23 = cvt_pk_bf16(v[2], v[3]);
                            bf16_t* vp = VT + ((size_t)((row0 + rloc) >> 6) * 512 + col) * 64 + ((row0 + rloc) & 63);
                            vp[0] = (bf16_t)(p01 & 0xffffu); vp[64] = (bf16_t)(p01 >> 16); vp[128] = (bf16_t)(p23 & 0xffffu); vp[192] = (bf16_t)(p23 >> 16);
                            if (needout) *(f32x4*)(ovb + (size_t)(orow0 + rloc) * 512 + col) = v;
                        }
                    EPI_FENCE;
                }
        }
    }
};
struct EpiS5E {
    static constexpr bool PERM = false, AFTER_DRAIN = false;
    float* E;
    DI void operator()(const f32x4 (&acc)[2][2][4][2], const Unit& u, int wr, int wc, int fr, int fq) const {
        const int g = u.pn, ci0 = (u.pm - 9 * g) * 256 + wr * 64 + fr, col0 = wc * 32 + 4 * fq;
#pragma unroll
        for (int ai = 0; ai < 2; ++ai)
#pragma unroll
            for (int m = 0; m < 4; ++m) {
                const int ci = ci0 + ai * 128 + m * 16;
                if (ci < NCHUNK16) {
                    float* rp = E + ((size_t)g * S5ROWS + ci) * 128 + col0;
#pragma unroll
                    for (int n = 0; n < 2; ++n) *(f32x4*)(rp + 16 * n) = acc[ai][0][m][n];
                }
                EPI_FENCE;
            }
    }
};
struct EpiS5Y {
    static constexpr bool PERM = true, AFTER_DRAIN = false;
    bf16_t* Y;
    DI void operator()(const f32x4 (&acc)[2][2][4][2], const Unit& u, int wr, int wc, int fr, int fq) const {
        const int g = u.pn, ci0 = (u.pm - 9 * g) * 256 + wr * 64 + fr;
        bf16_t* yb = Y + (size_t)ci0 * (16 * DM) + (size_t)(wc * 2 + (fq >> 1)) * DM + 16 * g + 8 * (fq & 1);
#pragma unroll
        for (int ai = 0; ai < 2; ++ai)
#pragma unroll
            for (int m = 0; m < 4; ++m) {
                if (ci0 + ai * 128 + m * 16 < NCHUNK16) {
#pragma unroll
                    for (int bj = 0; bj < 2; ++bj) {
                        const f32x4 v0 = acc[ai][bj][m][0], v1 = acc[ai][bj][m][1]; u32x4 w;
                        w.x = cvt_pk_bf16(v0[0], v0[1]); w.y = cvt_pk_bf16(v0[2], v0[3]); w.z = cvt_pk_bf16(v1[0], v1[1]); w.w = cvt_pk_bf16(v1[2], v1[3]);
                        *(u32x4*)(yb + (size_t)(ai * 128 + m * 16) * (16 * DM) + (size_t)bj * (8 * DM)) = w;
                    }
                }
                EPI_FENCE;
            }
    }
};
struct GateOrder {
    pg8::StaticOrder S;
    DI bool next(int i, Unit& u) const { if (!S.next(i, u)) return false; u.ka = u.pn * 256; return true; }
    DI void a_ready(const Unit&) const {}
    DI void done(const Unit&) const {}
};
struct S5Order {
    int G, c;
    DI bool next(int i, Unit& u) const { const int L = i * G + c; if (L >= 512) return false; u.pn = L >> 3; u.pm = (L >> 3) * 9 + (L & 7); u.ka = 0; return true; }
    DI void a_ready(const Unit&) const {}
    DI void done(const Unit&) const {}
};

struct Ctx { int tid, lane, wave, gw, ngw, gtid, ngt; LAS unsigned char* lds; };

DI void transpose_item(const float* W, const float* gk, int K, int N, bf16_t* WT, int k0, int n0s, int n0d, LAS float* scr, int lane) {
    const float gl = gk ? gk[k0 + lane] : 1.0f;
    float r_[32];
#pragma unroll
    for (int i = 0; i < 32; ++i) r_[i] = W[(size_t)(k0 + 2 * i + (lane >> 5)) * N + n0s + (lane & 31)];
#pragma unroll
    for (int i = 0; i < 32; ++i) { const int kk = 2 * i + (lane >> 5); scr[kk * 33 + (lane & 31)] = r_[i] * __shfl(gl, kk); }
    asm volatile("s_waitcnt lgkmcnt(0)" ::: "memory");
    const int c = lane & 7;
#pragma unroll
    for (int j = 0; j < 4; ++j) { const int n = (lane >> 3) + 8 * j; const LAS float* s = scr + (8 * c) * 33 + n;
        u32x4 o; o.x = cvt_pk_bf16(s[0 * 33], s[1 * 33]); o.y = cvt_pk_bf16(s[2 * 33], s[3 * 33]); o.z = cvt_pk_bf16(s[4 * 33], s[5 * 33]); o.w = cvt_pk_bf16(s[6 * 33], s[7 * 33]);
        *(u32x4*)(WT + (size_t)(n0d + n) * K + k0 + 8 * c) = o; }
    asm volatile("s_waitcnt lgkmcnt(0)" ::: "memory");
}
DI int map_col(int kind, int N, int nd) {
    if (kind == 1) { const int pn = nd >> 8, bj = (nd >> 7) & 1, j = nd & 127; return bj * (N >> 1) + pn * 128 + j; }
    if (kind == 2 && nd >= 1024 && nd < 2048) { const int p = nd & 255, bj = p >> 7, wc = (p >> 5) & 3, j = p & 31; return (nd & ~255) + 64 * wc + 32 * bj + j; }
    return nd;
}
DI void convert_matrix_items(const Ctx& C, const float* W, const float* gk, int K, int N, bf16_t* WT, int kind, int& base) {
    const int nblk = N / 32, nitems = (K / 64) * nblk;
    LAS float* scr = (LAS float*)(C.lds + C.wave * 16384);
    int first = C.gw - (base % C.ngw); if (first < 0) first += C.ngw;
    for (int it = first; it < nitems; it += C.ngw) {
        const int kb = it / nblk, nb = it % nblk;
        transpose_item(W, gk, K, N, WT, 64 * kb, map_col(kind, N, 32 * nb), 32 * nb, scr, C.lane);
    }
    base += nitems;
}
DI void norm_row(const float* src, float* cpy, const float* g, bf16_t* XN, bf16_t* A2, int row, int lane) {
    const f32x4* xr = (const f32x4*)src + lane;
    f32x4 v[4]; float s = 0.f;
#pragma unroll
    for (int j = 0; j < 4; ++j) { v[j] = xr[64 * j]; s += (v[j][0] * v[j][0] + v[j][1] * v[j][1]) + (v[j][2] * v[j][2] + v[j][3] * v[j][3]); }
    if (cpy) {
#pragma unroll
        for (int j = 0; j < 4; ++j) ((f32x4*)cpy)[lane + 64 * j] = v[j];
    }
    const float rstd = rsqrtf(wave_sum(s) * (1.0f / DM) + EPS);
#pragma unroll
    for (int j = 0; j < 4; ++j) {
        const int col = 4 * lane + 256 * j; const f32x4 gg = g ? *(const f32x4*)(g + col) : (f32x4){1.f, 1.f, 1.f, 1.f};
        u32x2 w; w.x = cvt_pk_bf16(v[j][0] * rstd * gg[0], v[j][1] * rstd * gg[1]); w.y = cvt_pk_bf16(v[j][2] * rstd * gg[2], v[j][3] * rstd * gg[3]);
        if (XN) *(u32x2*)(XN + (size_t)row * DM + col) = w;
        else { const int grp = col >> 4, cc = col & 15, chunk = row >> 4, jj = row & 15; *(u32x2*)(A2 + ((size_t)grp * S5ROWS + chunk) * S5LDA + 128 + jj * 16 + cc) = w; }
    }
}
DI void norm_store(const f32x4 (&v)[4], float rstd, const float* g, bf16_t* XN, bf16_t* A2, int row, int lane) {
#pragma unroll
    for (int j = 0; j < 4; ++j) {
        const int col = 4 * lane + 256 * j; const f32x4 gg = g ? *(const f32x4*)(g + col) : (f32x4){1.f, 1.f, 1.f, 1.f};
        u32x2 w; w.x = cvt_pk_bf16(v[j][0] * rstd * gg[0], v[j][1] * rstd * gg[1]); w.y = cvt_pk_bf16(v[j][2] * rstd * gg[2], v[j][3] * rstd * gg[3]);
        if (XN) *(u32x2*)(XN + (size_t)row * DM + col) = w;
        else { const int grp = col >> 4, cc = col & 15, chunk = row >> 4, jj = row & 15; *(u32x2*)(A2 + ((size_t)grp * S5ROWS + chunk) * S5LDA + 128 + jj * 16 + cc) = w; }
    }
}
DI void norm_phase(const Ctx& C, float* X, const float* g, bf16_t* XN, bf16_t* A2) {
    for (int row = C.gw; row < MTOK; row += 2 * C.ngw) {
        const int row2 = row + C.ngw; const bool has2 = row2 < MTOK;
        f32x4 v0[4], v1[4]; float s0 = 0.f, s1 = 0.f;
        const f32x4* x0 = (const f32x4*)(X + (size_t)row * DM) + C.lane; const f32x4* x1 = (const f32x4*)(X + (size_t)(has2 ? row2 : row) * DM) + C.lane;
#pragma unroll
        for (int j = 0; j < 4; ++j) { v0[j] = x0[64 * j]; v1[j] = x1[64 * j]; }
#pragma unroll
        for (int j = 0; j < 4; ++j) { s0 += (v0[j][0] * v0[j][0] + v0[j][1] * v0[j][1]) + (v0[j][2] * v0[j][2] + v0[j][3] * v0[j][3]); s1 += (v1[j][0] * v1[j][0] + v1[j][1] * v1[j][1]) + (v1[j][2] * v1[j][2] + v1[j][3] * v1[j][3]); }
        const float r0 = rsqrtf(wave_sum(s0) * (1.0f / DM) + EPS), r1 = rsqrtf(wave_sum(s1) * (1.0f / DM) + EPS);
        norm_store(v0, r0, g, XN, A2, row, C.lane);
        if (has2) norm_store(v1, r1, g, XN, A2, row2, C.lane);
    }
}

#define XB_TMO      128
#define XB_XCNT(j)  (256  + 64 * (j))
#define XB_XSUB(j)  (1280 + 64 * (j))
#define XB_XGEN(j)  (2304 + 64 * (j))
#define XB_TOP      3328
#define XB_TOPGEN   3392
#define XCD_BAR_WORDS 3456
#define XB_SPIN_CAP (1u << 18)

__device__ __forceinline__ unsigned xb_ld(unsigned* p)              { return __hip_atomic_load(p, __ATOMIC_RELAXED, __HIP_MEMORY_SCOPE_AGENT); }
__device__ __forceinline__ unsigned xb_add(unsigned* p, unsigned v) { return __hip_atomic_fetch_add(p, v, __ATOMIC_RELAXED, __HIP_MEMORY_SCOPE_AGENT); }
__device__ __forceinline__ unsigned xb_xcc_id() { return (unsigned)__builtin_amdgcn_s_getreg((3 << 11) | 20) & 0xFu; }
#define XB_SPIN(cond, bar) do { unsigned _sp = 0; while (cond) { __builtin_amdgcn_s_sleep(1); \
    if ((++_sp & 255u) == 0u) { if (xb_ld(&(bar)[XB_TMO])) break; if (_sp > XB_SPIN_CAP) { atomicAdd(&(bar)[XB_TMO], 1u); break; } } } } while (0)

struct XcdBarrier {
    unsigned* bar; unsigned x;
    volatile LAS unsigned* st;
};

__device__ __forceinline__ XcdBarrier xcd_barrier_post(unsigned* bar, volatile LAS unsigned* st) {
    XcdBarrier b; b.bar = bar; b.x = xb_xcc_id(); b.st = st;
    if (threadIdx.x == 0) (void)xb_add(&bar[XB_XCNT(b.x)], 1u);
    return b;
}
__device__ __forceinline__ void xcd_barrier_complete(unsigned* bar, unsigned x, unsigned& nloc, unsigned& nx) {
    const unsigned G = gridDim.x * gridDim.y * gridDim.z;
    unsigned sum, cnt, mine, sp = 0u;
    for (;;) {
        sum = 0u; cnt = 0u; mine = 0u;
#pragma unroll
        for (unsigned j = 0; j < 16; ++j) { const unsigned c = xb_ld(&bar[XB_XCNT(j)]); sum += c; cnt += (c > 0u) ? 1u : 0u; mine = (j == x) ? c : mine; }
        if (sum == G) break;
        __builtin_amdgcn_s_sleep(1);
        if ((++sp & 255u) == 0u) { if (xb_ld(&bar[XB_TMO])) break; if (sp > XB_SPIN_CAP) { atomicAdd(&bar[XB_TMO], 1u); break; } }
    }
    nloc = mine > 0u ? mine : 1u; nx = cnt > 0u ? cnt : 1u;
}

__device__ __forceinline__ void xcd_barrier(const XcdBarrier& b) {
    asm volatile("s_waitcnt vmcnt(0)" ::: "memory");
    __syncthreads();
    if (threadIdx.x == 0) {
        unsigned* bar = b.bar;
        __builtin_amdgcn_s_waitcnt(0);
        unsigned nloc = b.st[0], nx = b.st[1];
        if (nloc == 0u) { xcd_barrier_complete(bar, b.x, nloc, nx); b.st[0] = nloc; b.st[1] = nx; }
        const unsigned old = xb_add(&bar[XB_XSUB(b.x)], 1u);
        const unsigned gen = old / nloc;
        if (old + 1u == (gen + 1u) * nloc) {
            __builtin_amdgcn_fence(__ATOMIC_RELEASE, "agent");
            asm volatile("s_waitcnt vmcnt(0)" ::: "memory");
            const unsigned og = xb_add(&bar[XB_TOP], 1u);
            const unsigned tg = og / nx;
            if (og + 1u == (tg + 1u) * nx) xb_add(&bar[XB_TOPGEN], 1u);
            else XB_SPIN(xb_ld(&bar[XB_TOPGEN]) == tg, bar);
            __builtin_amdgcn_fence(__ATOMIC_ACQUIRE, "agent");
            xb_add(&bar[XB_XGEN(b.x)], 1u);
            asm volatile("s_waitcnt vmcnt(0)" ::: "memory");
        } else {
            XB_SPIN(xb_ld(&bar[XB_XGEN(b.x)]) == gen, bar);
            __builtin_amdgcn_fence(__ATOMIC_ACQUIRE, "agent");
            asm volatile("s_waitcnt vmcnt(0)" ::: "memory");
        }
    }
    __syncthreads();
}

constexpr size_t WS_BARW = 1 * MiB + 768 * 1024;
constexpr int LDS_BARST = LDS_BIAS + 8704;
DI void grid_barrier(KP kp, LAS unsigned char* lds) {
    XcdBarrier b; b.bar = (unsigned*)(opq((unsigned char*)kp->ws) + WS_BARW); b.x = xb_xcc_id(); b.st = (volatile LAS unsigned*)(lds + LDS_BARST);
    xcd_barrier(b);
}

DI void p0_row(const float* src, bf16_t* XB, float* RSrow, int lane) {
    const f32x4* xr = (const f32x4*)src + lane; float s = 0.f;
#pragma unroll
    for (int j = 0; j < 4; ++j) { const f32x4 v = xr[64 * j]; s += (v[0] * v[0] + v[1] * v[1]) + (v[2] * v[2] + v[3] * v[3]);
        u32x2 w; w.x = cvt_pk_bf16(v[0], v[1]); w.y = cvt_pk_bf16(v[2], v[3]); *(u32x2*)(XB + 4 * lane + 256 * j) = w; }
    s = wave_sum(s); if (lane == 0) *RSrow = s;
}

DI void stat_phase(const Ctx& C, const float* X, bf16_t* XB, float* RS) {
    for (int row = C.gw; row < MTOK; row += C.ngw) p0_row(X + (size_t)row * DM, XB + (size_t)row * DM, RS + row, C.lane);
}

DI void p0_phase(const Ctx& C, KP kp) {
    unsigned char* ws = opq(kp->ws);
    int base = 0;
    for (int l = 0; l < 2; ++l) {
        convert_matrix_items(C, kp->in[9] + (size_t)l * DM * 2 * DFF, kp->in[8] + l * DM, DM, 2 * DFF, (bf16_t*)(ws + WS_WIN + (size_t)(2 * l) * 11 * MiB), 1, base);
        convert_matrix_items(C, kp->in[13] + (size_t)l * DM * 2 * DFF, kp->in[12] + l * DM, DM, 2 * DFF, (bf16_t*)(ws + WS_WIN + (size_t)(2 * l + 1) * 11 * MiB), 1, base);
        convert_matrix_items(C, kp->in[10] + (size_t)l * DFF * DM, nullptr, DFF, DM, (bf16_t*)(ws + WS_WOUT + (size_t)(2 * l) * 11 * HALF_MIB), 0, base);
        convert_matrix_items(C, kp->in[14] + (size_t)l * DFF * DM, nullptr, DFF, DM, (bf16_t*)(ws + WS_WOUT + (size_t)(2 * l + 1) * 11 * HALF_MIB), 0, base);
    }
    convert_matrix_items(C, kp->in[15], kp->in[11], DM, 2560, (bf16_t*)(ws + WS_WPROJ), 2, base);
    convert_matrix_items(C, kp->in[26], nullptr, DM, DM, (bf16_t*)(ws + WS_WO), 0, base);
    convert_matrix_items(C, kp->in[35], nullptr, DM, 2048, (bf16_t*)(ws + WS_WGLU), 1, base);
    {
        bf16_t* XB = (bf16_t*)(ws + WS_XN);
        for (int row = C.gw; row < MTOK; row += C.ngw) {
            const float* src = row < MPROMPT ? kp->in[0] + (size_t)row * DM : kp->in[1] + (size_t)(row - MPROMPT) * DM;
            norm_row(src, nullptr, nullptr, XB, nullptr, row, C.lane);
        }
    }
    {
        bf16_t* WG = (bf16_t*)(ws + WS_WGATE); const float* wa = kp->in[18]; const float* wx = kp->in[20];
        for (int idx = C.gtid; idx < 1024 * 512 / 2; idx += C.ngt) {
            const int nd = idx >> 8, k = (idx & 255) * 2;
            const int pn = nd >> 8, bj = (nd >> 7) & 1, j = nd & 127, ch = pn * 128 + j, hb = ch >> 6, jj = ch & 63;
            float v0 = 0.f, v1 = 0.f;
            if ((k >> 6) == hb) { const float* w = bj ? wx : wa; v0 = w[((size_t)hb * 64 + (k & 63)) * 64 + jj]; v1 = w[((size_t)hb * 64 + (k & 63) + 1) * 64 + jj]; }
            *(unsigned*)(WG + (size_t)nd * 512 + k) = cvt_pk_bf16(v0, v1);
        }
    }
    {
        bf16_t* WGC = (bf16_t*)(ws + WS_WGATEC); const float* wa = kp->in[18]; const float* wx = kp->in[20];
        for (int idx = C.gtid; idx < 1024 * 128 / 2; idx += C.ngt) {
            const int nd = idx >> 6, k = (idx & 63) * 2;
            const int pn = nd >> 8, bj = (nd >> 7) & 1, j = nd & 127, ch = pn * 128 + j, hb = ch >> 6, jj = ch & 63;
            float v0 = 0.f, v1 = 0.f;
            if ((k >> 6) == (hb & 1)) { const float* w = bj ? wx : wa; v0 = w[((size_t)hb * 64 + (k & 63)) * 64 + jj]; v1 = w[((size_t)hb * 64 + (k & 63) + 1) * 64 + jj]; }
            *(unsigned*)(WGC + (size_t)nd * 128 + k) = cvt_pk_bf16(v0, v1);
        }
    }
    {
        bf16_t* KC = (bf16_t*)(ws + WS_KC); bf16_t* VC = (bf16_t*)(ws + WS_VC); const float* ck = kp->in[4]; const float* cv = kp->in[5];
        for (int idx = C.gtid; idx < 8 * 512 * 512 / 2; idx += C.ngt) {
            const f32x2 v = *(const f32x2*)(ck + (size_t)idx * 2); *(unsigned*)(KC + (size_t)idx * 2) = cvt_pk_bf16(v[0], v[1]);
        }
        for (int idx = C.gtid; idx < 8 * 512 * 512 / 2; idx += C.ngt) {
            const int b = idx >> 17, col = (idx >> 8) & 511, pos = (idx & 255) * 2;
            const float v0 = cv[((size_t)b * 512 + pos) * 512 + col], v1 = cv[((size_t)b * 512 + pos + 1) * 512 + col];
            *(unsigned*)(VC + ((size_t)(b * 8 + (pos >> 6)) * 512 + col) * 64 + (pos & 63)) = cvt_pk_bf16(v0, v1);
        }
    }
    {
        f32x2* AP = (f32x2*)(ws + WS_AP); f32x2* BB = (f32x2*)(ws + WS_BBAR);
        const float* Are = kp->in[27]; const float* Aim = kp->in[28]; const float* Bre = kp->in[29]; const float* Bim = kp->in[30]; const float* ldt = kp->in[34];
        for (int idx = C.gtid; idx < 4096; idx += C.ngt) {
            const int g = idx >> 6; const float dt = expf(ldt[g]); const float ar = Are[idx], ai = Aim[idx];
            f32x2 a1 = {0.f, 0.f};
            for (int e = 0; e <= 16; ++e) {
                const float mag = expf((float)e * ar * dt); float sn, cs; sincosf((float)e * ai * dt, &sn, &cs);
                const f32x2 v = {mag * cs, mag * sn}; AP[idx * 17 + e] = v; if (e == 1) a1 = v;
            }
            const float nr = a1[0] - 1.0f, ni = a1[1], den = 1.0f / (ar * ar + ai * ai);
            const float cr = (nr * ar + ni * ai) * den, ci = (ni * ar - nr * ai) * den;
            for (int ch = 0; ch < 16; ++ch) { const float br = Bre[idx * 16 + ch], bi = Bim[idx * 16 + ch]; const f32x2 v = {cr * br - ci * bi, cr * bi + ci * br}; BB[idx * 16 + ch] = v; }
        }
    }
}
DI void s5_fill_phase(const Ctx& C, KP kp) {
    unsigned char* ws = opq(kp->ws);
    const f32x2* AP = (const f32x2*)(ws + WS_AP); const f32x2* BB = (const f32x2*)(ws + WS_BBAR);
    bf16_t* BTE = (bf16_t*)(ws + WS_BTE); bf16_t* BTY = (bf16_t*)(ws + WS_BTY);
    const float* Cre = kp->in[31]; const float* Cim = kp->in[32]; const float* Dsk = kp->in[33];
    for (int idx = C.gtid; idx < 64 * 256 * 256; idx += C.ngt) {
        const int g = idx >> 16, n = (idx >> 8) & 255, k = idx & 255;
        float val = 0.f;
        if (n < 128) { const int p = n & 63, j = k >> 4, ch = k & 15; const f32x2 a = AP[(g * 64 + p) * 17 + (15 - j)], b = BB[(g * 64 + p) * 16 + ch];
            val = (n < 64) ? (a[0] * b[0] - a[1] * b[1]) : (a[0] * b[1] + a[1] * b[0]); }
        BTE[idx] = (bf16_t)(cvt_pk_bf16(val, 0.f) & 0xffffu);
    }
    for (int idx = C.gtid; idx < 64 * 256 * 128; idx += C.ngt) {
        const int g = idx >> 15, n = (idx >> 7) & 255, k = idx & 127, i = n >> 4, o = n & 15, p = k & 63;
        const f32x2 a = AP[(g * 64 + p) * 17 + (i + 1)]; const float cr = Cre[((size_t)g * 16 + o) * 64 + p], ci = Cim[((size_t)g * 16 + o) * 64 + p];
        const float val = (k < 64) ? (cr * a[0] - ci * a[1]) : -(cr * a[1] + ci * a[0]);
        BTY[((size_t)g * 256 + n) * 384 + k] = (bf16_t)(cvt_pk_bf16(val, 0.f) & 0xffffu);
    }
    for (int idx = C.gtid; idx < 64 * 31 * 256; idx += C.ngt) {
        const int ch = idx & 15, o = (idx >> 4) & 15, t = idx >> 8, dd = t % 31, g = t / 31, d = dd - 15;
        if (d >= 0) {
            float T = 0.f;
            for (int p = 0; p < 64; ++p) {
                const f32x2 a = AP[(g * 64 + p) * 17 + d], b = BB[(g * 64 + p) * 16 + ch];
                const float cr = Cre[((size_t)g * 16 + o) * 64 + p], ci = Cim[((size_t)g * 16 + o) * 64 + p];
                const float abr = a[0] * b[0] - a[1] * b[1], abi = a[0] * b[1] + a[1] * b[0];
                T += cr * abr - ci * abi;
            }
            if (d == 0 && o == ch) T += Dsk[g * 16 + o];
            const bf16_t tv = (bf16_t)(cvt_pk_bf16(T, 0.f) & 0xffffu);
            for (int i = d; i < 16; ++i) BTY[((size_t)g * 256 + i * 16 + o) * 384 + 128 + (i - d) * 16 + ch] = tv;
        } else {
            for (int j = -d; j < 16; ++j) BTY[((size_t)g * 256 + (j + d) * 16 + o) * 384 + 128 + j * 16 + ch] = (bf16_t)0;
        }
    }
}
DI void conv_phase(const Ctx& C, KP kp) {
    unsigned char* ws = opq(kp->ws);
    const bf16_t* XA = (const bf16_t*)(ws + WS_XA); bf16_t* XC = (bf16_t*)(ws + WS_XC);
    const float* cw = kp->in[16]; const float* cb = kp->in[17]; const float* st = kp->in[2];
    for (int idx = C.gtid; idx < (MTOK / 8) * 64; idx += C.ngt) {
        const int row0 = (idx >> 6) * 8, c8 = (idx & 63) * 8;
        int t0, b; const bool smp = row0 >= MPROMPT;
        if (smp) { const int r = row0 - MPROMPT; b = r >> 6; t0 = r & 63; } else { b = row0 >> 13; t0 = row0 & 8191; }
        u32x4 raw[11];
#pragma unroll
        for (int j = 0; j < 11; ++j) { raw[j] = (u32x4){0u, 0u, 0u, 0u}; if (t0 - 3 + j >= 0) raw[j] = *(const u32x4*)(XA + (size_t)(row0 - 3 + j) * 512 + c8); }
        float xf[11][8];
#pragma unroll
        for (int j = 0; j < 11; ++j) { const u32x4 r = raw[j];
            xf[j][0] = __uint_as_float(r.x << 16); xf[j][1] = __uint_as_float(r.x & 0xffff0000u); xf[j][2] = __uint_as_float(r.y << 16); xf[j][3] = __uint_as_float(r.y & 0xffff0000u);
            xf[j][4] = __uint_as_float(r.z << 16); xf[j][5] = __uint_as_float(r.z & 0xffff0000u); xf[j][6] = __uint_as_float(r.w << 16); xf[j][7] = __uint_as_float(r.w & 0xffff0000u); }
        if (smp && t0 == 0) {
#pragma unroll
            for (int j = 0; j < 3; ++j) { const float* sp = st + ((size_t)b * 3 + j) * 512 + c8; const f32x4 s0 = *(const f32x4*)sp, s1 = *(const f32x4*)(sp + 4);
                xf[j][0] = s0[0]; xf[j][1] = s0[1]; xf[j][2] = s0[2]; xf[j][3] = s0[3]; xf[j][4] = s1[0]; xf[j][5] = s1[1]; xf[j][6] = s1[2]; xf[j][7] = s1[3]; }
        }
        float wgt[4][8], bias[8];
#pragma unroll
        for (int k = 0; k < 4; ++k) { const f32x4 w0 = *(const f32x4*)(cw + k * 512 + c8), w1 = *(const f32x4*)(cw + k * 512 + c8 + 4);
            wgt[k][0] = w0[0]; wgt[k][1] = w0[1]; wgt[k][2] = w0[2]; wgt[k][3] = w0[3]; wgt[k][4] = w1[0]; wgt[k][5] = w1[1]; wgt[k][6] = w1[2]; wgt[k][7] = w1[3]; }
        { const f32x4 b0 = *(const f32x4*)(cb + c8), b1 = *(const f32x4*)(cb + c8 + 4); bias[0] = b0[0]; bias[1] = b0[1]; bias[2] = b0[2]; bias[3] = b0[3]; bias[4] = b1[0]; bias[5] = b1[1]; bias[6] = b1[2]; bias[7] = b1[3]; }
#pragma unroll
        for (int r = 0; r < 8; ++r) {
            float a[8];
#pragma unroll
            for (int e2 = 0; e2 < 8; ++e2) { float v = bias[e2];
#pragma unroll
                for (int k = 0; k < 4; ++k) v += xf[r + k][e2] * wgt[k][e2];
                a[e2] = v; }
            u32x4 w; w.x = cvt_pk_bf16(a[0], a[1]); w.y = cvt_pk_bf16(a[2], a[3]); w.z = cvt_pk_bf16(a[4], a[5]); w.w = cvt_pk_bf16(a[6], a[7]);
            *(u32x4*)(XC + (size_t)(row0 + r) * 512 + c8) = w;
        }
        const int S = smp ? 64 : 8192;
        if (t0 + 8 == S) {
            float* op = (smp ? kp->out + O_SCONV : kp->out + O_PCONV) + (size_t)b * 3 * 512 + c8;
#pragma unroll
            for (int j = 0; j < 3; ++j) { *(f32x4*)(op + j * 512) = (f32x4){xf[8 + j][0], xf[8 + j][1], xf[8 + j][2], xf[8 + j][3]}; *(f32x4*)(op + j * 512 + 4) = (f32x4){xf[8 + j][4], xf[8 + j][5], xf[8 + j][6], xf[8 + j][7]}; }
        }
    }
}
#define MFMA32(a, b, c) __builtin_amdgcn_mfma_f32_32x32x16_bf16((a), (b), (c), 0, 0, 0)
DI int crow(int reg, int h) { return (reg & 3) + 8 * (reg >> 2) + 4 * h; }
DI bf16x8 pack_step(const f32x16& x, int s) {
    u32x4 p; p.x = cvt_pk_bf16(x[8 * s], x[8 * s + 1]); p.y = cvt_pk_bf16(x[8 * s + 2], x[8 * s + 3]); p.z = cvt_pk_bf16(x[8 * s + 4], x[8 * s + 5]); p.w = cvt_pk_bf16(x[8 * s + 6], x[8 * s + 7]);
    return __builtin_bit_cast(bf16x8, p);
}
DI void attn_tile_ptrs(int cs, int jt, int qrow0, int h, const bf16_t* KB, const bf16_t* VT, const bf16_t* KC, const bf16_t* VC, const char*& Kpc, const char*& Vpc) {
    if (cs < 512 || jt == 8) { const int krow = qrow0 - (8 - jt) * 64; Kpc = (const char*)(KB + (size_t)krow * 512 + h * 64); Vpc = (const char*)(VT + ((size_t)(krow >> 6) * 512 + h * 64) * 64); }
    else { const int b = cs - 512; Kpc = (const char*)(KC + ((size_t)b * 512 + jt * 64) * 512 + h * 64); Vpc = (const char*)(VC + ((size_t)(b * 8 + jt) * 512 + h * 64) * 64); }
}
DI void attn_phase(const Ctx& C, KP kp) {
    unsigned char* ws = opq(kp->ws);
    const bf16_t* Q = (const bf16_t*)(ws + WS_Q); const bf16_t* KB = (const bf16_t*)(ws + WS_KB); const bf16_t* VT = (const bf16_t*)(ws + WS_VT);
    const bf16_t* KC = (const bf16_t*)(ws + WS_KC); const bf16_t* VC = (const bf16_t*)(ws + WS_VC); bf16_t* MIX = (bf16_t*)(ws + WS_MIX);
    LAS float* bt = (LAS float*)(C.lds + LDS_BIAS);
    for (int i = C.tid; i < 257 * 8; i += 512) { const int r = i >> 3, h = i & 7; bt[h * 257 + r] = kp->in[25][i]; }
    __syncthreads();
    const int l31 = C.lane & 31, hh = C.lane >> 5;
    LAS unsigned char* kbuf = C.lds + C.wave * LDS_ATTW;
    LAS unsigned char* vbuf = kbuf + 9216;
    const unsigned kvoff = (unsigned)((C.lane >> 3) * 1024 + (C.lane & 7) * 16), vvoff = (unsigned)C.lane * 16u, loff = (unsigned)((C.lane >> 3) * 144 + (C.lane & 7) * 16);
    for (int id = C.gw; id < 8320; id += C.ngw) {
        const int qt = id & 1, wv = id >> 1;
        int h, cs;
        if (wv < 64) { h = wv & 7; cs = 512 + (wv >> 3); }
        else if (wv < 4096) { const int j = wv - 64, q = j >> 3; h = j & 7; cs = (q / 126) * 128 + 2 + (q % 126); }
        else { const int j = wv - 4096, q = j >> 3; h = j & 7; cs = (q >> 1) * 128 + (q & 1); }
        const int qrow0 = cs * 64;
        int jt0 = 0;
        if (cs < 512) { const int c = cs & 127; jt0 = c >= 8 ? 0 : 8 - c; }
        bf16x8 qf[4];
#pragma unroll
        for (int ks = 0; ks < 4; ++ks) qf[ks] = *(const bf16x8*)(Q + (size_t)(qrow0 + 32 * qt + l31) * 512 + h * 64 + 16 * ks + 8 * hh);
        f32x16 O[2];
#pragma unroll
        for (int a = 0; a < 2; ++a)
#pragma unroll
            for (int r = 0; r < 16; ++r) O[a][r] = 0.f;
        float mrun = -1e30f, lsum = 0.f;
        const LAS float* bth = bt + h * 257;
        const float cfar = bth[256];
        u32x4 kr[8], vr[8];
        { const char* Kpc; const char* Vpc; attn_tile_ptrs(cs, jt0, qrow0, h, KB, VT, KC, VC, Kpc, Vpc);
#pragma unroll
          for (int i = 0; i < 8; ++i) { kr[i] = *(const u32x4*)(Kpc + (kvoff + (unsigned)i * 8192u)); vr[i] = *(const u32x4*)(Vpc + (vvoff + (unsigned)i * 1024u)); } }
        for (int jt = jt0; jt < 9; ++jt) {
#pragma unroll
            for (int i = 0; i < 8; ++i) *(LAS u32x4*)(kbuf + loff + i * 1152) = kr[i];
#pragma unroll
            for (int i = 0; i < 8; ++i) *(LAS u32x4*)(vbuf + loff + i * 1152) = vr[i];
            if (jt < 8) { const char* Kpc; const char* Vpc; attn_tile_ptrs(cs, jt + 1, qrow0, h, KB, VT, KC, VC, Kpc, Vpc);
#pragma unroll
                for (int i = 0; i < 8; ++i) { kr[i] = *(const u32x4*)(Kpc + (kvoff + (unsigned)i * 8192u)); vr[i] = *(const u32x4*)(Vpc + (vvoff + (unsigned)i * 1024u)); } }
            f32x16 S[2];
#pragma unroll
            for (int kt = 0; kt < 2; ++kt) {
                f32x16 acc;
#pragma unroll
                for (int r = 0; r < 16; ++r) acc[r] = 0.f;
#pragma unroll
                for (int ks = 0; ks < 4; ++ks) { const bf16x8 kf = *(const LAS bf16x8*)(kbuf + (32 * kt + l31) * 144 + 32 * ks + 16 * hh); acc = MFMA32(kf, qf[ks], acc); }
                S[kt] = acc;
            }
            const int dd = 8 - jt;
            if (dd >= 3) {
#pragma unroll
                for (int kt = 0; kt < 2; ++kt)
#pragma unroll
                    for (int r = 0; r < 16; ++r) S[kt][r] += cfar;
            } else {
                int qk0 = l31 + 32 * qt - 4 * hh + 64 * dd; asm volatile("" : "+v"(qk0));
#pragma unroll
                for (int kt = 0; kt < 2; ++kt)
#pragma unroll
                    for (int r = 0; r < 16; ++r) { const int rel = qk0 - 32 * kt - ((r & 3) + 8 * (r >> 2)); const int ix = (rel > 128 ? 128 : rel) + 128; S[kt][r] += bth[ix]; }
            }
            {
                float mx = S[0][0];
#pragma unroll
                for (int r = 1; r < 16; ++r) mx = fmaxf(mx, S[0][r]);
#pragma unroll
                for (int r = 0; r < 16; ++r) mx = fmaxf(mx, S[1][r]);
                mx = fmaxf(mx, __shfl_xor(mx, 32));
                const float mn = fmaxf(mrun, mx), alpha = fexp(mrun - mn); mrun = mn;
                float ps = 0.f;
#pragma unroll
                for (int kt = 0; kt < 2; ++kt)
#pragma unroll
                    for (int r = 0; r < 16; ++r) { const float p = fexp(S[kt][r] - mn); S[kt][r] = p; ps += p; }
                lsum = lsum * alpha + ps;
#pragma unroll
                for (int dt = 0; dt < 2; ++dt)
#pragma unroll
                    for (int r = 0; r < 16; ++r) O[dt][r] *= alpha;
            }
#pragma unroll
            for (int kt = 0; kt < 2; ++kt)
#pragma unroll
                for (int s = 0; s < 2; ++s) {
                    const bf16x8 pf = pack_step(S[kt], s);
#pragma unroll
                    for (int dt = 0; dt < 2; ++dt) {
                        const LAS unsigned char* vp = vbuf + (32 * dt + l31) * 144 + (32 * kt + 16 * s + 4 * hh) * 2;
                        const u32x2 lo = *(const LAS u32x2*)vp, hi = *(const LAS u32x2*)(vp + 16);
                        u32x4 w; w.x = lo.x; w.y = lo.y; w.z = hi.x; w.w = hi.y;
                        O[dt] = MFMA32(__builtin_bit_cast(bf16x8, w), pf, O[dt]);
                    }
                }
        }
        {
            const float lt = lsum + __shfl_xor(lsum, 32), inv = 1.0f / lt;
            bf16_t* op = MIX + (size_t)(qrow0 + 32 * qt + l31) * DM + 512 + h * 64;
#pragma unroll
            for (int dt = 0; dt < 2; ++dt)
#pragma unroll
                for (int g4 = 0; g4 < 4; ++g4) {
                    u32x2 w; w.x = cvt_pk_bf16(O[dt][4 * g4] * inv, O[dt][4 * g4 + 1] * inv); w.y = cvt_pk_bf16(O[dt][4 * g4 + 2] * inv, O[dt][4 * g4 + 3] * inv);
                    *(u32x2*)(op + 32 * dt + 8 * g4 + 4 * hh) = w;
                }
        }
    }
}
DI void scan_a_phase(const Ctx& C, KP kp) {
    unsigned char* ws = opq(kp->ws); const float* AB = (const float*)(ws + WS_AB); const float* UB = (const float*)(ws + WS_UB);
    float* SP = (float*)(ws + WS_SP); float* SHs = (float*)(ws + WS_SH);
    for (int idx = C.gtid; idx < 520 * 512; idx += C.ngt) {
        const int ch = idx & 511, cs = idx >> 9; const size_t o0 = (size_t)cs * 64 * 512 + ch;
        float pp = 1.f, hv = 0.f;
#pragma unroll 1
        for (int t0 = 0; t0 < 64; t0 += 32) {
            float a[32], u[32];
#pragma unroll
            for (int i = 0; i < 32; ++i) { a[i] = AB[o0 + (size_t)(t0 + i) * 512]; u[i] = UB[o0 + (size_t)(t0 + i) * 512]; }
#pragma unroll
            for (int i = 0; i < 32; ++i) { hv = a[i] * hv + u[i]; pp *= a[i]; }
        }
        SP[idx] = pp; SHs[idx] = hv;
    }
}
DI void scan_b_phase(const Ctx& C, KP kp) {
    unsigned char* ws = opq(kp->ws); const float* AB = (const float*)(ws + WS_AB); const float* UB = (const float*)(ws + WS_UB);
    const float* SP = (const float*)(ws + WS_SP); const float* SHs = (const float*)(ws + WS_SH);
    const bf16_t* GA = (const bf16_t*)(ws + WS_GA); bf16_t* MIX = (bf16_t*)(ws + WS_MIX);
    int rnd = 0;
    for (int idx = C.gtid; idx < 520 * 512; idx += C.ngt, ++rnd) {
        const int ch = idx & 511; int cs = idx >> 9;
        if ((rnd & 1) && cs < 512) cs = (cs & ~127) | (127 - (cs & 127));
        const size_t o0 = (size_t)cs * 64 * 512 + ch;
        float hv = 0.f; bool last; float* oh;
        if (cs < 512) {
            const int c = cs & 127, b = cs >> 7;
            int j = 0;
            for (; j + 8 <= c; j += 8) { float p_[8], h_[8];
#pragma unroll
                for (int i = 0; i < 8; ++i) { const int si = (b * 128 + j + i) * 512 + ch; p_[i] = SP[si]; h_[i] = SHs[si]; }
#pragma unroll
                for (int i = 0; i < 8; ++i) hv = p_[i] * hv + h_[i]; }
            for (; j < c; ++j) { const int si = (b * 128 + j) * 512 + ch; hv = SP[si] * hv + SHs[si]; }
            last = (c == 127); oh = kp->out + O_PH + b * 512 + ch;
        } else { const int b = cs - 512; hv = kp->in[3][b * 512 + ch]; last = true; oh = kp->out + O_SH + b * 512 + ch; }
#pragma unroll 1
        for (int t0 = 0; t0 < 64; t0 += 32) {
            float a[32], u[32], g[32];
#pragma unroll
            for (int i = 0; i < 32; ++i) { a[i] = AB[o0 + (size_t)(t0 + i) * 512]; u[i] = UB[o0 + (size_t)(t0 + i) * 512]; g[i] = bf2f(GA[o0 + (size_t)(t0 + i) * 512]); }
#pragma unroll
            for (int i = 0; i < 32; ++i) { hv = a[i] * hv + u[i]; const float y = hv * gelu_tanh(g[i]); MIX[((size_t)cs * 64 + t0 + i) * DM + ch] = (bf16_t)(cvt_pk_bf16(y, 0.f) & 0xffffu); }
        }
        if (last) *oh = hv;
    }
}
DI void s5_chain_phase(const Ctx& C, KP kp) {
    unsigned char* ws = opq(kp->ws); const f32x2* AP = (const f32x2*)(ws + WS_AP); const float* E = (const float*)(ws + WS_E); bf16_t* A2 = (bf16_t*)(ws + WS_A2);
    const bool spread = (C.ngw == 2048);
    for (int it_ = 0; ; ++it_) {
        int idx;
        if (spread) { if (it_ > 0) break;
            if (C.wave == 0) idx = (C.gw >> 3) * 64 + C.lane;
            else if (C.wave <= 2) idx = 16384 + (((C.gw >> 3) * 2 + (C.wave - 1)) * 64 + C.lane);
            else break; }
        else { idx = C.gtid + it_ * C.ngt; if (idx >= 12 * 4096) break; }
        const int gp = idx & 4095, g = gp >> 6, p = gp & 63, sid = idx >> 12;
        int nsteps, chunk0; float sr = 0.f, si = 0.f; float* ore; float* oim;
        if (sid < 4) { nsteps = 512; chunk0 = sid * 512; ore = kp->out + O_PRE + sid * 4096 + gp; oim = kp->out + O_PIM + sid * 4096 + gp; }
        else { const int b = sid - 4; nsteps = 4; chunk0 = 2048 + b * 4; sr = kp->in[6][b * 4096 + gp]; si = kp->in[7][b * 4096 + gp]; ore = kp->out + O_SRE + b * 4096 + gp; oim = kp->out + O_SIM + b * 4096 + gp; }
        const f32x2 a16 = AP[gp * 17 + 16];
        const size_t r0 = (size_t)g * S5ROWS + chunk0;
        if (nsteps >= 32) {
#pragma unroll 1
        for (int c0 = 0; c0 < nsteps; c0 += 32) {
            float er[32], ei[32];
#pragma unroll
            for (int i = 0; i < 32; ++i) { er[i] = E[(r0 + c0 + i) * 128 + p]; ei[i] = E[(r0 + c0 + i) * 128 + 64 + p]; }
#pragma unroll
            for (int i = 0; i < 32; ++i) {
                bf16_t* ap = A2 + (r0 + c0 + i) * S5LDA;
                ap[p] = (bf16_t)(cvt_pk_bf16(sr, 0.f) & 0xffffu); ap[64 + p] = (bf16_t)(cvt_pk_bf16(si, 0.f) & 0xffffu);
                const float nr = a16[0] * sr - a16[1] * si + er[i], ni = a16[0] * si + a16[1] * sr + ei[i]; sr = nr; si = ni;
            }
        }
        } else
#pragma unroll 1
        for (int c0 = 0; c0 < nsteps; c0 += 4) {
            float er[4], ei[4];
#pragma unroll
            for (int i = 0; i < 4; ++i) { er[i] = E[(r0 + c0 + i) * 128 + p]; ei[i] = E[(r0 + c0 + i) * 128 + 64 + p]; }
#pragma unroll
            for (int i = 0; i < 4; ++i) {
                bf16_t* ap = A2 + (r0 + c0 + i) * S5LDA;
                ap[p] = (bf16_t)(cvt_pk_bf16(sr, 0.f) & 0xffffu); ap[64 + p] = (bf16_t)(cvt_pk_bf16(si, 0.f) & 0xffffu);
                const float nr = a16[0] * sr - a16[1] * si + er[i], ni = a16[0] * si + a16[1] * sr + ei[i]; sr = nr; si = ni;
            }
        }
        *ore = sr; *oim = si;
    }
}


constexpr int SOUT_LD = 132;
template <class F>
DI void small_gemm(const Ctx& C, const bf16_t* A, int lda, const bf16_t* Bt, int K, int nunits, const F f) {
    const int l31 = C.lane & 31, hh = C.lane >> 5, w = C.wave;
    LAS float* part = (LAS float*)C.lds;
    const int kw = K >> 3, nks = kw >> 4, k0 = w * kw;
    for (int ui = blockIdx.x; ui < nunits; ui += gridDim.x) {
        int arow0, brow[4]; { int b0_, b1_, b2_, b3_; f.unit(ui, arow0, b0_, b1_, b2_, b3_); brow[0] = b0_; brow[1] = b1_; brow[2] = b2_; brow[3] = b3_; }
        f32x16 acc[4];
#pragma unroll
        for (int t = 0; t < 4; ++t)
#pragma unroll
            for (int r = 0; r < 16; ++r) acc[t][r] = 0.f;
        const bf16_t* ap = A + (size_t)(arow0 + l31) * lda + k0 + 8 * hh;
        const bf16_t* bp[4];
#pragma unroll
        for (int t = 0; t < 4; ++t) bp[t] = Bt + (size_t)(brow[t] + l31) * K + k0 + 8 * hh;
#pragma unroll 2
        for (int ks = 0; ks < nks; ++ks) {
            const bf16x8 a = *(const bf16x8*)(ap + 16 * ks);
            bf16x8 b[4];
#pragma unroll
            for (int t = 0; t < 4; ++t) b[t] = *(const bf16x8*)(bp[t] + 16 * ks);
#pragma unroll
            for (int t = 0; t < 4; ++t) acc[t] = MFMA32(b[t], a, acc[t]);
        }
        __syncthreads();
#pragma unroll
        for (int t = 0; t < 4; ++t)
#pragma unroll
            for (int g = 0; g < 4; ++g)
                *(LAS f32x4*)(part + (w * 32 + l31) * SOUT_LD + 32 * t + 8 * g + 4 * hh) = (f32x4){acc[t][4 * g], acc[t][4 * g + 1], acc[t][4 * g + 2], acc[t][4 * g + 3]};
        __syncthreads();
#pragma unroll
        for (int it = 0; it < 2; ++it) {
            const int item = it * 512 + C.tid, row = item >> 5, c4 = item & 31;
            f32x4 s = *(const LAS f32x4*)(part + row * SOUT_LD + 4 * c4);
#pragma unroll
            for (int p = 1; p < 8; ++p) s = s + *(const LAS f32x4*)(part + (p * 32 + row) * SOUT_LD + 4 * c4);
            *(LAS f32x4*)(part + row * SOUT_LD + 4 * c4) = s;
        }
        __syncthreads();
        f.epi(ui, part, C.tid);
    }
    __syncthreads();
}
constexpr int SG_KC = 256;
constexpr int SG_LD = SG_KC * 2 + 16;
constexpr int SG_A = 0, SG_B = 64 * SG_LD, SG_OUT = SG_B + 128 * SG_LD;
static_assert(SG_OUT + 64 * SOUT_LD * 4 <= LDS_BIAS, "small-GEMM LDS map");
template <class F>
DI void small_gemm2(const Ctx& C, const bf16_t* A, int lda, const bf16_t* Bt, int K, int nunits64, const F f) {
    const int l31 = C.lane & 31, hh = C.lane >> 5, w = C.wave, rt = w >> 2, ct = w & 3;
    LAS unsigned char* lds = C.lds; LAS float* out = (LAS float*)(lds + SG_OUT);
    const int nch = K / SG_KC;
    const int prow = C.tid >> 5, ppart = C.tid & 31;
    for (int u64 = blockIdx.x; u64 < nunits64; u64 += gridDim.x) {
        const int uA = ((u64 >> 3) << 4) | ((u64 & 7) << 1);
        int arow0, brow[4]; { int b0_, b1_, b2_, b3_; f.unit(uA, arow0, b0_, b1_, b2_, b3_); brow[0] = b0_; brow[1] = b1_; brow[2] = b2_; brow[3] = b3_; }
        const bf16_t* ag = A + (size_t)(arow0 + prow) * lda + ppart * 8;
        const bf16_t* bg[8];
#pragma unroll
        for (int i = 0; i < 8; ++i) bg[i] = Bt + (size_t)(brow[i >> 1] + prow + 16 * (i & 1)) * K + ppart * 8;
        u32x4 ra[4], rb[8];
#pragma unroll
        for (int i = 0; i < 4; ++i) ra[i] = *(const u32x4*)(ag + (size_t)(16 * i) * lda);
#pragma unroll
        for (int i = 0; i < 8; ++i) rb[i] = *(const u32x4*)(bg[i]);
        f32x16 acc;
#pragma unroll
        for (int r = 0; r < 16; ++r) acc[r] = 0.f;
        for (int ch = 0; ch < nch; ++ch) {
            __syncthreads();
#pragma unroll
            for (int i = 0; i < 4; ++i) *(LAS u32x4*)(lds + SG_A + (prow + 16 * i) * SG_LD + ppart * 16) = ra[i];
#pragma unroll
            for (int i = 0; i < 8; ++i) *(LAS u32x4*)(lds + SG_B + (prow + 16 * i) * SG_LD + ppart * 16) = rb[i];
            __syncthreads();
            if (ch + 1 < nch) {
#pragma unroll
                for (int i = 0; i < 4; ++i) ra[i] = *(const u32x4*)(ag + (size_t)(16 * i) * lda + (ch + 1) * SG_KC);
#pragma unroll
                for (int i = 0; i < 8; ++i) rb[i] = *(const u32x4*)(bg[i] + (ch + 1) * SG_KC);
            }
#pragma unroll
            for (int ks = 0; ks < SG_KC / 16; ++ks) {
                const bf16x8 a = *(const LAS bf16x8*)(lds + SG_A + (32 * rt + l31) * SG_LD + 32 * ks + 16 * hh);
                const bf16x8 b = *(const LAS bf16x8*)(lds + SG_B + (32 * ct + l31) * SG_LD + 32 * ks + 16 * hh);
                acc = MFMA32(b, a, acc);
            }
        }
#pragma unroll
        for (int g = 0; g < 4; ++g) *(LAS f32x4*)(out + (32 * rt + l31) * SOUT_LD + 32 * ct + 8 * g + 4 * hh) = (f32x4){acc[4 * g], acc[4 * g + 1], acc[4 * g + 2], acc[4 * g + 3]};
        __syncthreads();
        f.epi(uA, out, C.tid); f.epi(uA + 1, out + 32 * SOUT_LD, C.tid);
    }
    __syncthreads();
}
DI void pair_rows(int q, int rowbase, int& br0, int& br1, int& br2, int& br3) { const int gb = rowbase + 256 * (q >> 1) + 64 * (q & 1); br0 = gb; br1 = gb + 32; br2 = gb + 128; br3 = gb + 160; }

struct SF_SwiGLU {
    bf16_t* HB; const float* RS;
    DI void unit(int ui, int& arow0, int& br0, int& br1, int& br2, int& br3) const { arow0 = MPROMPT + 32 * (ui & 15); pair_rows(ui >> 4, 0, br0, br1, br2, br3); }
    DI void epi(int ui, const LAS float* out, int tid) const {
        const int t = tid >> 4, c4 = tid & 15, row = MPROMPT + 32 * (ui & 15) + t, q = ui >> 4;
        const float rstd = RS ? rsqrtf(RS[row] * (1.0f / DM) + EPS) : 1.0f;
        const f32x4 g = *(const LAS f32x4*)(out + t * SOUT_LD + 4 * c4) * rstd, u = *(const LAS f32x4*)(out + t * SOUT_LD + 64 + 4 * c4) * rstd;
        u32x2 w; w.x = cvt_pk_bf16(siluf_(g[0]) * u[0], siluf_(g[1]) * u[1]); w.y = cvt_pk_bf16(siluf_(g[2]) * u[2], siluf_(g[3]) * u[3]);
        *(u32x2*)(HB + (size_t)row * DFF + 64 * q + 4 * c4) = w;
    }
};
struct SF_Residual {
    float* X; float s; const float* Rs; bf16_t* XB; float* RS;
    DI void unit(int ui, int& arow0, int& br0, int& br1, int& br2, int& br3) const { arow0 = MPROMPT + 32 * (ui & 15); const int cg = ui >> 4; br0 = 128 * cg; br1 = 128 * cg + 32; br2 = 128 * cg + 64; br3 = 128 * cg + 96; }
    DI void epi(int ui, const LAS float* out, int tid) const {
        const float sc = s; const float* const rsrc = Rs;
#pragma unroll
        for (int it = 0; it < 2; ++it) {
            const int item = it * 512 + tid, t = item >> 5, c4 = item & 31, rl = 32 * (ui & 15) + t, row = MPROMPT + rl, col = 128 * (ui >> 4) + 4 * c4;
            const f32x4 pv = *(const LAS f32x4*)(out + t * SOUT_LD + 4 * c4);
            f32x4 v = *(const f32x4*)(rsrc + (size_t)rl * DM + col); v[0] += pv[0] * sc; v[1] += pv[1] * sc; v[2] += pv[2] * sc; v[3] += pv[3] * sc;
            *(f32x4*)(X + (size_t)row * DM + col) = v;
        }
    }
};
struct SF_GLU {
    float* X; bf16_t* XB; float* RS;
    DI void unit(int ui, int& arow0, int& br0, int& br1, int& br2, int& br3) const { arow0 = MPROMPT + 32 * (ui & 15); pair_rows(ui >> 4, 0, br0, br1, br2, br3); }
    DI void epi(int ui, const LAS float* out, int tid) const {
        const int t = tid >> 4, c4 = tid & 15, row = MPROMPT + 32 * (ui & 15) + t, col = 64 * (ui >> 4) + 4 * c4;
        const f32x4 a = *(const LAS f32x4*)(out + t * SOUT_LD + 4 * c4), g = *(const LAS f32x4*)(out + t * SOUT_LD + 64 + 4 * c4);
        f32x4 v = *(const f32x4*)(X + (size_t)row * DM + col);
        v[0] += a[0] * sigmoidf_(g[0]); v[1] += a[1] * sigmoidf_(g[1]); v[2] += a[2] * sigmoidf_(g[2]); v[3] += a[3] * sigmoidf_(g[3]);
        *(f32x4*)(X + (size_t)row * DM + col) = v;
    }
};
struct SF_Gate {
    const bf16_t* XC; float* AB; float* UB; const float *ba, *bx, *lam;
    DI void unit(int ui, int& arow0, int& br0, int& br1, int& br2, int& br3) const { arow0 = MPROMPT + 32 * (ui & 15); pair_rows(ui >> 4, 0, br0, br1, br2, br3); }
    DI void epi(int ui, const LAS float* out, int tid) const {
        const int t = tid >> 4, c4 = tid & 15, row = MPROMPT + 32 * (ui & 15) + t, ch = 64 * (ui >> 4) + 4 * c4;
        const f32x4 rr = *(const LAS f32x4*)(out + t * SOUT_LD + 4 * c4) + *(const f32x4*)(ba + ch), ii = *(const LAS f32x4*)(out + t * SOUT_LD + 64 + 4 * c4) + *(const f32x4*)(bx + ch);
        const f32x4 lm = *(const f32x4*)(lam + ch);
        const size_t off = (size_t)row * 512 + ch; const u32x2 xr = *(const u32x2*)(XC + off);
        const float xc[4] = {__uint_as_float(xr.x << 16), __uint_as_float(xr.x & 0xffff0000u), __uint_as_float(xr.y << 16), __uint_as_float(xr.y & 0xffff0000u)};
        f32x4 av, uv;
#pragma unroll
        for (int e = 0; e < 4; ++e) { const float r = sigmoidf_(rr[e]), ig = sigmoidf_(ii[e]); const float la = -8.0f * log1pf(expf(-lm[e])) * r; const float a_ = fexp(la); av[e] = a_; uv[e] = __builtin_sqrtf(fmaxf(1.0f - a_ * a_, 0.0f)) * (ig * xc[e]); }
        *(f32x4*)(AB + off) = av; *(f32x4*)(UB + off) = uv;
    }
};
struct SF_QKV {
    bf16_t *XA, *GA, *Q, *KB, *VT; float* out; const float *qg, *kg; const float* RS;
    DI void unit(int ui, int& arow0, int& br0, int& br1, int& br2, int& br3) const {
        arow0 = MPROMPT + 32 * (ui & 15); const int cg = ui >> 4, pn = cg >> 1, hf = cg & 1;
        if (pn >= 4 && pn < 8) { const int b0 = 256 * pn + 64 * hf; br0 = b0; br1 = b0 + 128; br2 = b0 + 32; br3 = b0 + 160; }
        else { br0 = 128 * cg; br1 = 128 * cg + 32; br2 = 128 * cg + 64; br3 = 128 * cg + 96; }
    }
    DI void epi(int ui, const LAS float* o, int tid) const {
        const int cg = ui >> 4, pn = cg >> 1, hf = cg & 1;
#pragma unroll
        for (int it = 0; it < 2; ++it) {
            const int item = it * 512 + tid, t = item >> 5, c4 = item & 31, rl = 32 * (ui & 15) + t, row = MPROMPT + rl;
            const float rstd = RS ? rsqrtf(RS[row] * (1.0f / DM) + EPS) : 1.0f;
            f32x4 v = *(const LAS f32x4*)(o + t * SOUT_LD + 4 * c4) * rstd;
            if (pn < 4) {
                bf16_t* base = (pn < 2) ? XA : GA; u32x2 w; w.x = cvt_pk_bf16(v[0], v[1]); w.y = cvt_pk_bf16(v[2], v[3]);
                *(u32x2*)(base + (size_t)row * 512 + 128 * (cg & 3) + 4 * c4) = w;
            } else if (pn < 8) {
                const bool isq = pn < 6; const int head = (pn & 1) * 4 + 2 * hf + (c4 >> 4), dim = 4 * (c4 & 15);
                float ss = (v[0] * v[0] + v[1] * v[1]) + (v[2] * v[2] + v[3] * v[3]);
                ss += __shfl_xor(ss, 1); ss += __shfl_xor(ss, 2); ss += __shfl_xor(ss, 4); ss += __shfl_xor(ss, 8);
                const float rs = rsqrtf(ss * (1.0f / 64.0f) + EPS);
                const f32x4 gn = *(const f32x4*)((isq ? qg : kg) + dim);
                v = v * rs * gn;
                const float gs = isq ? 0.125f : 1.0f;
                u32x2 w; w.x = cvt_pk_bf16(v[0] * gs, v[1] * gs); w.y = cvt_pk_bf16(v[2] * gs, v[3] * gs);
                *(u32x2*)((isq ? Q : KB) + (size_t)row * 512 + head * 64 + dim) = w;
                if (!isq) *(f32x4*)(out + O_SK + (size_t)rl * 512 + head * 64 + dim) = v;
            } else {
                const int col = 128 * (cg & 3) + 4 * c4;
                const unsigned p01 = cvt_pk_bf16(v[0], v[1]), p23 = cvt_pk_bf16(v[2], v[3]);
                bf16_t* vp = VT + ((size_t)(row >> 6) * 512 + col) * 64 + (row & 63);
                vp[0] = (bf16_t)(p01 & 0xffffu); vp[64] = (bf16_t)(p01 >> 16); vp[128] = (bf16_t)(p23 & 0xffffu); vp[192] = (bf16_t)(p23 >> 16);
                *(f32x4*)(out + O_SV + (size_t)rl * 512 + col) = v;
            }
        }
    }
};
struct SF_S5E {
    float* E;
    DI void unit(int ui, int& arow0, int& br0, int& br1, int& br2, int& br3) const { arow0 = ui * S5ROWS + 2048; br0 = ui * 256; br1 = ui * 256 + 32; br2 = ui * 256 + 64; br3 = ui * 256 + 96; }
    DI void epi(int ui, const LAS float* out, int tid) const {
#pragma unroll
        for (int it = 0; it < 2; ++it) { const int item = it * 512 + tid, t = item >> 5, c4 = item & 31;
            *(f32x4*)(E + ((size_t)ui * S5ROWS + 2048 + t) * 128 + 4 * c4) = *(const LAS f32x4*)(out + t * SOUT_LD + 4 * c4); }
    }
};
struct SF_S5Y {
    bf16_t* Y;
    DI void unit(int ui, int& arow0, int& br0, int& br1, int& br2, int& br3) const { const int g = ui >> 1, hf = ui & 1; arow0 = g * S5ROWS + 2048; const int b0 = g * 256 + 128 * hf; br0 = b0; br1 = b0 + 32; br2 = b0 + 64; br3 = b0 + 96; }
    DI void epi(int ui, const LAS float* out, int tid) const {
        const int g = ui >> 1, hf = ui & 1;
#pragma unroll
        for (int it = 0; it < 2; ++it) { const int item = it * 512 + tid, t = item >> 5, c4 = item & 31, n = 128 * hf + 4 * c4, i16 = n >> 4, o = n & 15;
            const f32x4 v = *(const LAS f32x4*)(out + t * SOUT_LD + 4 * c4); u32x2 w; w.x = cvt_pk_bf16(v[0], v[1]); w.y = cvt_pk_bf16(v[2], v[3]);
            *(u32x2*)(Y + ((size_t)(2048 + t) * 16 + i16) * DM + 16 * g + o) = w; }
    }
};

template <class Epi, class Sched>
DI void run_gemm(LAS unsigned char* lds, const bf16_t* A, int lda, const bf16_t* Bt, int K, const Sched& S, const Epi& E) {
    pg8::Gemm g{A, Bt, K, lda};
    pg8::gemm_phase<Epi, Sched, true, true>(lds, g, S, E);
}

#ifndef PHMASK
#define PHMASK 0xffffffffu
#endif
#define PH_ON(b) (((PHMASK) >> (b)) & 1u)
__global__ void __launch_bounds__(512) fwd_megakernel(Params P) {
    extern __shared__ __attribute__((aligned(16))) unsigned char lds_raw[];
    int ph = 0;
    { volatile LAS unsigned* st_ = (volatile LAS unsigned*)((LAS unsigned char*)lds_raw + LDS_BARST); if (threadIdx.x == 0) { st_[0] = 0u; st_[1] = 0u; } __syncthreads();
      (void)xcd_barrier_post((unsigned*)(opq((unsigned char*)get_kp()->ws) + WS_BARW), st_); }
#define PHASE_BEGIN { KP kp = get_kp(); if (ph >= kp->ph_lo && ph < kp->ph_hi) { Ctx C; { int t_ = threadIdx.x; asm volatile("" : "+v"(t_)); C.tid = t_; } C.lane = C.tid & 63; C.wave = __builtin_amdgcn_readfirstlane(C.tid >> 6); \
    C.gw = blockIdx.x * 8 + C.wave; C.ngw = gridDim.x * 8; C.gtid = blockIdx.x * 512 + C.tid; C.ngt = gridDim.x * 512; C.lds = (LAS unsigned char*)lds_raw; \
    const int G = gridDim.x, c = blockIdx.x; (void)G; (void)c; \
    unsigned char* ws = opq((unsigned char*)kp->ws); float* X = opq((float*)kp->out); bf16_t* XN = (bf16_t*)(ws + WS_XN); bf16_t* HB = (bf16_t*)(ws + WS_HB); (void)X; (void)XN; (void)HB;
#define PHASE_END   if (ph + 1 < get_kp()->ph_hi) { if (ph == 0) cg::this_grid().sync(); else grid_barrier(get_kp(), C.lds); } } } ++ph;

    PHASE_BEGIN if (PH_ON(0)) p0_phase(C, get_kp()); PHASE_END
#define WIN_(i)  ((const bf16_t*)(ws + WS_WIN + (size_t)(i) * 11 * MiB))
#define WOUT_(i) ((const bf16_t*)(ws + WS_WOUT + (size_t)(i) * 11 * HALF_MIB))
#define RS_(slot) ((float*)nullptr)
#define XS_ (X + (size_t)MPROMPT * DM)
#define GEMM_FFN_IN(wi, slot)  PHASE_BEGIN if (PH_ON(2)) { pg8::StaticOrder S; S.init(MPROMPT, 2 * DFF, G, c); EpiSwiGLU E{HB, RS_(slot)}; run_gemm(C.lds, XN, DM, WIN_(wi), DM, S, E); SF_SwiGLU F{HB, RS_(slot)}; small_gemm2(C, XN, DM, WIN_(wi), DM, 352, F); } PHASE_END
#define GEMM_FFN_OUT(wi, rp, rs, xb, rsp) PHASE_BEGIN if (PH_ON(3)) { pg8::StaticOrder S; S.init(MPROMPT, DM, G, c); EpiResidual E{X, 0.5f, rp, rs, xb, rsp}; run_gemm(C.lds, HB, DFF, WOUT_(wi), DFF, S, E); SF_Residual F{X, 0.5f, rs, xb, rsp}; small_gemm2(C, HB, DFF, WOUT_(wi), DFF, 64, F); } PHASE_END
    GEMM_FFN_IN(0, 4)
    GEMM_FFN_OUT(0, kp->in[0], kp->in[1], (bf16_t*)nullptr, (float*)nullptr)
    PHASE_BEGIN norm_phase(C, X, nullptr, XN, nullptr); if (PH_ON(4)) s5_fill_phase(C, get_kp()); PHASE_END
    PHASE_BEGIN if (PH_ON(5)) { pg8::StaticOrder S; S.init(MPROMPT, 2560, G, c);
        EpiQKV E{(bf16_t*)(ws + WS_XA), (bf16_t*)(ws + WS_GA), (bf16_t*)(ws + WS_Q), (bf16_t*)(ws + WS_KB), (bf16_t*)(ws + WS_VT), X, kp->in[23], kp->in[24], RS_(0)};
        run_gemm(C.lds, XN, DM, (const bf16_t*)(ws + WS_WPROJ), DM, S, E);
        SF_QKV F{E.XA, E.GA, E.Q, E.KB, E.VT, E.out, E.qg, E.kg, E.RS}; small_gemm2(C, XN, DM, (const bf16_t*)(ws + WS_WPROJ), DM, 160, F); } PHASE_END
    PHASE_BEGIN if (PH_ON(6)) conv_phase(C, get_kp()); if (PH_ON(7)) attn_phase(C, get_kp()); PHASE_END
    PHASE_BEGIN if (PH_ON(8)) { GateOrder S; S.S.init(MPROMPT, 1024, G, c);
        EpiGate E{(const bf16_t*)(ws + WS_XC), (float*)(ws + WS_AB), (float*)(ws + WS_UB), kp->in[19], kp->in[21], kp->in[22]};
        run_gemm(C.lds, (const bf16_t*)(ws + WS_XC), 512, (const bf16_t*)(ws + WS_WGATEC), 128, S, E);
        SF_Gate F{E.XC, E.AB, E.UB, E.ba, E.bx, E.lam}; small_gemm2(C, (const bf16_t*)(ws + WS_XC), 512, (const bf16_t*)(ws + WS_WGATE), 512, 64, F); } PHASE_END
    PHASE_BEGIN if (PH_ON(9)) scan_a_phase(C, get_kp()); PHASE_END
    PHASE_BEGIN if (PH_ON(10)) scan_b_phase(C, get_kp()); PHASE_END
    PHASE_BEGIN if (PH_ON(3)) { pg8::StaticOrder S; S.init(MPROMPT, DM, G, c); EpiResidual E{X, 1.0f, X, XS_, (bf16_t*)nullptr, (float*)nullptr}; run_gemm(C.lds, (const bf16_t*)(ws + WS_MIX), DM, (const bf16_t*)(ws + WS_WO), DM, S, E); SF_Residual F{X, 1.0f, XS_, (bf16_t*)nullptr, (float*)nullptr}; small_gemm2(C, (const bf16_t*)(ws + WS_MIX), DM, (const bf16_t*)(ws + WS_WO), DM, 64, F); } PHASE_END
    PHASE_BEGIN norm_phase(C, X, nullptr, XN, nullptr); PHASE_END
    GEMM_FFN_IN(1, 1)
    GEMM_FFN_OUT(1, X, XS_, (bf16_t*)nullptr, (float*)nullptr)
    PHASE_BEGIN norm_phase(C, X, nullptr, XN, nullptr); PHASE_END
    GEMM_FFN_IN(2, 2)
    GEMM_FFN_OUT(2, X, XS_, (bf16_t*)nullptr, (float*)nullptr)
    PHASE_BEGIN if (PH_ON(1)) norm_phase(C, X, kp->in[11] + DM, nullptr, (bf16_t*)(ws + WS_A2)); PHASE_END
    PHASE_BEGIN if (PH_ON(11)) { S5Order S{G, c}; EpiS5E E{(float*)(ws + WS_E)}; run_gemm(C.lds, (const bf16_t*)(ws + WS_A2) + 128, S5LDA, (const bf16_t*)(ws + WS_BTE), 256, S, E); SF_S5E F{E.E}; small_gemm(C, (const bf16_t*)(ws + WS_A2) + 128, S5LDA, (const bf16_t*)(ws + WS_BTE), 256, 64, F); } PHASE_END
    PHASE_BEGIN if (PH_ON(12)) s5_chain_phase(C, get_kp()); PHASE_END
    PHASE_BEGIN if (PH_ON(13)) { S5Order S{G, c}; EpiS5Y E{(bf16_t*)(ws + WS_Y)}; run_gemm(C.lds, (const bf16_t*)(ws + WS_A2), S5LDA, (const bf16_t*)(ws + WS_BTY), 384, S, E); SF_S5Y F{E.Y}; small_gemm(C, (const bf16_t*)(ws + WS_A2), S5LDA, (const bf16_t*)(ws + WS_BTY), 384, 128, F); } PHASE_END
    PHASE_BEGIN if (PH_ON(14)) { pg8::StaticOrder S; S.init(MPROMPT, 2048, G, c); EpiGLU E{X, (bf16_t*)nullptr, (float*)nullptr}; run_gemm(C.lds, (const bf16_t*)(ws + WS_Y), DM, (const bf16_t*)(ws + WS_WGLU), DM, S, E); SF_GLU F{X, (bf16_t*)nullptr, (float*)nullptr}; small_gemm2(C, (const bf16_t*)(ws + WS_Y), DM, (const bf16_t*)(ws + WS_WGLU), DM, 128, F); } PHASE_END
    PHASE_BEGIN norm_phase(C, X, nullptr, XN, nullptr); PHASE_END
    GEMM_FFN_IN(3, 3)
    GEMM_FFN_OUT(3, X, XS_, (bf16_t*)nullptr, (float*)nullptr)
}
constexpr int N_PHASES = 24;

extern "C" void kernel_launch(void* const* d_in, const int* in_sizes, int n_in, void* d_out, int out_size, void* d_ws, size_t ws_size, hipStream_t stream) {
    static int grid = 0;
    if (grid == 0) {
        if (n_in != 36 || ws_size < WS_END) { fprintf(stderr, "kernel_launch: unexpected n_in %d or ws_size %zu (< %zu)\n", n_in, ws_size, (size_t)WS_END); grid = -1; return; }
        int dev = 0, cus = 0, per_cu = 0;
        hipGetDevice(&dev); hipDeviceGetAttribute(&cus, hipDeviceAttributeMultiprocessorCount, dev);
        if (hipFuncSetAttribute((const void*)fwd_megakernel, hipFuncAttributeMaxDynamicSharedMemorySize, LDS_BYTES) != hipSuccess) { fprintf(stderr, "kernel_launch: hipFuncSetAttribute failed\n"); grid = -1; return; }
        hipOccupancyMaxActiveBlocksPerMultiprocessor(&per_cu, (const void*)fwd_megakernel, 512, LDS_BYTES);
        if (per_cu < 1) { fprintf(stderr, "kernel_launch: occupancy query says %d blocks per CU\n", per_cu); per_cu = 1; }
        (void)hipGetLastError();
        grid = cus * 1;
    }
    if (grid < 0) return;
    if (hipMemsetAsync((char*)d_ws + WS_BARW, 0, 16384, stream) != hipSuccess) { fprintf(stderr, "kernel_launch: memset of barrier words failed\n"); return; }
    Params p{};
    for (int i = 0; i < 36; ++i) p.in[i] = (const float*)d_in[i];
    p.out = (float*)d_out; p.ws = (unsigned char*)d_ws; p.ph_lo = 0; p.ph_hi = N_PHASES;
    void* args[] = {&p};
    hipError_t e = hipLaunchCooperativeKernel((const void*)fwd_megakernel, dim3(grid), dim3(512), args, LDS_BYTES, stream);
    if (e != hipSuccess) fprintf(stderr, "cooperative launch failed: %s (grid %d)\n", hipGetErrorString(e), grid);
}
```

```cpp
#include <hip/hip_runtime.h>
#include <hip/hip_cooperative_groups.h>
#include <cstdio>
#include <cstdint>
namespace cg = cooperative_groups;
namespace pg8 {
#define PG8_LAS __attribute__((address_space(3)))
typedef unsigned short bf16_t;
typedef short bf16x8 __attribute__((ext_vector_type(8)));
typedef float f32x4 __attribute__((ext_vector_type(4)));
typedef unsigned u32x4 __attribute__((ext_vector_type(4)));
constexpr int BM = 256, BK = 64, HALF = 128, HTB = HALF * BK * 2  , STAGE_BYTES = 8 * HTB, NXCD = 8, WGM = 8;

__host__ __device__ __forceinline__ int lds_byte(int r, int c) { const int st = (r >> 4) * 2 + (c >> 5), rr = r & 15, cc = c & 31, ob = rr * 64 + cc * 2; return st * 1024 + (ob ^ (((ob >> 9) & 1) << 5)); }
__host__ __device__ __forceinline__ void stage_rc(int b, int& R, int& C) { const int st = b / 1024, sb = b % 1024, swz = sb ^ (((sb >> 9) & 1) << 5); R = (st >> 1) * 16 + swz / 64; C = (st & 1) * 32 + (swz % 64) / 2; }
__host__ __device__ __forceinline__ int perm32(int rho) { const int n = rho >> 4, i = rho & 15; return 8 * (i >> 2) + 4 * n + (i & 3); }

struct Unit { int pm, pn, ka; };
struct Gemm { const bf16_t* A; const bf16_t* Bt; int K, lda; };

struct StaticOrder {
    int nM, nN, nwg, G, c;
    __host__ __device__ void init(int M, int N, int G_, int c_) { nM = M / BM; nN = N / BM; nwg = nM * nN; G = G_; c = c_; }
    __host__ __device__ bool next(int i, Unit& u) const {
        const long L = (long)i * G + c; if (L >= nwg) return false;
        int wgid = (int)L; { const int q = nwg / NXCD, r = nwg % NXCD, xcd = wgid % NXCD, off = wgid / NXCD; wgid = (xcd < r ? xcd * (q + 1) : r * (q + 1) + (xcd - r) * q) + off; }
        const int nig = WGM * nN, gid = wgid / nig, fm = gid * WGM, gsz = (nM - fm) < WGM ? (nM - fm) : WGM;
        u.pm = fm + ((wgid % nig) % gsz); u.pn = (wgid % nig) / gsz; u.ka = 0; return true;
    }
    __device__ __forceinline__ void a_ready(const Unit&) const {}
    __device__ __forceinline__ void done(const Unit&) const {}
};

typedef float f32x2 __attribute__((ext_vector_type(2)));
typedef __bf16 bf16v2_t __attribute__((ext_vector_type(2)));
__device__ __forceinline__ unsigned cvt_pk_bf16(float lo, float hi) { f32x2 v = {lo, hi}; return __builtin_bit_cast(unsigned, __builtin_convertvector(v, bf16v2_t)); }
template <class Epi, class Sched, bool ALIGN_EPI = false, bool SP2 = false>
__device__ __forceinline__ void gemm_phase(PG8_LAS unsigned char* lds, const Gemm g, const Sched& S, const Epi& E) {
    int tid_ = threadIdx.x; asm volatile("" : "+v"(tid_));
    const int tid = tid_, wid = __builtin_amdgcn_readfirstlane(tid >> 6), lane = tid & 63, wr = wid >> 2, wc = wid & 3, fr = lane & 15, fq = lane >> 4;
    int K_ = g.K, lda_ = g.lda; asm volatile("" : "+s"(K_), "+s"(lda_));
    const int K = K_, lda = lda_, nt = K / BK;
    unsigned voffA[2], voffB[2];
#pragma unroll
    for (int i = 0; i < 2; ++i) { int R, C; stage_rc(tid * 16 + i * 8192, R, C); const int Rb = Epi::PERM ? ((R & ~31) + perm32(R & 31)) : R;
        voffA[i] = (unsigned)(R * lda + C) * 2u; voffB[i] = (unsigned)(Rb * K + C) * 2u; }
    const size_t kstep = (size_t)(BK * 2);
    const size_t hsA = (size_t)HALF * lda * 2, hsB = (size_t)HALF * K * 2;
    const size_t tsA = 2 * hsA, tsB = 2 * hsB;
    const unsigned ldsw = (unsigned)wid * 1024u;
    const int aoff = lds_byte(wr * 64 + fr, fq * 8), boff = lds_byte(wc * 32 + fr, fq * 8);
#define PG8_SA(b, h) (((b) * 2 + (h)) * HTB)
#define PG8_SB(b, h) ((4 + (b) * 2 + (h)) * HTB)
#define PG8_STAGE(bufoff, gbase, voff) do { _Pragma("unroll") for (int _i = 0; _i < 2; ++_i) \
        __builtin_amdgcn_global_load_lds((const unsigned*)((const char*)(gbase) + (voff)[_i]), (PG8_LAS unsigned*)(lds + (bufoff) + ldsw + _i * 8192), 16, 0, 0); } while (0)
#define PG8_LDA(dst, b, h) do { _Pragma("unroll") for (int m = 0; m < 4; ++m) _Pragma("unroll") for (int k = 0; k < 2; ++k) dst[m][k] = *(const PG8_LAS bf16x8*)(lds + PG8_SA(b, h) + aoff + m * 2048 + k * 1024); } while (0)
#define PG8_LDB(dst, b, h) do { _Pragma("unroll") for (int n = 0; n < 2; ++n) _Pragma("unroll") for (int k = 0; k < 2; ++k) dst[n][k] = *(const PG8_LAS bf16x8*)(lds + PG8_SB(b, h) + boff + n * 2048 + k * 1024); } while (0)
#define PG8_MMA(ai, bj, At, Bt) do { __builtin_amdgcn_s_setprio(1); _Pragma("unroll") for (int m = 0; m < 4; ++m) _Pragma("unroll") for (int n = 0; n < 2; ++n) _Pragma("unroll") for (int k = 0; k < 2; ++k) \
        acc[ai][bj][m][n] = __builtin_amdgcn_mfma_f32_16x16x32_bf16(Bt[n][k], At[m][k], acc[ai][bj][m][n], 0, 0, 0); __builtin_amdgcn_s_setprio(0); } while (0)
#define PG8_WAIT_V(n) asm volatile("s_waitcnt vmcnt(" #n ")" ::: "memory")
#define PG8_WAIT_L(n) asm volatile("s_waitcnt lgkmcnt(" #n ")" ::: "memory")
#define PG8_BAR __builtin_amdgcn_s_barrier()
#define PG8_SCHED __builtin_amdgcn_sched_barrier(0)
    Unit cur, nxt; int ui = 0;
    if (!S.next(0, cur)) return;
    f32x4 acc[2][2][4][2];
#pragma unroll
    for (int a = 0; a < 2; ++a)
#pragma unroll
        for (int b = 0; b < 2; ++b)
#pragma unroll
            for (int m = 0; m < 4; ++m)
#pragma unroll
                for (int n = 0; n < 2; ++n) acc[a][b][m][n] = (f32x4){0.f, 0.f, 0.f, 0.f};
    bf16x8 At[4][2], B0[2][2], B1[2][2];
    const char* cA = (const char*)g.A + (size_t)cur.pm * tsA + cur.ka; const char* cB = (const char*)g.Bt + (size_t)cur.pn * tsB;
    S.a_ready(cur);
    if constexpr (SP2) {
        PG8_STAGE(PG8_SB(0, 0), cB, voffB); PG8_STAGE(PG8_SB(0, 1), cB + hsB, voffB); PG8_STAGE(PG8_SA(0, 0), cA, voffA); PG8_STAGE(PG8_SA(0, 1), cA + hsA, voffA);
        if (wr == 1) PG8_BAR;
        PG8_WAIT_V(2); PG8_BAR;
        PG8_STAGE(PG8_SB(1, 0), cB + kstep, voffB); PG8_STAGE(PG8_SA(1, 0), cA + kstep, voffA); PG8_STAGE(PG8_SB(1, 1), cB + hsB + kstep, voffB);
        PG8_WAIT_V(6); PG8_BAR;
    } else {
        PG8_STAGE(PG8_SB(0, 0), cB, voffB); PG8_STAGE(PG8_SA(0, 0), cA, voffA); PG8_STAGE(PG8_SB(0, 1), cB + hsB, voffB); PG8_STAGE(PG8_SA(0, 1), cA + hsA, voffA);
        if (wr == 1) PG8_BAR;
        PG8_WAIT_V(4); PG8_BAR;
        PG8_STAGE(PG8_SB(1, 0), cB + kstep, voffB); PG8_STAGE(PG8_SA(1, 0), cA + kstep, voffA); PG8_STAGE(PG8_SB(1, 1), cB + hsB + kstep, voffB);
        PG8_WAIT_V(6); PG8_BAR;
    }
    for (;;) {
        const bool has_next = S.next(ui + 1, nxt);
        const char* nA = has_next ? (const char*)g.A + (size_t)nxt.pm * tsA + nxt.ka : cA; const char* nB = has_next ? (const char*)g.Bt + (size_t)nxt.pn * tsB : cB;
        for (int t = 0; t < nt; t += 2) {
            const bool last = (t == nt - 2);
            const char* a1 = cA + (size_t)(t + 1) * kstep;
            const char* a2 = last ? nA : cA + (size_t)(t + 2) * kstep; const char* b2 = last ? nB : cB + (size_t)(t + 2) * kstep;
            const char* a3 = a2 + kstep; const char* b3 = b2 + kstep;
            if (last && has_next) S.a_ready(nxt);
            if constexpr (SP2) {
            PG8_LDB(B0, 0, 0); PG8_LDB(B1, 0, 1); PG8_SCHED; PG8_LDA(At, 0, 0); PG8_STAGE(PG8_SA(1, 1), a1 + hsA, voffA);
            PG8_WAIT_V(8); PG8_WAIT_L(0); PG8_BAR; PG8_MMA(0, 0, At, B0); PG8_MMA(0, 1, At, B1); PG8_BAR; PG8_SCHED;
            PG8_LDA(At, 0, 1); PG8_STAGE(PG8_SB(0, 0), b2, voffB); PG8_STAGE(PG8_SB(0, 1), b2 + hsB, voffB); PG8_STAGE(PG8_SA(0, 0), a2, voffA);
            PG8_WAIT_V(8); PG8_WAIT_L(0); PG8_BAR; PG8_MMA(1, 0, At, B0); PG8_MMA(1, 1, At, B1); PG8_BAR; PG8_SCHED;
            PG8_LDB(B0, 1, 0); PG8_LDB(B1, 1, 1); PG8_SCHED; PG8_LDA(At, 1, 0); PG8_STAGE(PG8_SA(0, 1), a2 + hsA, voffA);
            PG8_WAIT_V(8); PG8_WAIT_L(0); PG8_BAR; PG8_MMA(0, 0, At, B0); PG8_MMA(0, 1, At, B1); PG8_BAR; PG8_SCHED;
            PG8_LDA(At, 1, 1); PG8_STAGE(PG8_SB(1, 0), b3, voffB); PG8_STAGE(PG8_SB(1, 1), b3 + hsB, voffB); PG8_STAGE(PG8_SA(1, 0), a3, voffA);
            PG8_WAIT_V(8); PG8_WAIT_L(0); PG8_BAR; PG8_MMA(1, 0, At, B0); PG8_MMA(1, 1, At, B1); PG8_BAR; PG8_SCHED;
            } else {
            PG8_LDB(B0, 0, 0); PG8_SCHED; PG8_LDA(At, 0, 0); PG8_STAGE(PG8_SA(1, 1), a1 + hsA, voffA);
            PG8_WAIT_L(8); PG8_BAR; PG8_WAIT_L(0); PG8_MMA(0, 0, At, B0); PG8_BAR; PG8_SCHED;
            PG8_LDB(B1, 0, 1); PG8_STAGE(PG8_SB(0, 0), b2, voffB);
            PG8_BAR; PG8_WAIT_L(0); PG8_MMA(0, 1, At, B1); PG8_BAR;
            PG8_LDA(At, 0, 1); PG8_STAGE(PG8_SA(0, 0), a2, voffA);
            PG8_BAR; PG8_WAIT_L(0); PG8_MMA(1, 0, At, B0); PG8_BAR; PG8_SCHED;
            PG8_STAGE(PG8_SB(0, 1), b2 + hsB, voffB);
            PG8_WAIT_V(6); PG8_BAR; PG8_MMA(1, 1, At, B1); PG8_BAR;
            PG8_LDB(B0, 1, 0); PG8_SCHED; PG8_LDA(At, 1, 0); PG8_STAGE(PG8_SA(0, 1), a2 + hsA, voffA);
            PG8_WAIT_L(8); PG8_BAR; PG8_WAIT_L(0); PG8_MMA(0, 0, At, B0); PG8_BAR; PG8_SCHED;
            PG8_LDB(B1, 1, 1); PG8_STAGE(PG8_SB(1, 0), b3, voffB);
            PG8_BAR; PG8_WAIT_L(0); PG8_MMA(0, 1, At, B1); PG8_BAR;
            PG8_LDA(At, 1, 1); PG8_STAGE(PG8_SA(1, 0), a3, voffA);
            PG8_BAR; PG8_WAIT_L(0); PG8_MMA(1, 0, At, B0); PG8_BAR; PG8_SCHED;
            PG8_STAGE(PG8_SB(1, 1), b3 + hsB, voffB);
            PG8_WAIT_V(6); PG8_BAR; PG8_MMA(1, 1, At, B1); PG8_BAR;
            }
        }
        if constexpr (ALIGN_EPI) { if (wr == 0) PG8_BAR; }
        if constexpr (!Epi::AFTER_DRAIN) { E(acc, cur, wr, wc, fr, fq); S.done(cur); }
        if (!has_next) break;
#pragma unroll
        for (int a = 0; a < 2; ++a)
#pragma unroll
            for (int b = 0; b < 2; ++b)
#pragma unroll
                for (int m = 0; m < 4; ++m)
#pragma unroll
                    for (int n = 0; n < 2; ++n) acc[a][b][m][n] = (f32x4){0.f, 0.f, 0.f, 0.f};
        cur = nxt; cA = nA; cB = nB; ++ui;
        if constexpr (ALIGN_EPI) { if (wr == 1) PG8_BAR; }
    }
    PG8_WAIT_V(0);
    if constexpr (!ALIGN_EPI) { if (wr == 0) PG8_BAR; }
    PG8_BAR;
    if constexpr (Epi::AFTER_DRAIN) { E.fused(acc, cur, wr, wc, fr, fq, lds, wid, lane); S.done(cur); }
#undef PG8_SA
#undef PG8_SB
#undef PG8_STAGE
#undef PG8_LDA
#undef PG8_LDB
#undef PG8_MMA
#undef PG8_WAIT_V
#undef PG8_WAIT_L
#undef PG8_BAR
#undef PG8_SCHED
}
}

using pg8::f32x2; using pg8::bf16_t; using pg8::bf16x8; using pg8::f32x4; using pg8::u32x4; using pg8::Unit; using pg8::cvt_pk_bf16;
#define LAS __attribute__((address_space(3)))
#define DI __device__ __forceinline__
typedef float f32x16 __attribute__((ext_vector_type(16)));
template <class T> DI T* opq(T* p) { asm volatile("" : "+s"(p)); return p; }
#define EPI_FENCE asm volatile("" ::: "memory")
typedef unsigned u32x2 __attribute__((ext_vector_type(2)));

constexpr int MTOK = 33280;
constexpr int MPROMPT = 32768;
constexpr int DM = 1024, DFF = 2816;
constexpr int NCHUNK16 = 2080;
constexpr int S5ROWS = 2304;
constexpr int S5LDA = 384;
constexpr float EPS = 1e-6f;

constexpr size_t MiB = 1u << 20;
constexpr size_t WS_AP = 0, WS_BBAR = 1 * MiB, WS_SP = 2 * MiB, WS_SH = 4 * MiB, WS_KC = 6 * MiB, WS_VC = 10 * MiB;
constexpr size_t WS_WGATEC = 14 * MiB;
constexpr size_t WS_RS = 14 * MiB + 512 * 1024;
constexpr size_t WS_WIN = 16 * MiB;
constexpr size_t WS_WOUT = 60 * MiB;
constexpr size_t WS_WPROJ = 82 * MiB, WS_WO = 87 * MiB, WS_WGLU = 89 * MiB, WS_WGATE = 93 * MiB, WS_BTE = 94 * MiB, WS_BTY = 102 * MiB;
constexpr size_t WS_XN = 114 * MiB;
constexpr size_t WS_SCR = 179 * MiB;
constexpr size_t HALF_MIB = MiB / 2;
constexpr size_t WS_HB = WS_SCR;
constexpr size_t WS_XA = WS_SCR, WS_Q = WS_SCR + 65 * HALF_MIB, WS_KB = WS_SCR + 130 * HALF_MIB, WS_VT = WS_SCR + 195 * HALF_MIB,
                 WS_GA = WS_SCR + 260 * HALF_MIB, WS_XC = WS_SCR + 325 * HALF_MIB, WS_MIX = WS_SCR + 390 * HALF_MIB;
constexpr size_t WS_AB = WS_SCR, WS_UB = WS_SCR + 65 * MiB;
constexpr size_t WS_A2 = WS_SCR, WS_E = WS_SCR + 108 * MiB, WS_Y = WS_SCR + 180 * MiB;
constexpr size_t WS_END = WS_SCR + 260 * MiB;

constexpr size_t O_Y = 0, O_PCONV = 34078720, O_PH = 34084864, O_PK = 34086912, O_PV = 35135488, O_PRE = 36184064, O_PIM = 36200448,
                 O_SCONV = 36216832, O_SH = 36229120, O_SK = 36233216, O_SV = 36495360, O_SRE = 36757504, O_SIM = 36790272;

constexpr int LDS_RING = 131072, LDS_ATTW = 18432  , LDS_BIAS = 147456, LDS_BYTES = 163840;

struct Params { const float* in[36]; float* out; unsigned char* ws; int ph_lo, ph_hi; };
typedef const __attribute__((address_space(4))) Params* KP;
DI KP get_kp() { KP p = (KP)__builtin_amdgcn_kernarg_segment_ptr(); asm volatile("" : "+s"(p)); return p; }

DI float bf2f(unsigned short b) { return __uint_as_float(((unsigned)b) << 16); }
DI float fexp(float x) { return __builtin_amdgcn_exp2f(x * 1.4426950408889634f); }
DI float sigmoidf_(float x) { return __builtin_amdgcn_rcpf(1.0f + fexp(-x)); }
DI float siluf_(float x) { return x * sigmoidf_(x); }
DI float gelu_tanh(float x) { const float y = 0.7978845608028654f * (x + 0.044715f * x * x * x); const float t = fexp(2.0f * y); const float th = 1.0f - 2.0f * __builtin_amdgcn_rcpf(t + 1.0f); return 0.5f * x * (1.0f + th); }
DI float wave_sum(float v) {
#pragma unroll
    for (int o = 1; o < 64; o <<= 1) v += __shfl_xor(v, o);
    return v;
}

struct EpiSwiGLU {
    static constexpr bool PERM = true, AFTER_DRAIN = false;
    bf16_t* O; const float* RS;
    DI void operator()(const f32x4 (&acc)[2][2][4][2], const Unit& u, int wr, int wc, int fr, int fq) const {
        const int row0 = u.pm * 256 + wr * 64 + fr, col0 = u.pn * 128 + wc * 32 + 8 * fq;
#pragma unroll
        for (int ai = 0; ai < 2; ++ai)
#pragma unroll
            for (int m = 0; m < 4; ++m) {
                bf16_t* p = O + (size_t)(row0 + ai * 128 + m * 16) * DFF + col0;
                const float rstd = RS ? rsqrtf(RS[row0 + ai * 128 + m * 16] * (1.0f / DM) + EPS) : 1.0f;
                const f32x4 g0 = acc[ai][0][m][0] * rstd, g1 = acc[ai][0][m][1] * rstd, u0 = acc[ai][1][m][0] * rstd, u1 = acc[ai][1][m][1] * rstd;
                u32x4 w;
                w.x = cvt_pk_bf16(siluf_(g0[0]) * u0[0], siluf_(g0[1]) * u0[1]); w.y = cvt_pk_bf16(siluf_(g0[2]) * u0[2], siluf_(g0[3]) * u0[3]);
                w.z = cvt_pk_bf16(siluf_(g1[0]) * u1[0], siluf_(g1[1]) * u1[1]); w.w = cvt_pk_bf16(siluf_(g1[2]) * u1[2], siluf_(g1[3]) * u1[3]);
                *(u32x4*)p = w; EPI_FENCE;
            }
    }
};
struct EpiResidual {
    static constexpr bool PERM = false, AFTER_DRAIN = false;
    float* X; float s; const float* Rp; const float* Rs; bf16_t* XB; float* RS;
    DI void operator()(const f32x4 (&acc)[2][2][4][2], const Unit& u, int wr, int wc, int fr, int fq) const {
        const int row0 = u.pm * 256 + wr * 64 + fr, col0 = u.pn * 256 + wc * 32 + 4 * fq;
        const float* R = (u.pm < 128) ? Rp : Rs - (size_t)MPROMPT * DM;
#pragma unroll
        for (int ai = 0; ai < 2; ++ai)
#pragma unroll
            for (int m = 0; m < 4; ++m) {
                const int row = row0 + ai * 128 + m * 16; const size_t off = (size_t)row * DM + col0;
#pragma unroll
                for (int bj = 0; bj < 2; ++bj)
#pragma unroll
                    for (int n = 0; n < 2; ++n) { const size_t o = off + bj * 128 + n * 16; f32x4 v = *(const f32x4*)(R + o); v = v + acc[ai][bj][m][n] * s; *(f32x4*)(X + o) = v;
 }
                if (m & 1) EPI_FENCE;
            }
    }
};
struct EpiGLU {
    static constexpr bool PERM = false, AFTER_DRAIN = false;
    float* X; bf16_t* XB; float* RS;
    DI void operator()(const f32x4 (&acc)[2][2][4][2], const Unit& u, int wr, int wc, int fr, int fq) const {
        const int row0 = u.pm * 256 + wr * 64 + fr, col0 = u.pn * 128 + wc * 32 + 4 * fq;
#pragma unroll
        for (int ai = 0; ai < 2; ++ai)
#pragma unroll
            for (int m = 0; m < 4; ++m) {
                const int row = row0 + ai * 128 + m * 16; const size_t off = (size_t)row * DM + col0;
#pragma unroll
                for (int n = 0; n < 2; ++n) { const size_t o = off + n * 16; f32x4 v = *(const f32x4*)(X + o); const f32x4 a = acc[ai][0][m][n], g = acc[ai][1][m][n];
                    v[0] += a[0] * sigmoidf_(g[0]); v[1] += a[1] * sigmoidf_(g[1]); v[2] += a[2] * sigmoidf_(g[2]); v[3] += a[3] * sigmoidf_(g[3]); *(f32x4*)(X + o) = v;
 }
                if (m & 1) EPI_FENCE;
            }
    }
};
struct EpiGate {
    static constexpr bool PERM = false, AFTER_DRAIN = false;
    const bf16_t* XC; float* AB; float* UB; const float *ba, *bx, *lam;
    DI void operator()(const f32x4 (&acc)[2][2][4][2], const Unit& u, int wr, int wc, int fr, int fq) const {
        const int row0 = u.pm * 256 + wr * 64 + fr, ch0 = u.pn * 128 + wc * 32 + 4 * fq;
#pragma unroll
        for (int n = 0; n < 2; ++n) {
            const int ch = ch0 + 16 * n;
            const f32x4 b_a = *(const f32x4*)(ba + ch), b_x = *(const f32x4*)(bx + ch), lm = *(const f32x4*)(lam + ch);
            f32x4 sp;
#pragma unroll
            for (int e = 0; e < 4; ++e) sp[e] = -8.0f * log1pf(expf(-lm[e]));
#pragma unroll
            for (int ai = 0; ai < 2; ++ai)
#pragma unroll
                for (int m = 0; m < 4; ++m) {
                    const size_t off = (size_t)(row0 + ai * 128 + m * 16) * 512 + ch;
                    const u32x2 xr = *(const u32x2*)(XC + off);
                    const float xc[4] = {__uint_as_float(xr.x << 16), __uint_as_float(xr.x & 0xffff0000u), __uint_as_float(xr.y << 16), __uint_as_float(xr.y & 0xffff0000u)};
                    const f32x4 rr = acc[ai][0][m][n] + b_a, ii = acc[ai][1][m][n] + b_x;
                    f32x4 av, uv;
#pragma unroll
                    for (int e = 0; e < 4; ++e) {
                        const float r = sigmoidf_(rr[e]), ig = sigmoidf_(ii[e]);
                        const float la = sp[e] * r;
                        const float a_ = fexp(la);
                        av[e] = a_;
                        uv[e] = __builtin_sqrtf(fmaxf(1.0f - a_ * a_, 0.0f)) * (ig * xc[e]);
                    }
                    *(f32x4*)(AB + off) = av; *(f32x4*)(UB + off) = uv; EPI_FENCE;
                }
        }
    }
};
struct EpiQKV {
    static constexpr bool PERM = true, AFTER_DRAIN = false;
    bf16_t *XA, *GA, *Q, *KB, *VT; float* out; const float *qg, *kg; const float* RS;
    DI void operator()(const f32x4 (&acc)[2][2][4][2], const Unit& u, int wr, int wc, int fr, int fq) const {
        const int pn = u.pn, row0 = u.pm * 256 + wr * 64 + fr;
        const bool needout = (u.pm >= 128) || ((u.pm & 31) >= 30);
        float* okb; float* ovb; int orow0;
        if (u.pm >= 128) { okb = out + O_SK; ovb = out + O_SV; orow0 = row0 - MPROMPT; }
        else { okb = out + O_PK; ovb = out + O_PV; orow0 = (u.pm >> 5) * 512 + ((u.pm & 31) - 30) * 256 + wr * 64 + fr; }
        if (pn < 4) {
            bf16_t* base = (pn < 2) ? XA : GA; const int col0 = (pn & 1) * 256 + wc * 32 + 8 * fq;
#pragma unroll
            for (int ai = 0; ai < 2; ++ai)
#pragma unroll
                for (int m = 0; m < 4; ++m)
#pragma unroll
                    for (int bj = 0; bj < 2; ++bj) {
                        const float rstd = RS ? rsqrtf(RS[row0 + ai * 128 + m * 16] * (1.0f / DM) + EPS) : 1.0f;
                        const f32x4 v0 = acc[ai][bj][m][0] * rstd, v1 = acc[ai][bj][m][1] * rstd; u32x4 w;
                        w.x = cvt_pk_bf16(v0[0], v0[1]); w.y = cvt_pk_bf16(v0[2], v0[3]); w.z = cvt_pk_bf16(v1[0], v1[1]); w.w = cvt_pk_bf16(v1[2], v1[3]);
                        *(u32x4*)(base + (size_t)(row0 + ai * 128 + m * 16) * 512 + col0 + bj * 128) = w; EPI_FENCE;
                    }
        } else if (pn < 8) {
            const bool isq = pn < 6; const int head = (pn & 1) * 4 + wc;
            const float* gp = isq ? qg : kg; const float gs = isq ? 0.125f : 1.0f;
            bf16_t* dst = isq ? Q : KB;
            f32x4 gn[2][2];
#pragma unroll
            for (int bj = 0; bj < 2; ++bj)
#pragma unroll
                for (int n = 0; n < 2; ++n) gn[bj][n] = *(const f32x4*)(gp + 32 * bj + 8 * fq + 4 * n);
#pragma unroll
            for (int ai = 0; ai < 2; ++ai)
#pragma unroll
                for (int m = 0; m < 4; ++m) {
                    float ss = 0.f;
                    const int rloc = ai * 128 + m * 16;
                    const float rstd = RS ? rsqrtf(RS[row0 + rloc] * (1.0f / DM) + EPS) : 1.0f;
#pragma unroll
                    for (int bj = 0; bj < 2; ++bj)
#pragma unroll
                        for (int n = 0; n < 2; ++n) { const f32x4 x = acc[ai][bj][m][n]; ss += (x[0] * x[0] + x[1] * x[1]) + (x[2] * x[2] + x[3] * x[3]); }
                    ss += __shfl_xor(ss, 16); ss += __shfl_xor(ss, 32);
                    const float rs = rstd * rsqrtf(ss * (rstd * rstd) * (1.0f / 64.0f) + EPS);
#pragma unroll
                    for (int bj = 0; bj < 2; ++bj) {
                        const f32x4 v0 = acc[ai][bj][m][0] * rs * gn[bj][0], v1 = acc[ai][bj][m][1] * rs * gn[bj][1];
                        u32x4 w; w.x = cvt_pk_bf16(v0[0] * gs, v0[1] * gs); w.y = cvt_pk_bf16(v0[2] * gs, v0[3] * gs); w.z = cvt_pk_bf16(v1[0] * gs, v1[1] * gs); w.w = cvt_pk_bf16(v1[2] * gs, v1[3] * gs);
                        *(u32x4*)(dst + (size_t)(row0 + rloc) * 512 + head * 64 + 32 * bj + 8 * fq) = w;
                        if (!isq && needout) { float* op = okb + (size_t)(orow0 + rloc) * 512 + head * 64 + 32 * bj + 8 * fq; *(f32x4*)op = v0; *(f32x4*)(op + 4) = v1; }
                    }
                    EPI_FENCE;
                }
        } else {
            const int col0 = (pn & 1) * 256 + wc * 32 + 8 * fq;
#pragma unroll
            for (int ai = 0; ai < 2; ++ai)
#pragma unroll
                for (int m = 0; m < 4; ++m) {
                    const int rloc = ai * 128 + m * 16;
#pragma unroll
                    for (int bj = 0; bj < 2; ++bj)
#pragma unroll
                        for (int n = 0; n < 2; ++n) {
                            const f32x4 v = acc[ai][bj][m][n] * (RS ? rsqrtf(RS[row0 + rloc] * (1.0f / DM) + EPS) : 1.0f); const int col = col0 + bj * 128 + 4 * n;
                            const unsigned p01 = cvt_pk_bf16(v[0], v[1]), p23 = cvt_pk_bf16(v[2], v[3]);
                            bf16_t* vp = VT + ((size_t)((row0 + rloc) >> 6) * 512 + col) * 64 + ((row0 + rloc) & 63);
                            vp[0] = (bf16_t)(p01 & 0xffffu); vp[64] = (bf16_t)(p01 >> 16); vp[128] = (bf16_t)(p23 & 0xffffu); vp[192] = (bf16_t)(p23 >> 16);
                            if (needout) *(f32x4*)(ovb + (size_t)(orow0 + rloc) * 512 + col) = v;
                        }
                    EPI_FENCE;
                }
        }
    }
};
struct EpiS5E {
    static constexpr bool PERM = false, AFTER_DRAIN = false;
    float* E;
    DI void operator()(const f32x4 (&acc)[2][2][4][2], const Unit& u, int wr, int wc, int fr, int fq) const {
        const int g = u.pn, ci0 = (u.pm - 9 * g) * 256 + wr * 64 + fr, col0 = wc * 32 + 4 * fq;
#pragma unroll
        for (int ai = 0; ai < 2; ++ai)
#pragma unroll
            for (int m = 0; m < 4; ++m) {
                const int ci = ci0 + ai * 128 + m * 16;
                if (ci < NCHUNK16) {
                    float* rp = E + ((size_t)g * S5ROWS + ci) * 128 + col0;
#pragma unroll
                    for (int n = 0; n < 2; ++n) *(f32x4*)(rp + 16 * n) = acc[ai][0][m][n];
                }
                EPI_FENCE;
            }
    }
};
struct EpiS5Y {
    static constexpr bool PERM = true, AFTER_DRAIN = false;
    bf16_t* Y;
    DI void operator()(const f32x4 (&acc)[2][2][4][2], const Unit& u, int wr, int wc, int fr, int fq) const {
        const int g = u.pn, ci0 = (u.pm - 9 * g) * 256 + wr * 64 + fr;
        bf16_t* yb = Y + (size_t)ci0 * (16 * DM) + (size_t)(wc * 2 + (fq >> 1)) * DM + 16 * g + 8 * (fq & 1);
#pragma unroll
        for (int ai = 0; ai < 2; ++ai)
#pragma unroll
            for (int m = 0; m < 4; ++m) {
                if (ci0 + ai * 128 + m * 16 < NCHUNK16) {
#pragma unroll
                    for (int bj = 0; bj < 2; ++bj) {
                        const f32x4 v0 = acc[ai][bj][m][0], v1 = acc[ai][bj][m][1]; u32x4 w;
                        w.x = cvt_pk_bf16(v0[0], v0[1]); w.y = cvt_pk_bf16(v0[2], v0[3]); w.z = cvt_pk_bf16(v1[0], v1[1]); w.w = cvt_pk_bf16(v1[2], v1[3]);
                        *(u32x4*)(yb + (size_t)(ai * 128 + m * 16) * (16 * DM) + (size_t)bj * (8 * DM)) = w;
                    }
                }
                EPI_FENCE;
            }
    }
};
struct GateOrder {
    pg8::StaticOrder S;
    DI bool next(int i, Unit& u) const { if (!S.next(i, u)) return false; u.ka = u.pn * 256; return true; }
    DI void a_ready(const Unit&) const {}
    DI void done(const Unit&) const {}
};
struct S5Order {
    int G, c;
    DI bool next(int i, Unit& u) const { const int L = i * G + c; if (L >= 512) return false; u.pn = L >> 3; u.pm = (L >> 3) * 9 + (L & 7); u.ka = 0; return true; }
    DI void a_ready(const Unit&) const {}
    DI void done(const Unit&) const {}
};

struct Ctx { int tid, lane, wave, gw, ngw, gtid, ngt; LAS unsigned char* lds; };

DI void transpose_item(const float* W, const float* gk, int K, int N, bf16_t* WT, int k0, int n0s, int n0d, LAS float* scr, int lane) {
    const float gl = gk ? gk[k0 + lane] : 1.0f;
    float r_[32];
#pragma unroll
    for (int i = 0; i < 32; ++i) r_[i] = W[(size_t)(k0 + 2 * i + (lane >> 5)) * N + n0s + (lane & 31)];
#pragma unroll
    for (int i = 0; i < 32; ++i) { const int kk = 2 * i + (lane >> 5); scr[kk * 33 + (lane & 31)] = r_[i] * __shfl(gl, kk); }
    asm volatile("s_waitcnt lgkmcnt(0)" ::: "memory");
    const int c = lane & 7;
#pragma unroll
    for (int j = 0; j < 4; ++j) { const int n = (lane >> 3) + 8 * j; const LAS float* s = scr + (8 * c) * 33 + n;
        u32x4 o; o.x = cvt_pk_bf16(s[0 * 33], s[1 * 33]); o.y = cvt_pk_bf16(s[2 * 33], s[3 * 33]); o.z = cvt_pk_bf16(s[4 * 33], s[5 * 33]); o.w = cvt_pk_bf16(s[6 * 33], s[7 * 33]);
        *(u32x4*)(WT + (size_t)(n0d + n) * K + k0 + 8 * c) = o; }
    asm volatile("s_waitcnt lgkmcnt(0)" ::: "memory");
}
DI int map_col(int kind, int N, int nd) {
    if (kind == 1) { const int pn = nd >> 8, bj = (nd >> 7) & 1, j = nd & 127; return bj * (N >> 1) + pn * 128 + j; }
    if (kind == 2 && nd >= 1024 && nd < 2048) { const int p = nd & 255, bj = p >> 7, wc = (p >> 5) & 3, j = p & 31; return (nd & ~255) + 64 * wc + 32 * bj + j; }
    return nd;
}
DI void convert_matrix_items(const Ctx& C, const float* W, const float* gk, int K, int N, bf16_t* WT, int kind, int& base) {
    const int nblk = N / 32, nitems = (K / 64) * nblk;
    LAS float* scr = (LAS float*)(C.lds + C.wave * 16384);
    int first = C.gw - (base % C.ngw); if (first < 0) first += C.ngw;
    for (int it = first; it < nitems; it += C.ngw) {
        const int kb = it / nblk, nb = it % nblk;
        transpose_item(W, gk, K, N, WT, 64 * kb, map_col(kind, N, 32 * nb), 32 * nb, scr, C.lane);
    }
    base += nitems;
}
DI void norm_row(const float* src, float* cpy, const float* g, bf16_t* XN, bf16_t* A2, int row, int lane) {
    const f32x4* xr = (const f32x4*)src + lane;
    f32x4 v[4]; float s = 0.f;
#pragma unroll
    for (int j = 0; j < 4; ++j) { v[j] = xr[64 * j]; s += (v[j][0] * v[j][0] + v[j][1] * v[j][1]) + (v[j][2] * v[j][2] + v[j][3] * v[j][3]); }
    if (cpy) {
#pragma unroll
        for (int j = 0; j < 4; ++j) ((f32x4*)cpy)[lane + 64 * j] = v[j];
    }
    const float rstd = rsqrtf(wave_sum(s) * (1.0f / DM) + EPS);
#pragma unroll
    for (int j = 0; j < 4; ++j) {
        const int col = 4 * lane + 256 * j; const f32x4 gg = g ? *(const f32x4*)(g + col) : (f32x4){1.f, 1.f, 1.f, 1.f};
        u32x2 w; w.x = cvt_pk_bf16(v[j][0] * rstd * gg[0], v[j][1] * rstd * gg[1]); w.y = cvt_pk_bf16(v[j][2] * rstd * gg[2], v[j][3] * rstd * gg[3]);
        if (XN) *(u32x2*)(XN + (size_t)row * DM + col) = w;
        else { const int grp = col >> 4, cc = col & 15, chunk = row >> 4, jj = row & 15; *(u32x2*)(A2 + ((size_t)grp * S5ROWS + chunk) * S5LDA + 128 + jj * 16 + cc) = w; }
    }
}
DI void norm_store(const f32x4 (&v)[4], float rstd, const float* g, bf16_t* XN, bf16_t* A2, int row, int lane) {
#pragma unroll
    for (int j = 0; j < 4; ++j) {
        const int col = 4 * lane + 256 * j; const f32x4 gg = g ? *(const f32x4*)(g + col) : (f32x4){1.f, 1.f, 1.f, 1.f};
        u32x2 w; w.x = cvt_pk_bf16(v[j][0] * rstd * gg[0], v[j][1] * rstd * gg[1]); w.y = cvt_pk_bf16(v[j][2] * rstd * gg[2], v[j][3] * rstd * gg[3]);
        if (XN) *(u32x2*)(XN + (size_t)row * DM + col) = w;
        else { const int grp = col >> 4, cc = col & 15, chunk = row >> 4, jj = row & 15; *(u32x2*)(A2 + ((size_t)grp * S5ROWS + chunk) * S5LDA + 128 + jj * 16 + cc) = w; }
    }
}
DI void norm_phase(const Ctx& C, float* X, const float* g, bf16_t* XN, bf16_t* A2) {
    for (int row = C.gw; row < MTOK; row += 2 * C.ngw) {
        const int row2 = row + C.ngw; const bool has2 = row2 < MTOK;
        f32x4 v0[4], v1[4]; float s0 = 0.f, s1 = 0.f;
        const f32x4* x0 = (const f32x4*)(X + (size_t)row * DM) + C.lane; const f32x4* x1 = (const f32x4*)(X + (size_t)(has2 ? row2 : row) * DM) + C.lane;
#pragma unroll
        for (int j = 0; j < 4; ++j) { v0[j] = x0[64 * j]; v1[j] = x1[64 * j]; }
#pragma unroll
        for (int j = 0; j < 4; ++j) { s0 += (v0[j][0] * v0[j][0] + v0[j][1] * v0[j][1]) + (v0[j][2] * v0[j][2] + v0[j][3] * v0[j][3]); s1 += (v1[j][0] * v1[j][0] + v1[j][1] * v1[j][1]) + (v1[j][2] * v1[j][2] + v1[j][3] * v1[j][3]); }
        const float r0 = rsqrtf(wave_sum(s0) * (1.0f / DM) + EPS), r1 = rsqrtf(wave_sum(s1) * (1.0f / DM) + EPS);
        norm_store(v0, r0, g, XN, A2, row, C.lane);
        if (has2) norm_store(v1, r1, g, XN, A2, row2, C.lane);
    }
}

#define XB_TMO      128
#define XB_XCNT(j)  (256  + 64 * (j))
#define XB_XSUB(j)  (1280 + 64 * (j))
#define XB_XGEN(j)  (2304 + 64 * (j))
#define XB_TOP      3328
#define XB_TOPGEN   3392
#define XCD_BAR_WORDS 3456
#define XB_SPIN_CAP (1u << 18)

__device__ __forceinline__ unsigned xb_ld(unsigned* p)              { return __hip_atomic_load(p, __ATOMIC_RELAXED, __HIP_MEMORY_SCOPE_AGENT); }
__device__ __forceinline__ unsigned xb_add(unsigned* p, unsigned v) { return __hip_atomic_fetch_add(p, v, __ATOMIC_RELAXED, __HIP_MEMORY_SCOPE_AGENT); }
__device__ __forceinline__ unsigned xb_xcc_id() { return (unsigned)__builtin_amdgcn_s_getreg((3 << 11) | 20) & 0xFu; }
#define XB_SPIN(cond, bar) do { unsigned _sp = 0; while (cond) { __builtin_amdgcn_s_sleep(1); \
    if ((++_sp & 255u) == 0u) { if (xb_ld(&(bar)[XB_TMO])) break; if (_sp > XB_SPIN_CAP) { atomicAdd(&(bar)[XB_TMO], 1u); break; } } } } while (0)

struct XcdBarrier {
    unsigned* bar; unsigned x;
    volatile LAS unsigned* st;
};

__device__ __forceinline__ XcdBarrier xcd_barrier_post(unsigned* bar, volatile LAS unsigned* st) {
    XcdBarrier b; b.bar = bar; b.x = xb_xcc_id(); b.st = st;
    if (threadIdx.x == 0) (void)xb_add(&bar[XB_XCNT(b.x)], 1u);
    return b;
}
__device__ __forceinline__ void xcd_barrier_complete(unsigned* bar, unsigned x, unsigned& nloc, unsigned& nx) {
    const unsigned G = gridDim.x * gridDim.y * gridDim.z;
    unsigned sum, cnt, mine, sp = 0u;
    for (;;) {
        sum = 0u; cnt = 0u; mine = 0u;
#pragma unroll
        for (unsigned j = 0; j < 16; ++j) { const unsigned c = xb_ld(&bar[XB_XCNT(j)]); sum += c; cnt += (c > 0u) ? 1u : 0u; mine = (j == x) ? c : mine; }
        if (sum == G) break;
        __builtin_amdgcn_s_sleep(1);
        if ((++sp & 255u) == 0u) { if (xb_ld(&bar[XB_TMO])) break; if (sp > XB_SPIN_CAP) { atomicAdd(&bar[XB_TMO], 1u); break; } }
    }
    nloc = mine > 0u ? mine : 1u; nx = cnt > 0u ? cnt : 1u;
}

__device__ __forceinline__ void xcd_barrier(const XcdBarrier& b) {
    asm volatile("s_waitcnt vmcnt(0)" ::: "memory");
    __syncthreads();
    if (threadIdx.x == 0) {
        unsigned* bar = b.bar;
        __builtin_amdgcn_s_waitcnt(0);
        unsigned nloc = b.st[0], nx = b.st[1];
        if (nloc == 0u) { xcd_barrier_complete(bar, b.x, nloc, nx); b.st[0] = nloc; b.st[1] = nx; }
        const unsigned old = xb_add(&bar[XB_XSUB(b.x)], 1u);
        const unsigned gen = old / nloc;
        if (old + 1u == (gen + 1u) * nloc) {
            __builtin_amdgcn_fence(__ATOMIC_RELEASE, "agent");
            asm volatile("s_waitcnt vmcnt(0)" ::: "memory");
            const unsigned og = xb_add(&bar[XB_TOP], 1u);
            const unsigned tg = og / nx;
            if (og + 1u == (tg + 1u) * nx) xb_add(&bar[XB_TOPGEN], 1u);
            else XB_SPIN(xb_ld(&bar[XB_TOPGEN]) == tg, bar);
            __builtin_amdgcn_fence(__ATOMIC_ACQUIRE, "agent");
            xb_add(&bar[XB_XGEN(b.x)], 1u);
            asm volatile("s_waitcnt vmcnt(0)" ::: "memory");
        } else {
            XB_SPIN(xb_ld(&bar[XB_XGEN(b.x)]) == gen, bar);
            __builtin_amdgcn_fence(__ATOMIC_ACQUIRE, "agent");
            asm volatile("s_waitcnt vmcnt(0)" ::: "memory");
        }
    }
    __syncthreads();
}

constexpr size_t WS_BARW = 1 * MiB + 768 * 1024;
constexpr int LDS_BARST = LDS_BIAS + 8704;
DI void grid_barrier(KP kp, LAS unsigned char* lds) {
    XcdBarrier b; b.bar = (unsigned*)(opq((unsigned char*)kp->ws) + WS_BARW); b.x = xb_xcc_id(); b.st = (volatile LAS unsigned*)(lds + LDS_BARST);
    xcd_barrier(b);
}

DI void p0_row(const float* src, bf16_t* XB, float* RSrow, int lane) {
    const f32x4* xr = (const f32x4*)src + lane; float s = 0.f;
#pragma unroll
    for (int j = 0; j < 4; ++j) { const f32x4 v = xr[64 * j]; s += (v[0] * v[0] + v[1] * v[1]) + (v[2] * v[2] + v[3] * v[3]);
        u32x2 w; w.x = cvt_pk_bf16(v[0], v[1]); w.y = cvt_pk_bf16(v[2], v[3]); *(u32x2*)(XB + 4 * lane + 256 * j) = w; }
    s = wave_sum(s); if (lane == 0) *RSrow = s;
}

DI void stat_phase(const Ctx& C, const float* X, bf16_t* XB, float* RS) {
    for (int row = C.gw; row < MTOK; row += C.ngw) p0_row(X + (size_t)row * DM, XB + (size_t)row * DM, RS + row, C.lane);
}

DI void p0_phase(const Ctx& C, KP kp) {
    unsigned char* ws = opq(kp->ws);
    int base = 0;
    for (int l = 0; l < 2; ++l) {
        convert_matrix_items(C, kp->in[9] + (size_t)l * DM * 2 * DFF, kp->in[8] + l * DM, DM, 2 * DFF, (bf16_t*)(ws + WS_WIN + (size_t)(2 * l) * 11 * MiB), 1, base);
        convert_matrix_items(C, kp->in[13] + (size_t)l * DM * 2 * DFF, kp->in[12] + l * DM, DM, 2 * DFF, (bf16_t*)(ws + WS_WIN + (size_t)(2 * l + 1) * 11 * MiB), 1, base);
        convert_matrix_items(C, kp->in[10] + (size_t)l * DFF * DM, nullptr, DFF, DM, (bf16_t*)(ws + WS_WOUT + (size_t)(2 * l) * 11 * HALF_MIB), 0, base);
        convert_matrix_items(C, kp->in[14] + (size_t)l * DFF * DM, nullptr, DFF, DM, (bf16_t*)(ws + WS_WOUT + (size_t)(2 * l + 1) * 11 * HALF_MIB), 0, base);
    }
    convert_matrix_items(C, kp->in[15], kp->in[11], DM, 2560, (bf16_t*)(ws + WS_WPROJ), 2, base);
    convert_matrix_items(C, kp->in[26], nullptr, DM, DM, (bf16_t*)(ws + WS_WO), 0, base);
    convert_matrix_items(C, kp->in[35], nullptr, DM, 2048, (bf16_t*)(ws + WS_WGLU), 1, base);
    {
        bf16_t* XB = (bf16_t*)(ws + WS_XN);
        for (int row = C.gw; row < MTOK; row += 2 * C.ngw) {
            const int row2 = row + C.ngw; const bool has2 = row2 < MTOK; const int rb = has2 ? row2 : row;
            const f32x4* x0 = (const f32x4*)(row < MPROMPT ? kp->in[0] + (size_t)row * DM : kp->in[1] + (size_t)(row - MPROMPT) * DM) + C.lane;
            const f32x4* x1 = (const f32x4*)(rb < MPROMPT ? kp->in[0] + (size_t)rb * DM : kp->in[1] + (size_t)(rb - MPROMPT) * DM) + C.lane;
            f32x4 v0[4], v1[4]; float s0 = 0.f, s1 = 0.f;
#pragma unroll
            for (int j = 0; j < 4; ++j) { v0[j] = x0[64 * j]; v1[j] = x1[64 * j]; }
#pragma unroll
            for (int j = 0; j < 4; ++j) { s0 += (v0[j][0] * v0[j][0] + v0[j][1] * v0[j][1]) + (v0[j][2] * v0[j][2] + v0[j][3] * v0[j][3]); s1 += (v1[j][0] * v1[j][0] + v1[j][1] * v1[j][1]) + (v1[j][2] * v1[j][2] + v1[j][3] * v1[j][3]); }
            const float r0 = rsqrtf(wave_sum(s0) * (1.0f / DM) + EPS), r1 = rsqrtf(wave_sum(s1) * (1.0f / DM) + EPS);
            norm_store(v0, r0, nullptr, XB, nullptr, row, C.lane);
            if (has2) norm_store(v1, r1, nullptr, XB, nullptr, row2, C.lane);
        }
    }
    {
        bf16_t* WG = (bf16_t*)(ws + WS_WGATE); const float* wa = kp->in[18]; const float* wx = kp->in[20];
        for (int idx = C.gtid; idx < 1024 * 512 / 2; idx += C.ngt) {
            const int nd = idx >> 8, k = (idx & 255) * 2;
            const int pn = nd >> 8, bj = (nd >> 7) & 1, j = nd & 127, ch = pn * 128 + j, hb = ch >> 6, jj = ch & 63;
            float v0 = 0.f, v1 = 0.f;
            if ((k >> 6) == hb) { const float* w = bj ? wx : wa; v0 = w[((size_t)hb * 64 + (k & 63)) * 64 + jj]; v1 = w[((size_t)hb * 64 + (k & 63) + 1) * 64 + jj]; }
            *(unsigned*)(WG + (size_t)nd * 512 + k) = cvt_pk_bf16(v0, v1);
        }
    }
    {
        bf16_t* WGC = (bf16_t*)(ws + WS_WGATEC); const float* wa = kp->in[18]; const float* wx = kp->in[20];
        for (int idx = C.gtid; idx < 1024 * 128 / 2; idx += C.ngt) {
            const int nd = idx >> 6, k = (idx & 63) * 2;
            const int pn = nd >> 8, bj = (nd >> 7) & 1, j = nd & 127, ch = pn * 128 + j, hb = ch >> 6, jj = ch & 63;
            float v0 = 0.f, v1 = 0.f;
            if ((k >> 6) == (hb & 1)) { const float* w = bj ? wx : wa; v0 = w[((size_t)hb * 64 + (k & 63)) * 64 + jj]; v1 = w[((size_t)hb * 64 + (k & 63) + 1) * 64 + jj]; }
            *(unsigned*)(WGC + (size_t)nd * 128 + k) = cvt_pk_bf16(v0, v1);
        }
    }
    {
        bf16_t* KC = (bf16_t*)(ws + WS_KC); bf16_t* VC = (bf16_t*)(ws + WS_VC); const float* ck = kp->in[4]; const float* cv = kp->in[5];
        for (int idx = C.gtid; idx < 8 * 512 * 512 / 2; idx += C.ngt) {
            const f32x2 v = *(const f32x2*)(ck + (size_t)idx * 2); *(unsigned*)(KC + (size_t)idx * 2) = cvt_pk_bf16(v[0], v[1]);
        }
        for (int idx = C.gtid; idx < 8 * 512 * 512 / 2; idx += C.ngt) {
            const int b = idx >> 17, col = (idx >> 8) & 511, pos = (idx & 255) * 2;
            const float v0 = cv[((size_t)b * 512 + pos) * 512 + col], v1 = cv[((size_t)b * 512 + pos + 1) * 512 + col];
            *(unsigned*)(VC + ((size_t)(b * 8 + (pos >> 6)) * 512 + col) * 64 + (pos & 63)) = cvt_pk_bf16(v0, v1);
        }
    }
    {
        f32x2* AP = (f32x2*)(ws + WS_AP); f32x2* BB = (f32x2*)(ws + WS_BBAR);
        const float* Are = kp->in[27]; const float* Aim = kp->in[28]; const float* Bre = kp->in[29]; const float* Bim = kp->in[30]; const float* ldt = kp->in[34];
        for (int idx = C.gtid; idx < 4096; idx += C.ngt) {
            const int g = idx >> 6; const float dt = expf(ldt[g]); const float ar = Are[idx], ai = Aim[idx];
            f32x2 a1 = {0.f, 0.f};
            for (int e = 0; e <= 16; ++e) {
                const float mag = expf((float)e * ar * dt); float sn, cs; sincosf((float)e * ai * dt, &sn, &cs);
                const f32x2 v = {mag * cs, mag * sn}; AP[idx * 17 + e] = v; if (e == 1) a1 = v;
            }
            const float nr = a1[0] - 1.0f, ni = a1[1], den = 1.0f / (ar * ar + ai * ai);
            const float cr = (nr * ar + ni * ai) * den, ci = (ni * ar - nr * ai) * den;
            for (int ch = 0; ch < 16; ++ch) { const float br = Bre[idx * 16 + ch], bi = Bim[idx * 16 + ch]; const f32x2 v = {cr * br - ci * bi, cr * bi + ci * br}; BB[idx * 16 + ch] = v; }
        }
    }
}
DI void s5_fill_phase(const Ctx& C, KP kp) {
    unsigned char* ws = opq(kp->ws);
    const f32x2* AP = (const f32x2*)(ws + WS_AP); const f32x2* BB = (const f32x2*)(ws + WS_BBAR);
    bf16_t* BTE = (bf16_t*)(ws + WS_BTE); bf16_t* BTY = (bf16_t*)(ws + WS_BTY);
    const float* Cre = kp->in[31]; const float* Cim = kp->in[32]; const float* Dsk = kp->in[33];
    for (int idx = C.gtid; idx < 64 * 256 * 256; idx += C.ngt) {
        const int g = idx >> 16, n = (idx >> 8) & 255, k = idx & 255;
        float val = 0.f;
        if (n < 128) { const int p = n & 63, j = k >> 4, ch = k & 15; const f32x2 a = AP[(g * 64 + p) * 17 + (15 - j)], b = BB[(g * 64 + p) * 16 + ch];
            val = (n < 64) ? (a[0] * b[0] - a[1] * b[1]) : (a[0] * b[1] + a[1] * b[0]); }
        BTE[idx] = (bf16_t)(cvt_pk_bf16(val, 0.f) & 0xffffu);
    }
    for (int idx = C.gtid; idx < 64 * 256 * 128; idx += C.ngt) {
        const int g = idx >> 15, n = (idx >> 7) & 255, k = idx & 127, i = n >> 4, o = n & 15, p = k & 63;
        const f32x2 a = AP[(g * 64 + p) * 17 + (i + 1)]; const float cr = Cre[((size_t)g * 16 + o) * 64 + p], ci = Cim[((size_t)g * 16 + o) * 64 + p];
        const float val = (k < 64) ? (cr * a[0] - ci * a[1]) : -(cr * a[1] + ci * a[0]);
        BTY[((size_t)g * 256 + n) * 384 + k] = (bf16_t)(cvt_pk_bf16(val, 0.f) & 0xffffu);
    }
    for (int idx = C.gtid; idx < 64 * 31 * 256; idx += C.ngt) {
        const int ch = idx & 15, o = (idx >> 4) & 15, t = idx >> 8, dd = t % 31, g = t / 31, d = dd - 15;
        if (d >= 0) {
            float T = 0.f;
            for (int p = 0; p < 64; ++p) {
                const f32x2 a = AP[(g * 64 + p) * 17 + d], b = BB[(g * 64 + p) * 16 + ch];
                const float cr = Cre[((size_t)g * 16 + o) * 64 + p], ci = Cim[((size_t)g * 16 + o) * 64 + p];
                const float abr = a[0] * b[0] - a[1] * b[1], abi = a[0] * b[1] + a[1] * b[0];
                T += cr * abr - ci * abi;
            }
            if (d == 0 && o == ch) T += Dsk[g * 16 + o];
            const bf16_t tv = (bf16_t)(cvt_pk_bf16(T, 0.f) & 0xffffu);
            for (int i = d; i < 16; ++i) BTY[((size_t)g * 256 + i * 16 + o) * 384 + 128 + (i - d) * 16 + ch] = tv;
        } else {
            for (int j = -d; j < 16; ++j) BTY[((size_t)g * 256 + (j + d) * 16 + o) * 384 + 128 + j * 16 + ch] = (bf16_t)0;
        }
    }
}
DI void conv_phase(const Ctx& C, KP kp) {
    unsigned char* ws = opq(kp->ws);
    const bf16_t* XA = (const bf16_t*)(ws + WS_XA); bf16_t* XC = (bf16_t*)(ws + WS_XC);
    const float* cw = kp->in[16]; const float* cb = kp->in[17]; const float* st = kp->in[2];
    for (int idx = C.gtid; idx < (MTOK / 8) * 64; idx += C.ngt) {
        const int row0 = (idx >> 6) * 8, c8 = (idx & 63) * 8;
        int t0, b; const bool smp = row0 >= MPROMPT;
        if (smp) { const int r = row0 - MPROMPT; b = r >> 6; t0 = r & 63; } else { b = row0 >> 13; t0 = row0 & 8191; }
        u32x4 raw[11];
#pragma unroll
        for (int j = 0; j < 11; ++j) { raw[j] = (u32x4){0u, 0u, 0u, 0u}; if (t0 - 3 + j >= 0) raw[j] = *(const u32x4*)(XA + (size_t)(row0 - 3 + j) * 512 + c8); }
        float xf[11][8];
#pragma unroll
        for (int j = 0; j < 11; ++j) { const u32x4 r = raw[j];
            xf[j][0] = __uint_as_float(r.x << 16); xf[j][1] = __uint_as_float(r.x & 0xffff0000u); xf[j][2] = __uint_as_float(r.y << 16); xf[j][3] = __uint_as_float(r.y & 0xffff0000u);
            xf[j][4] = __uint_as_float(r.z << 16); xf[j][5] = __uint_as_float(r.z & 0xffff0000u); xf[j][6] = __uint_as_float(r.w << 16); xf[j][7] = __uint_as_float(r.w & 0xffff0000u); }
        if (smp && t0 == 0) {
#pragma unroll
            for (int j = 0; j < 3; ++j) { const float* sp = st + ((size_t)b * 3 + j) * 512 + c8; const f32x4 s0 = *(const f32x4*)sp, s1 = *(const f32x4*)(sp + 4);
                xf[j][0] = s0[0]; xf[j][1] = s0[1]; xf[j][2] = s0[2]; xf[j][3] = s0[3]; xf[j][4] = s1[0]; xf[j][5] = s1[1]; xf[j][6] = s1[2]; xf[j][7] = s1[3]; }
        }
        float wgt[4][8], bias[8];
#pragma unroll
        for (int k = 0; k < 4; ++k) { const f32x4 w0 = *(const f32x4*)(cw + k * 512 + c8), w1 = *(const f32x4*)(cw + k * 512 + c8 + 4);
            wgt[k][0] = w0[0]; wgt[k][1] = w0[1]; wgt[k][2] = w0[2]; wgt[k][3] = w0[3]; wgt[k][4] = w1[0]; wgt[k][5] = w1[1]; wgt[k][6] = w1[2]; wgt[k][7] = w1[3]; }
        { const f32x4 b0 = *(const f32x4*)(cb + c8), b1 = *(const f32x4*)(cb + c8 + 4); bias[0] = b0[0]; bias[1] = b0[1]; bias[2] = b0[2]; bias[3] = b0[3]; bias[4] = b1[0]; bias[5] = b1[1]; bias[6] = b1[2]; bias[7] = b1[3]; }
#pragma unroll
        for (int r = 0; r < 8; ++r) {
            float a[8];
#pragma unroll
            for (int e2 = 0; e2 < 8; ++e2) { float v = bias[e2];
#pragma unroll
                for (int k = 0; k < 4; ++k) v += xf[r + k][e2] * wgt[k][e2];
                a[e2] = v; }
            u32x4 w; w.x = cvt_pk_bf16(a[0], a[1]); w.y = cvt_pk_bf16(a[2], a[3]); w.z = cvt_pk_bf16(a[4], a[5]); w.w = cvt_pk_bf16(a[6], a[7]);
            *(u32x4*)(XC + (size_t)(row0 + r) * 512 + c8) = w;
        }
        const int S = smp ? 64 : 8192;
        if (t0 + 8 == S) {
            float* op = (smp ? kp->out + O_SCONV : kp->out + O_PCONV) + (size_t)b * 3 * 512 + c8;
#pragma unroll
            for (int j = 0; j < 3; ++j) { *(f32x4*)(op + j * 512) = (f32x4){xf[8 + j][0], xf[8 + j][1], xf[8 + j][2], xf[8 + j][3]}; *(f32x4*)(op + j * 512 + 4) = (f32x4){xf[8 + j][4], xf[8 + j][5], xf[8 + j][6], xf[8 + j][7]}; }
        }
    }
}
#define MFMA32(a, b, c) __builtin_amdgcn_mfma_f32_32x32x16_bf16((a), (b), (c), 0, 0, 0)
DI int crow(int reg, int h) { return (reg & 3) + 8 * (reg >> 2) + 4 * h; }
DI bf16x8 pack_step(const f32x16& x, int s) {
    u32x4 p; p.x = cvt_pk_bf16(x[8 * s], x[8 * s + 1]); p.y = cvt_pk_bf16(x[8 * s + 2], x[8 * s + 3]); p.z = cvt_pk_bf16(x[8 * s + 4], x[8 * s + 5]); p.w = cvt_pk_bf16(x[8 * s + 6], x[8 * s + 7]);
    return __builtin_bit_cast(bf16x8, p);
}
DI void attn_tile_ptrs(int cs, int jt, int qrow0, int h, const bf16_t* KB, const bf16_t* VT, const bf16_t* KC, const bf16_t* VC, const char*& Kpc, const char*& Vpc) {
    if (cs < 512 || jt == 8) { const int krow = qrow0 - (8 - jt) * 64; Kpc = (const char*)(KB + (size_t)krow * 512 + h * 64); Vpc = (const char*)(VT + ((size_t)(krow >> 6) * 512 + h * 64) * 64); }
    else { const int b = cs - 512; Kpc = (const char*)(KC + ((size_t)b * 512 + jt * 64) * 512 + h * 64); Vpc = (const char*)(VC + ((size_t)(b * 8 + jt) * 512 + h * 64) * 64); }
}
DI void attn_phase(const Ctx& C, KP kp) {
    unsigned char* ws = opq(kp->ws);
    const bf16_t* Q = (const bf16_t*)(ws + WS_Q); const bf16_t* KB = (const bf16_t*)(ws + WS_KB); const bf16_t* VT = (const bf16_t*)(ws + WS_VT);
    const bf16_t* KC = (const bf16_t*)(ws + WS_KC); const bf16_t* VC = (const bf16_t*)(ws + WS_VC); bf16_t* MIX = (bf16_t*)(ws + WS_MIX);
    LAS float* bt = (LAS float*)(C.lds + LDS_BIAS);
    for (int i = C.tid; i < 257 * 8; i += 512) { const int r = i >> 3, h = i & 7; bt[h * 257 + r] = kp->in[25][i]; }
    __syncthreads();
    const int l31 = C.lane & 31, hh = C.lane >> 5;
    LAS unsigned char* kbuf = C.lds + C.wave * LDS_ATTW;
    LAS unsigned char* vbuf = kbuf + 9216;
    const unsigned kvoff = (unsigned)((C.lane >> 3) * 1024 + (C.lane & 7) * 16), vvoff = (unsigned)C.lane * 16u, loff = (unsigned)((C.lane >> 3) * 144 + (C.lane & 7) * 16);
    for (int id = C.gw; id < 8320; id += C.ngw) {
        const int qt = id & 1, wv = id >> 1;
        int h, cs;
        if (wv < 64) { h = wv & 7; cs = 512 + (wv >> 3); }
        else if (wv < 4096) { const int j = wv - 64, q = j >> 3; h = j & 7; cs = (q / 126) * 128 + 2 + (q % 126); }
        else { const int j = wv - 4096, q = j >> 3; h = j & 7; cs = (q >> 1) * 128 + (q & 1); }
        const int qrow0 = cs * 64;
        int jt0 = 0;
        if (cs < 512) { const int c = cs & 127; jt0 = c >= 8 ? 0 : 8 - c; }
        bf16x8 qf[4];
#pragma unroll
        for (int ks = 0; ks < 4; ++ks) qf[ks] = *(const bf16x8*)(Q + (size_t)(qrow0 + 32 * qt + l31) * 512 + h * 64 + 16 * ks + 8 * hh);
        f32x16 O[2];
#pragma unroll
        for (int a = 0; a < 2; ++a)
#pragma unroll
            for (int r = 0; r < 16; ++r) O[a][r] = 0.f;
        float mrun = -1e30f, lsum = 0.f;
        const LAS float* bth = bt + h * 257;
        const float cfar = bth[256];
        u32x4 kr[8], vr[8];
        { const char* Kpc; const char* Vpc; attn_tile_ptrs(cs, jt0, qrow0, h, KB, VT, KC, VC, Kpc, Vpc);
#pragma unroll
          for (int i = 0; i < 8; ++i) { kr[i] = *(const u32x4*)(Kpc + (kvoff + (unsigned)i * 8192u)); vr[i] = *(const u32x4*)(Vpc + (vvoff + (unsigned)i * 1024u)); } }
        for (int jt = jt0; jt < 9; ++jt) {
#pragma unroll
            for (int i = 0; i < 8; ++i) *(LAS u32x4*)(kbuf + loff + i * 1152) = kr[i];
#pragma unroll
            for (int i = 0; i < 8; ++i) *(LAS u32x4*)(vbuf + loff + i * 1152) = vr[i];
            if (jt < 8) { const char* Kpc; const char* Vpc; attn_tile_ptrs(cs, jt + 1, qrow0, h, KB, VT, KC, VC, Kpc, Vpc);
#pragma unroll
                for (int i = 0; i < 8; ++i) { kr[i] = *(const u32x4*)(Kpc + (kvoff + (unsigned)i * 8192u)); vr[i] = *(const u32x4*)(Vpc + (vvoff + (unsigned)i * 1024u)); } }
            f32x16 S[2];
#pragma unroll
            for (int kt = 0; kt < 2; ++kt) {
                f32x16 acc;
#pragma unroll
                for (int r = 0; r < 16; ++r) acc[r] = 0.f;
#pragma unroll
                for (int ks = 0; ks < 4; ++ks) { const bf16x8 kf = *(const LAS bf16x8*)(kbuf + (32 * kt + l31) * 144 + 32 * ks + 16 * hh); acc = MFMA32(kf, qf[ks], acc); }
                S[kt] = acc;
            }
            const int dd = 8 - jt;
            if (dd >= 3) {
#pragma unroll
                for (int kt = 0; kt < 2; ++kt)
#pragma unroll
                    for (int r = 0; r < 16; ++r) S[kt][r] += cfar;
            } else {
                int qk0 = l31 + 32 * qt - 4 * hh + 64 * dd; asm volatile("" : "+v"(qk0));
#pragma unroll
                for (int kt = 0; kt < 2; ++kt)
#pragma unroll
                    for (int r = 0; r < 16; ++r) { const int rel = qk0 - 32 * kt - ((r & 3) + 8 * (r >> 2)); const int ix = (rel > 128 ? 128 : rel) + 128; S[kt][r] += bth[ix]; }
            }
            {
                float mx = S[0][0];
#pragma unroll
                for (int r = 1; r < 16; ++r) mx = fmaxf(mx, S[0][r]);
#pragma unroll
                for (int r = 0; r < 16; ++r) mx = fmaxf(mx, S[1][r]);
                mx = fmaxf(mx, __shfl_xor(mx, 32));
                const float mn = fmaxf(mrun, mx), alpha = fexp(mrun - mn); mrun = mn;
                float ps = 0.f;
#pragma unroll
                for (int kt = 0; kt < 2; ++kt)
#pragma unroll
                    for (int r = 0; r < 16; ++r) { const float p = fexp(S[kt][r] - mn); S[kt][r] = p; ps += p; }
                lsum = lsum * alpha + ps;
#pragma unroll
                for (int dt = 0; dt < 2; ++dt)
#pragma unroll
                    for (int r = 0; r < 16; ++r) O[dt][r] *= alpha;
            }
#pragma unroll
            for (int kt = 0; kt < 2; ++kt)
#pragma unroll
                for (int s = 0; s < 2; ++s) {
                    const bf16x8 pf = pack_step(S[kt], s);
#pragma unroll
                    for (int dt = 0; dt < 2; ++dt) {
                        const LAS unsigned char* vp = vbuf + (32 * dt + l31) * 144 + (32 * kt + 16 * s + 4 * hh) * 2;
                        const u32x2 lo = *(const LAS u32x2*)vp, hi = *(const LAS u32x2*)(vp + 16);
                        u32x4 w; w.x = lo.x; w.y = lo.y; w.z = hi.x; w.w = hi.y;
                        O[dt] = MFMA32(__builtin_bit_cast(bf16x8, w), pf, O[dt]);
                    }
                }
        }
        {
            const float lt = lsum + __shfl_xor(lsum, 32), inv = 1.0f / lt;
            bf16_t* op = MIX + (size_t)(qrow0 + 32 * qt + l31) * DM + 512 + h * 64;
#pragma unroll
            for (int dt = 0; dt < 2; ++dt)
#pragma unroll
                for (int g4 = 0; g4 < 4; ++g4) {
                    u32x2 w; w.x = cvt_pk_bf16(O[dt][4 * g4] * inv, O[dt][4 * g4 + 1] * inv); w.y = cvt_pk_bf16(O[dt][4 * g4 + 2] * inv, O[dt][4 * g4 + 3] * inv);
                    *(u32x2*)(op + 32 * dt + 8 * g4 + 4 * hh) = w;
                }
        }
    }
}
DI void scan_a_phase(const Ctx& C, KP kp) {
    unsigned char* ws = opq(kp->ws); const float* AB = (const float*)(ws + WS_AB); const float* UB = (const float*)(ws + WS_UB);
    float* SP = (float*)(ws + WS_SP); float* SHs = (float*)(ws + WS_SH);
    for (int idx = C.gtid; idx < 520 * 512; idx += C.ngt) {
        const int ch = idx & 511, cs = idx >> 9; const size_t o0 = (size_t)cs * 64 * 512 + ch;
        float pp = 1.f, hv = 0.f;
#pragma unroll 1
        for (int t0 = 0; t0 < 64; t0 += 32) {
            float a[32], u[32];
#pragma unroll
            for (int i = 0; i < 32; ++i) { a[i] = AB[o0 + (size_t)(t0 + i) * 512]; u[i] = UB[o0 + (size_t)(t0 + i) * 512]; }
#pragma unroll
            for (int i = 0; i < 32; ++i) { hv = a[i] * hv + u[i]; pp *= a[i]; }
        }
        SP[idx] = pp; SHs[idx] = hv;
    }
}
DI void scan_b_phase(const Ctx& C, KP kp) {
    unsigned char* ws = opq(kp->ws); const float* AB = (const float*)(ws + WS_AB); const float* UB = (const float*)(ws + WS_UB);
    const float* SP = (const float*)(ws + WS_SP); const float* SHs = (const float*)(ws + WS_SH);
    const bf16_t* GA = (const bf16_t*)(ws + WS_GA); bf16_t* MIX = (bf16_t*)(ws + WS_MIX);
    int rnd = 0;
    for (int idx = C.gtid; idx < 520 * 512; idx += C.ngt, ++rnd) {
        const int ch = idx & 511; int cs = idx >> 9;
        if ((rnd & 1) && cs < 512) cs = (cs & ~127) | (127 - (cs & 127));
        const size_t o0 = (size_t)cs * 64 * 512 + ch;
        float hv = 0.f; bool last; float* oh;
        if (cs < 512) {
            const int c = cs & 127, b = cs >> 7;
            int j = 0;
            for (; j + 8 <= c; j += 8) { float p_[8], h_[8];
#pragma unroll
                for (int i = 0; i < 8; ++i) { const int si = (b * 128 + j + i) * 512 + ch; p_[i] = SP[si]; h_[i] = SHs[si]; }
#pragma unroll
                for (int i = 0; i < 8; ++i) hv = p_[i] * hv + h_[i]; }
            for (; j < c; ++j) { const int si = (b * 128 + j) * 512 + ch; hv = SP[si] * hv + SHs[si]; }
            last = (c == 127); oh = kp->out + O_PH + b * 512 + ch;
        } else { const int b = cs - 512; hv = kp->in[3][b * 512 + ch]; last = true; oh = kp->out + O_SH + b * 512 + ch; }
#pragma unroll 1
        for (int t0 = 0; t0 < 64; t0 += 32) {
            float a[32], u[32], g[32];
#pragma unroll
            for (int i = 0; i < 32; ++i) { a[i] = AB[o0 + (size_t)(t0 + i) * 512]; u[i] = UB[o0 + (size_t)(t0 + i) * 512]; g[i] = bf2f(GA[o0 + (size_t)(t0 + i) * 512]); }
#pragma unroll
            for (int i = 0; i < 32; ++i) { hv = a[i] * hv + u[i]; const float y = hv * gelu_tanh(g[i]); MIX[((size_t)cs * 64 + t0 + i) * DM + ch] = (bf16_t)(cvt_pk_bf16(y, 0.f) & 0xffffu); }
        }
        if (last) *oh = hv;
    }
}
DI void s5_chain_phase(const Ctx& C, KP kp) {
    unsigned char* ws = opq(kp->ws); const f32x2* AP = (const f32x2*)(ws + WS_AP); const float* E = (const float*)(ws + WS_E); bf16_t* A2 = (bf16_t*)(ws + WS_A2);
    const bool spread = (C.ngw == 2048);
    for (int it_ = 0; ; ++it_) {
        int idx;
        if (spread) { if (it_ > 0) break;
            if (C.wave == 0) idx = (C.gw >> 3) * 64 + C.lane;
            else if (C.wave <= 2) idx = 16384 + (((C.gw >> 3) * 2 + (C.wave - 1)) * 64 + C.lane);
            else break; }
        else { idx = C.gtid + it_ * C.ngt; if (idx >= 12 * 4096) break; }
        const int gp = idx & 4095, g = gp >> 6, p = gp & 63, sid = idx >> 12;
        int nsteps, chunk0; float sr = 0.f, si = 0.f; float* ore; float* oim;
        if (sid < 4) { nsteps = 512; chunk0 = sid * 512; ore = kp->out + O_PRE + sid * 4096 + gp; oim = kp->out + O_PIM + sid * 4096 + gp; }
        else { const int b = sid - 4; nsteps = 4; chunk0 = 2048 + b * 4; sr = kp->in[6][b * 4096 + gp]; si = kp->in[7][b * 4096 + gp]; ore = kp->out + O_SRE + b * 4096 + gp; oim = kp->out + O_SIM + b * 4096 + gp; }
        const f32x2 a16 = AP[gp * 17 + 16];
        const size_t r0 = (size_t)g * S5ROWS + chunk0;
        if (nsteps >= 32) {
#pragma unroll 1
        for (int c0 = 0; c0 < nsteps; c0 += 32) {
            float er[32], ei[32];
#pragma unroll
            for (int i = 0; i < 32; ++i) { er[i] = E[(r0 + c0 + i) * 128 + p]; ei[i] = E[(r0 + c0 + i) * 128 + 64 + p]; }
#pragma unroll
            for (int i = 0; i < 32; ++i) {
                bf16_t* ap = A2 + (r0 + c0 + i) * S5LDA;
                ap[p] = (bf16_t)(cvt_pk_bf16(sr, 0.f) & 0xffffu); ap[64 + p] = (bf16_t)(cvt_pk_bf16(si, 0.f) & 0xffffu);
                const float nr = a16[0] * sr - a16[1] * si + er[i], ni = a16[0] * si + a16[1] * sr + ei[i]; sr = nr; si = ni;
            }
        }
        } else
#pragma unroll 1
        for (int c0 = 0; c0 < nsteps; c0 += 4) {
            float er[4], ei[4];
#pragma unroll
            for (int i = 0; i < 4; ++i) { er[i] = E[(r0 + c0 + i) * 128 + p]; ei[i] = E[(r0 + c0 + i) * 128 + 64 + p]; }
#pragma unroll
            for (int i = 0; i < 4; ++i) {
                bf16_t* ap = A2 + (r0 + c0 + i) * S5LDA;
                ap[p] = (bf16_t)(cvt_pk_bf16(sr, 0.f) & 0xffffu); ap[64 + p] = (bf16_t)(cvt_pk_bf16(si, 0.f) & 0xffffu);
                const float nr = a16[0] * sr - a16[1] * si + er[i], ni = a16[0] * si + a16[1] * sr + ei[i]; sr = nr; si = ni;
            }
        }
        *ore = sr; *oim = si;
    }
}


constexpr int SOUT_LD = 132;
template <class F>
DI void small_gemm(const Ctx& C, const bf16_t* A, int lda, const bf16_t* Bt, int K, int nunits, const F f) {
    const int l31 = C.lane & 31, hh = C.lane >> 5, w = C.wave;
    LAS float* part = (LAS float*)C.lds;
    const int kw = K >> 3, nks = kw >> 4, k0 = w * kw;
    for (int ui = blockIdx.x; ui < nunits; ui += gridDim.x) {
        int arow0, brow[4]; { int b0_, b1_, b2_, b3_; f.unit(ui, arow0, b0_, b1_, b2_, b3_); brow[0] = b0_; brow[1] = b1_; brow[2] = b2_; brow[3] = b3_; }
        f32x16 acc[4];
#pragma unroll
        for (int t = 0; t < 4; ++t)
#pragma unroll
            for (int r = 0; r < 16; ++r) acc[t][r] = 0.f;
        const bf16_t* ap = A + (size_t)(arow0 + l31) * lda + k0 + 8 * hh;
        const bf16_t* bp[4];
#pragma unroll
        for (int t = 0; t < 4; ++t) bp[t] = Bt + (size_t)(brow[t] + l31) * K + k0 + 8 * hh;
#pragma unroll 2
        for (int ks = 0; ks < nks; ++ks) {
            const bf16x8 a = *(const bf16x8*)(ap + 16 * ks);
            bf16x8 b[4];
#pragma unroll
            for (int t = 0; t < 4; ++t) b[t] = *(const bf16x8*)(bp[t] + 16 * ks);
#pragma unroll
            for (int t = 0; t < 4; ++t) acc[t] = MFMA32(b[t], a, acc[t]);
        }
        __syncthreads();
#pragma unroll
        for (int t = 0; t < 4; ++t)
#pragma unroll
            for (int g = 0; g < 4; ++g)
                *(LAS f32x4*)(part + (w * 32 + l31) * SOUT_LD + 32 * t + 8 * g + 4 * hh) = (f32x4){acc[t][4 * g], acc[t][4 * g + 1], acc[t][4 * g + 2], acc[t][4 * g + 3]};
        __syncthreads();
#pragma unroll
        for (int it = 0; it < 2; ++it) {
            const int item = it * 512 + C.tid, row = item >> 5, c4 = item & 31;
            f32x4 s = *(const LAS f32x4*)(part + row * SOUT_LD + 4 * c4);
#pragma unroll
            for (int p = 1; p < 8; ++p) s = s + *(const LAS f32x4*)(part + (p * 32 + row) * SOUT_LD + 4 * c4);
            *(LAS f32x4*)(part + row * SOUT_LD + 4 * c4) = s;
        }
        __syncthreads();
        f.epi(ui, part, C.tid);
    }
    __syncthreads();
}
constexpr int SG_KC = 256;
constexpr int SG_LD = SG_KC * 2 + 16;
constexpr int SG_A = 0, SG_B = 64 * SG_LD, SG_OUT = SG_B + 128 * SG_LD;
static_assert(SG_OUT + 64 * SOUT_LD * 4 <= LDS_BIAS, "small-GEMM LDS map");
template <class F>
DI void small_gemm2(const Ctx& C, const bf16_t* A, int lda, const bf16_t* Bt, int K, int nunits64, const F f) {
    const int l31 = C.lane & 31, hh = C.lane >> 5, w = C.wave, rt = w >> 2, ct = w & 3;
    LAS unsigned char* lds = C.lds; LAS float* out = (LAS float*)(lds + SG_OUT);
    const int nch = K / SG_KC;
    const int prow = C.tid >> 5, ppart = C.tid & 31;
    for (int u64 = blockIdx.x; u64 < nunits64; u64 += gridDim.x) {
        const int uA = ((u64 >> 3) << 4) | ((u64 & 7) << 1);
        int arow0, brow[4]; { int b0_, b1_, b2_, b3_; f.unit(uA, arow0, b0_, b1_, b2_, b3_); brow[0] = b0_; brow[1] = b1_; brow[2] = b2_; brow[3] = b3_; }
        const bf16_t* ag = A + (size_t)(arow0 + prow) * lda + ppart * 8;
        const bf16_t* bg[8];
#pragma unroll
        for (int i = 0; i < 8; ++i) bg[i] = Bt + (size_t)(brow[i >> 1] + prow + 16 * (i & 1)) * K + ppart * 8;
        u32x4 ra[4], rb[8];
#pragma unroll
        for (int i = 0; i < 4; ++i) ra[i] = *(const u32x4*)(ag + (size_t)(16 * i) * lda);
#pragma unroll
        for (int i = 0; i < 8; ++i) rb[i] = *(const u32x4*)(bg[i]);
        f32x16 acc;
#pragma unroll
        for (int r = 0; r < 16; ++r) acc[r] = 0.f;
        for (int ch = 0; ch < nch; ++ch) {
            __syncthreads();
#pragma unroll
            for (int i = 0; i < 4; ++i) *(LAS u32x4*)(lds + SG_A + (prow + 16 * i) * SG_LD + ppart * 16) = ra[i];
#pragma unroll
            for (int i = 0; i < 8; ++i) *(LAS u32x4*)(lds + SG_B + (prow + 16 * i) * SG_LD + ppart * 16) = rb[i];
            __syncthreads();
            if (ch + 1 < nch) {
#pragma unroll
                for (int i = 0; i < 4; ++i) ra[i] = *(const u32x4*)(ag + (size_t)(16 * i) * lda + (ch + 1) * SG_KC);
#pragma unroll
                for (int i = 0; i < 8; ++i) rb[i] = *(const u32x4*)(bg[i] + (ch + 1) * SG_KC);
            }
#pragma unroll
            for (int ks = 0; ks < SG_KC / 16; ++ks) {
                const bf16x8 a = *(const LAS bf16x8*)(lds + SG_A + (32 * rt + l31) * SG_LD + 32 * ks + 16 * hh);
                const bf16x8 b = *(const LAS bf16x8*)(lds + SG_B + (32 * ct + l31) * SG_LD + 32 * ks + 16 * hh);
                acc = MFMA32(b, a, acc);
            }
        }
#pragma unroll
        for (int g = 0; g < 4; ++g) *(LAS f32x4*)(out + (32 * rt + l31) * SOUT_LD + 32 * ct + 8 * g + 4 * hh) = (f32x4){acc[4 * g], acc[4 * g + 1], acc[4 * g + 2], acc[4 * g + 3]};
        __syncthreads();
        f.epi(uA, out, C.tid); f.epi(uA + 1, out + 32 * SOUT_LD, C.tid);
    }
    __syncthreads();
}
DI void pair_rows(int q, int rowbase, int& br0, int& br1, int& br2, int& br3) { const int gb = rowbase + 256 * (q >> 1) + 64 * (q & 1); br0 = gb; br1 = gb + 32; br2 = gb + 128; br3 = gb + 160; }

struct SF_SwiGLU {
    bf16_t* HB; const float* RS;
    DI void unit(int ui, int& arow0, int& br0, int& br1, int& br2, int& br3) const { arow0 = MPROMPT + 32 * (ui & 15); pair_rows(ui >> 4, 0, br0, br1, br2, br3); }
    DI void epi(int ui, const LAS float* out, int tid) const {
        const int t = tid >> 4, c4 = tid & 15, row = MPROMPT + 32 * (ui & 15) + t, q = ui >> 4;
        const float rstd = RS ? rsqrtf(RS[row] * (1.0f / DM) + EPS) : 1.0f;
        const f32x4 g = *(const LAS f32x4*)(out + t * SOUT_LD + 4 * c4) * rstd, u = *(const LAS f32x4*)(out + t * SOUT_LD + 64 + 4 * c4) * rstd;
        u32x2 w; w.x = cvt_pk_bf16(siluf_(g[0]) * u[0], siluf_(g[1]) * u[1]); w.y = cvt_pk_bf16(siluf_(g[2]) * u[2], siluf_(g[3]) * u[3]);
        *(u32x2*)(HB + (size_t)row * DFF + 64 * q + 4 * c4) = w;
    }
};
struct SF_Residual {
    float* X; float s; const float* Rs; bf16_t* XB; float* RS;
    DI void unit(int ui, int& arow0, int& br0, int& br1, int& br2, int& br3) const { arow0 = MPROMPT + 32 * (ui & 15); const int cg = ui >> 4; br0 = 128 * cg; br1 = 128 * cg + 32; br2 = 128 * cg + 64; br3 = 128 * cg + 96; }
    DI void epi(int ui, const LAS float* out, int tid) const {
        const float sc = s; const float* const rsrc = Rs;
#pragma unroll
        for (int it = 0; it < 2; ++it) {
            const int item = it * 512 + tid, t = item >> 5, c4 = item & 31, rl = 32 * (ui & 15) + t, row = MPROMPT + rl, col = 128 * (ui >> 4) + 4 * c4;
            const f32x4 pv = *(const LAS f32x4*)(out + t * SOUT_LD + 4 * c4);
            f32x4 v = *(const f32x4*)(rsrc + (size_t)rl * DM + col); v[0] += pv[0] * sc; v[1] += pv[1] * sc; v[2] += pv[2] * sc; v[3] += pv[3] * sc;
            *(f32x4*)(X + (size_t)row * DM + col) = v;
        }
    }
};
struct SF_GLU {
    float* X; bf16_t* XB; float* RS;
    DI void unit(int ui, int& arow0, int& br0, int& br1, int& br2, int& br3) const { arow0 = MPROMPT + 32 * (ui & 15); pair_rows(ui >> 4, 0, br0, br1, br2, br3); }
    DI void epi(int ui, const LAS float* out, int tid) const {
        const int t = tid >> 4, c4 = tid & 15, row = MPROMPT + 32 * (ui & 15) + t, col = 64 * (ui >> 4) + 4 * c4;
        const f32x4 a = *(const LAS f32x4*)(out + t * SOUT_LD + 4 * c4), g = *(const LAS f32x4*)(out + t * SOUT_LD + 64 + 4 * c4);
        f32x4 v = *(const f32x4*)(X + (size_t)row * DM + col);
        v[0] += a[0] * sigmoidf_(g[0]); v[1] += a[1] * sigmoidf_(g[1]); v[2] += a[2] * sigmoidf_(g[2]); v[3] += a[3] * sigmoidf_(g[3]);
        *(f32x4*)(X + (size_t)row * DM + col) = v;
    }
};
struct SF_Gate {
    const bf16_t* XC; float* AB; float* UB; const float *ba, *bx, *lam;
    DI void unit(int ui, int& arow0, int& br0, int& br1, int& br2, int& br3) const { arow0 = MPROMPT + 32 * (ui & 15); pair_rows(ui >> 4, 0, br0, br1, br2, br3); }
    DI void epi(int ui, const LAS float* out, int tid) const {
        const int t = tid >> 4, c4 = tid & 15, row = MPROMPT + 32 * (ui & 15) + t, ch = 64 * (ui >> 4) + 4 * c4;
        const f32x4 rr = *(const LAS f32x4*)(out + t * SOUT_LD + 4 * c4) + *(const f32x4*)(ba + ch), ii = *(const LAS f32x4*)(out + t * SOUT_LD + 64 + 4 * c4) + *(const f32x4*)(bx + ch);
        const f32x4 lm = *(const f32x4*)(lam + ch);
        const size_t off = (size_t)row * 512 + ch; const u32x2 xr = *(const u32x2*)(XC + off);
        const float xc[4] = {__uint_as_float(xr.x << 16), __uint_as_float(xr.x & 0xffff0000u), __uint_as_float(xr.y << 16), __uint_as_float(xr.y & 0xffff0000u)};
        f32x4 av, uv;
#pragma unroll
        for (int e = 0; e < 4; ++e) { const float r = sigmoidf_(rr[e]), ig = sigmoidf_(ii[e]); const float la = -8.0f * log1pf(expf(-lm[e])) * r; const float a_ = fexp(la); av[e] = a_; uv[e] = __builtin_sqrtf(fmaxf(1.0f - a_ * a_, 0.0f)) * (ig * xc[e]); }
        *(f32x4*)(AB + off) = av; *(f32x4*)(UB + off) = uv;
    }
};
struct SF_QKV {
    bf16_t *XA, *GA, *Q, *KB, *VT; float* out; const float *qg, *kg; const float* RS;
    DI void unit(int ui, int& arow0, int& br0, int& br1, int& br2, int& br3) const {
        arow0 = MPROMPT + 32 * (ui & 15); const int cg = ui >> 4, pn = cg >> 1, hf = cg & 1;
        if (pn >= 4 && pn < 8) { const int b0 = 256 * pn + 64 * hf; br0 = b0; br1 = b0 + 128; br2 = b0 + 32; br3 = b0 + 160; }
        else { br0 = 128 * cg; br1 = 128 * cg + 32; br2 = 128 * cg + 64; br3 = 128 * cg + 96; }
    }
    DI void epi(int ui, const LAS float* o, int tid) const {
        const int cg = ui >> 4, pn = cg >> 1, hf = cg & 1;
#pragma unroll
        for (int it = 0; it < 2; ++it) {
            const int item = it * 512 + tid, t = item >> 5, c4 = item & 31, rl = 32 * (ui & 15) + t, row = MPROMPT + rl;
            const float rstd = RS ? rsqrtf(RS[row] * (1.0f / DM) + EPS) : 1.0f;
            f32x4 v = *(const LAS f32x4*)(o + t * SOUT_LD + 4 * c4) * rstd;
            if (pn < 4) {
                bf16_t* base = (pn < 2) ? XA : GA; u32x2 w; w.x = cvt_pk_bf16(v[0], v[1]); w.y = cvt_pk_bf16(v[2], v[3]);
                *(u32x2*)(base + (size_t)row * 512 + 128 * (cg & 3) + 4 * c4) = w;
            } else if (pn < 8) {
                const bool isq = pn < 6; const int head = (pn & 1) * 4 + 2 * hf + (c4 >> 4), dim = 4 * (c4 & 15);
                float ss = (v[0] * v[0] + v[1] * v[1]) + (v[2] * v[2] + v[3] * v[3]);
                ss += __shfl_xor(ss, 1); ss += __shfl_xor(ss, 2); ss += __shfl_xor(ss, 4); ss += __shfl_xor(ss, 8);
                const float rs = rsqrtf(ss * (1.0f / 64.0f) + EPS);
                const f32x4 gn = *(const f32x4*)((isq ? qg : kg) + dim);
                v = v * rs * gn;
                const float gs = isq ? 0.125f : 1.0f;
                u32x2 w; w.x = cvt_pk_bf16(v[0] * gs, v[1] * gs); w.y = cvt_pk_bf16(v[2] * gs, v[3] * gs);
                *(u32x2*)((isq ? Q : KB) + (size_t)row * 512 + head * 64 + dim) = w;
                if (!isq) *(f32x4*)(out + O_SK + (size_t)rl * 512 + head * 64 + dim) = v;
            } else {
                const int col = 128 * (cg & 3) + 4 * c4;
                const unsigned p01 = cvt_pk_bf16(v[0], v[1]), p23 = cvt_pk_bf16(v[2], v[3]);
                bf16_t* vp = VT + ((size_t)(row >> 6) * 512 + col) * 64 + (row & 63);
                vp[0] = (bf16_t)(p01 & 0xffffu); vp[64] = (bf16_t)(p01 >> 16); vp[128] = (bf16_t)(p23 & 0xffffu); vp[192] = (bf16_t)(p23 >> 16);
                *(f32x4*)(out + O_SV + (size_t)rl * 512 + col) = v;
            }
        }
    }
};
struct SF_S5E {
    float* E;
    DI void unit(int ui, int& arow0, int& br0, int& br1, int& br2, int& br3) const { arow0 = ui * S5ROWS + 2048; br0 = ui * 256; br1 = ui * 256 + 32; br2 = ui * 256 + 64; br3 = ui * 256 + 96; }
    DI void epi(int ui, const LAS float* out, int tid) const {
#pragma unroll
        for (int it = 0; it < 2; ++it) { const int item = it * 512 + tid, t = item >> 5, c4 = item & 31;
            *(f32x4*)(E + ((size_t)ui * S5ROWS + 2048 + t) * 128 + 4 * c4) = *(const LAS f32x4*)(out + t * SOUT_LD + 4 * c4); }
    }
};
struct SF_S5Y {
    bf16_t* Y;
    DI void unit(int ui, int& arow0, int& br0, int& br1, int& br2, int& br3) const { const int g = ui >> 1, hf = ui & 1; arow0 = g * S5ROWS + 2048; const int b0 = g * 256 + 128 * hf; br0 = b0; br1 = b0 + 32; br2 = b0 + 64; br3 = b0 + 96; }
    DI void epi(int ui, const LAS float* out, int tid) const {
        const int g = ui >> 1, hf = ui & 1;
#pragma unroll
        for (int it = 0; it < 2; ++it) { const int item = it * 512 + tid, t = item >> 5, c4 = item & 31, n = 128 * hf + 4 * c4, i16 = n >> 4, o = n & 15;
            const f32x4 v = *(const LAS f32x4*)(out + t * SOUT_LD + 4 * c4); u32x2 w; w.x = cvt_pk_bf16(v[0], v[1]); w.y = cvt_pk_bf16(v[2], v[3]);
            *(u32x2*)(Y + ((size_t)(2048 + t) * 16 + i16) * DM + 16 * g + o) = w; }
    }
};

template <class Epi, class Sched>
DI void run_gemm(LAS unsigned char* lds, const bf16_t* A, int lda, const bf16_t* Bt, int K, const Sched& S, const Epi& E) {
    pg8::Gemm g{A, Bt, K, lda};
    pg8::gemm_phase<Epi, Sched, true, true>(lds, g, S, E);
}

#ifndef PHMASK
#define PHMASK 0xffffffffu
#endif
#define PH_ON(b) (((PHMASK) >> (b)) & 1u)
__global__ void __launch_bounds__(512) fwd_megakernel(Params P) {
    extern __shared__ __attribute__((aligned(16))) unsigned char lds_raw[];
    int ph = 0;
    { volatile LAS unsigned* st_ = (volatile LAS unsigned*)((LAS unsigned char*)lds_raw + LDS_BARST); if (threadIdx.x == 0) { st_[0] = 0u; st_[1] = 0u; } __syncthreads();
      (void)xcd_barrier_post((unsigned*)(opq((unsigned char*)get_kp()->ws) + WS_BARW), st_); }
#define PHASE_BEGIN { KP kp = get_kp(); if (ph >= kp->ph_lo && ph < kp->ph_hi) { Ctx C; { int t_ = threadIdx.x; asm volatile("" : "+v"(t_)); C.tid = t_; } C.lane = C.tid & 63; C.wave = __builtin_amdgcn_readfirstlane(C.tid >> 6); \
    C.gw = blockIdx.x * 8 + C.wave; C.ngw = gridDim.x * 8; C.gtid = blockIdx.x * 512 + C.tid; C.ngt = gridDim.x * 512; C.lds = (LAS unsigned char*)lds_raw; \
    const int G = gridDim.x, c = blockIdx.x; (void)G; (void)c; \
    unsigned char* ws = opq((unsigned char*)kp->ws); float* X = opq((float*)kp->out); bf16_t* XN = (bf16_t*)(ws + WS_XN); bf16_t* HB = (bf16_t*)(ws + WS_HB); (void)X; (void)XN; (void)HB;
#define PHASE_END   if (ph + 1 < get_kp()->ph_hi) { if (ph == 0) cg::this_grid().sync(); else grid_barrier(get_kp(), C.lds); } } } ++ph;

    PHASE_BEGIN if (PH_ON(0)) p0_phase(C, get_kp()); PHASE_END
#define WIN_(i)  ((const bf16_t*)(ws + WS_WIN + (size_t)(i) * 11 * MiB))
#define WOUT_(i) ((const bf16_t*)(ws + WS_WOUT + (size_t)(i) * 11 * HALF_MIB))
#define RS_(slot) ((float*)nullptr)
#define XS_ (X + (size_t)MPROMPT * DM)
#define GEMM_FFN_IN(wi, slot)  PHASE_BEGIN if (PH_ON(2)) { pg8::StaticOrder S; S.init(MPROMPT, 2 * DFF, G, c); EpiSwiGLU E{HB, RS_(slot)}; run_gemm(C.lds, XN, DM, WIN_(wi), DM, S, E); SF_SwiGLU F{HB, RS_(slot)}; small_gemm2(C, XN, DM, WIN_(wi), DM, 352, F); } PHASE_END
#define GEMM_FFN_OUT(wi, rp, rs, xb, rsp) PHASE_BEGIN if (PH_ON(3)) { pg8::StaticOrder S; S.init(MPROMPT, DM, G, c); EpiResidual E{X, 0.5f, rp, rs, xb, rsp}; run_gemm(C.lds, HB, DFF, WOUT_(wi), DFF, S, E); SF_Residual F{X, 0.5f, rs, xb, rsp}; small_gemm2(C, HB, DFF, WOUT_(wi), DFF, 64, F); } PHASE_END
    GEMM_FFN_IN(0, 4)
    GEMM_FFN_OUT(0, kp->in[0], kp->in[1], (bf16_t*)nullptr, (float*)nullptr)
    PHASE_BEGIN norm_phase(C, X, nullptr, XN, nullptr); if (PH_ON(4)) s5_fill_phase(C, get_kp()); PHASE_END
    PHASE_BEGIN if (PH_ON(5)) { pg8::StaticOrder S; S.init(MPROMPT, 2560, G, c);
        EpiQKV E{(bf16_t*)(ws + WS_XA), (bf16_t*)(ws + WS_GA), (bf16_t*)(ws + WS_Q), (bf16_t*)(ws + WS_KB), (bf16_t*)(ws + WS_VT), X, kp->in[23], kp->in[24], RS_(0)};
        run_gemm(C.lds, XN, DM, (const bf16_t*)(ws + WS_WPROJ), DM, S, E);
        SF_QKV F{E.XA, E.GA, E.Q, E.KB, E.VT, E.out, E.qg, E.kg, E.RS}; small_gemm2(C, XN, DM, (const bf16_t*)(ws + WS_WPROJ), DM, 160, F); } PHASE_END
    PHASE_BEGIN if (PH_ON(6)) conv_phase(C, get_kp()); if (PH_ON(7)) attn_phase(C, get_kp()); PHASE_END
    PHASE_BEGIN if (PH_ON(8)) { GateOrder S; S.S.init(MPROMPT, 1024, G, c);
        EpiGate E{(const bf16_t*)(ws + WS_XC), (float*)(ws + WS_AB), (float*)(ws + WS_UB), kp->in[19], kp->in[21], kp->in[22]};
        run_gemm(C.lds, (const bf16_t*)(ws + WS_XC), 512, (const bf16_t*)(ws + WS_WGATEC), 128, S, E);
        SF_Gate F{E.XC, E.AB, E.UB, E.ba, E.bx, E.lam}; small_gemm2(C, (const bf16_t*)(ws + WS_XC), 512, (const bf16_t*)(ws + WS_WGATE), 512, 64, F); } PHASE_END
    PHASE_BEGIN if (PH_ON(9)) scan_a_phase(C, get_kp()); PHASE_END
    PHASE_BEGIN if (PH_ON(10)) scan_b_phase(C, get_kp()); PHASE_END
    PHASE_BEGIN if (PH_ON(3)) { pg8::StaticOrder S; S.init(MPROMPT, DM, G, c); EpiResidual E{X, 1.0f, X, XS_, (bf16_t*)nullptr, (float*)nullptr}; run_gemm(C.lds, (const bf16_t*)(ws + WS_MIX), DM, (const bf16_t*)(ws + WS_WO), DM, S, E); SF_Residual F{X, 1.0f, XS_, (bf16_t*)nullptr, (float*)nullptr}; small_gemm2(C, (const bf16_t*)(ws + WS_MIX), DM, (const bf16_t*)(ws + WS_WO), DM, 64, F); } PHASE_END
    PHASE_BEGIN norm_phase(C, X, nullptr, XN, nullptr); PHASE_END
    GEMM_FFN_IN(1, 1)
    GEMM_FFN_OUT(1, X, XS_, (bf16_t*)nullptr, (float*)nullptr)
    PHASE_BEGIN norm_phase(C, X, nullptr, XN, nullptr); PHASE_END
    GEMM_FFN_IN(2, 2)
    GEMM_FFN_OUT(2, X, XS_, (bf16_t*)nullptr, (float*)nullptr)
    PHASE_BEGIN if (PH_ON(1)) norm_phase(C, X, kp->in[11] + DM, nullptr, (bf16_t*)(ws + WS_A2)); PHASE_END
    PHASE_BEGIN if (PH_ON(11)) { S5Order S{G, c}; EpiS5E E{(float*)(ws + WS_E)}; run_gemm(C.lds, (const bf16_t*)(ws + WS_A2) + 128, S5LDA, (const bf16_t*)(ws + WS_BTE), 256, S, E); SF_S5E F{E.E}; small_gemm(C, (const bf16_t*)(ws + WS_A2) + 128, S5LDA, (const bf16_t*)(ws + WS_BTE), 256, 64, F); } PHASE_END
    PHASE_BEGIN if (PH_ON(12)) s5_chain_phase(C, get_kp()); PHASE_END
    PHASE_BEGIN if (PH_ON(13)) { S5Order S{G, c}; EpiS5Y E{(bf16_t*)(ws + WS_Y)}; run_gemm(C.lds, (const bf16_t*)(ws + WS_A2), S5LDA, (const bf16_t*)(ws + WS_BTY), 384, S, E); SF_S5Y F{E.Y}; small_gemm(C, (const bf16_t*)(ws + WS_A2), S5LDA, (const bf16_t*)(ws + WS_BTY), 384, 128, F); } PHASE_END
    PHASE_BEGIN if (PH_ON(14)) { pg8::StaticOrder S; S.init(MPROMPT, 2048, G, c); EpiGLU E{X, (bf16_t*)nullptr, (float*)nullptr}; run_gemm(C.lds, (const bf16_t*)(ws + WS_Y), DM, (const bf16_t*)(ws + WS_WGLU), DM, S, E); SF_GLU F{X, (bf16_t*)nullptr, (float*)nullptr}; small_gemm2(C, (const bf16_t*)(ws + WS_Y), DM, (const bf16_t*)(ws + WS_WGLU), DM, 128, F); } PHASE_END
    PHASE_BEGIN norm_phase(C, X, nullptr, XN, nullptr); PHASE_END
    GEMM_FFN_IN(3, 3)
    GEMM_FFN_OUT(3, X, XS_, (bf16_t*)nullptr, (float*)nullptr)
}
constexpr int N_PHASES = 24;

extern "C" void kernel_launch(void* const* d_in, const int* in_sizes, int n_in, void* d_out, int out_size, void* d_ws, size_t ws_size, hipStream_t stream) {
    static int grid = 0;
    if (grid == 0) {
        if (n_in != 36 || ws_size < WS_END) { fprintf(stderr, "kernel_launch: unexpected n_in %d or ws_size %zu (< %zu)\n", n_in, ws_size, (size_t)WS_END); grid = -1; return; }
        int dev = 0, cus = 0, per_cu = 0;
        hipGetDevice(&dev); hipDeviceGetAttribute(&cus, hipDeviceAttributeMultiprocessorCount, dev);
        if (hipFuncSetAttribute((const void*)fwd_megakernel, hipFuncAttributeMaxDynamicSharedMemorySize, LDS_BYTES) != hipSuccess) { fprintf(stderr, "kernel_launch: hipFuncSetAttribute failed\n"); grid = -1; return; }
        hipOccupancyMaxActiveBlocksPerMultiprocessor(&per_cu, (const void*)fwd_megakernel, 512, LDS_BYTES);
        if (per_cu < 1) { fprintf(stderr, "kernel_launch: occupancy query says %d blocks per CU\n", per_cu); per_cu = 1; }
        (void)hipGetLastError();
        grid = cus * 1;
    }
    if (grid < 0) return;
    if (hipMemsetAsync((char*)d_ws + WS_BARW, 0, 16384, stream) != hipSuccess) { fprintf(stderr, "kernel_launch: memset of barrier words failed\n"); return; }
    Params p{};
    for (int i = 0; i < 36; ++i) p.in[i] = (const float*)d_in[i];
    p.out = (float*)d_out; p.ws = (unsigned char*)d_ws; p.ph_lo = 0; p.ph_hi = N_PHASES;
    void* args[] = {&p};
    hipError_t e = hipLaunchCooperativeKernel((const void*)fwd_megakernel, dim3(grid), dim3(512), args, LDS_BYTES, stream);
    if (e != hipSuccess) fprintf(stderr, "cooperative launch failed: %s (grid %d)\n", hipGetErrorString(e), grid);
}
```
